# Optimizing an MI355X kernel written in HIP

```python
import jax, jax.numpy as jnp
from jax import lax
import numpy as np

D_MODEL = 1024
BATCH = 4
SEQ = 4096
DEPTH = 2

CHUNK = 64
QBLOCK = 128
HEAD_DIM = 64
EPS = 1e-6
H_FOX = 8
H_CHK = 8
N_LEFT_CHUNKS = 8
BAND = (N_LEFT_CHUNKS + 1) * CHUNK
REL_CLIP = 256
N_REL = CHUNK - 1 + REL_CLIP + 1
FORGET_BIAS = 3.0
H_SB = 8
H_MLA = 8
Q_LORA = 384
KV_LORA = 256
NOPE_DIM = 64
ROPE_DIM = 32
V_DIM = 64
ROPE_THETA = 10000.0
D_FF = 4 * D_MODEL
N_EVEN = (DEPTH + 1) // 2
N_ODD = DEPTH // 2

W_FOX = H_FOX * HEAD_DIM
W_CHK = H_CHK * HEAD_DIM
W_SB = H_SB * HEAD_DIM
W_MLA = H_MLA * V_DIM
SPLIT_AB = [W_FOX, W_FOX, W_FOX, H_FOX, W_CHK, W_CHK, W_CHK]
SPLIT_CD = [W_SB, W_SB, W_SB, Q_LORA, KV_LORA, ROPE_DIM]
IN_AB = sum(SPLIT_AB)
IN_CD = sum(SPLIT_CD)
MIX_AB = W_FOX + W_CHK
MIX_CD = W_SB + W_MLA

kernel_name = "chunk_causal_hybrid_fox_chunkrel_stickbreak_mla"


def _split(h, sizes):
    return jnp.split(h, np.cumsum(sizes)[:-1].tolist(), axis=-1)


def rmsnorm(x, g):
    xf = x.astype(jnp.float32)
    y = xf * lax.rsqrt(jnp.mean(xf * xf, axis=-1, keepdims=True) + EPS)
    return (y * g.astype(jnp.float32)).astype(x.dtype)


def rope(x, positions):
    half = ROPE_DIM // 2
    inv_freq = ROPE_THETA ** (-jnp.arange(half, dtype=jnp.float32) / half)
    ang = positions.astype(jnp.float32)[..., None] * inv_freq
    cos = jnp.cos(ang)[:, :, None, :]
    sin = jnp.sin(ang)[:, :, None, :]
    x1 = x[..., :half].astype(jnp.float32)
    x2 = x[..., half:].astype(jnp.float32)
    out = jnp.concatenate([x1 * cos - x2 * sin, x2 * cos + x1 * sin], axis=-1)
    return out.astype(x.dtype)


def _sweep_query_blocks(block_fn, seq):
    out = lax.map(block_fn, jnp.arange(seq // QBLOCK))
    nb, b, qb, h, dv = out.shape
    return jnp.moveaxis(out, 0, 1).reshape(b, nb * qb, h, dv)


def fox_attention(q, k, v, log_f):
    seq = q.shape[1]
    scale = HEAD_DIM ** -0.5
    cum = jnp.transpose(jnp.cumsum(log_f, axis=1), (0, 2, 1))
    k_pos = jnp.arange(seq)

    def block(i):
        start = i * QBLOCK
        qb = lax.dynamic_slice_in_dim(q, start, QBLOCK, axis=1)
        cq = lax.dynamic_slice_in_dim(cum, start, QBLOCK, axis=2)
        q_pos = start + jnp.arange(QBLOCK)
        s = jnp.einsum('bqhd,bkhd->bhqk', qb, k).astype(jnp.float32) * scale
        s = s + cq[..., :, None] - cum[..., None, :]
        mask = k_pos[None, :] <= q_pos[:, None]
        p = jax.nn.softmax(jnp.where(mask, s, -jnp.inf), axis=-1)
        return jnp.einsum('bhqk,bkhd->bqhd', p.astype(v.dtype), v)

    return _sweep_query_blocks(block, seq)


def chunked_relpos_attention(q, k, v, rel_bias):
    b, seq, h, d = q.shape
    nc = seq // CHUNK
    left = N_LEFT_CHUNKS * CHUNK
    scale = HEAD_DIM ** -0.5

    def band(t):
        tp = jnp.pad(t, ((0, 0), (left, 0), (0, 0), (0, 0)))
        tp = tp.reshape(b, nc + N_LEFT_CHUNKS, CHUNK, h, d)
        return jnp.concatenate([tp[:, i:i + nc] for i in range(N_LEFT_CHUNKS + 1)], axis=2)

    kb, vb = band(k), band(v)
    qc = q.reshape(b, nc, CHUNK, h, d)
    rel = np.arange(CHUNK)[:, None] + left - np.arange(BAND)[None, :]
    rel_idx = np.clip(rel, -(CHUNK - 1), REL_CLIP) + (CHUNK - 1)
    bias = rel_bias[:, rel_idx].astype(jnp.float32)
    s = jnp.einsum('bcqhd,bckhd->bhcqk', qc, kb).astype(jnp.float32) * scale
    s = s + bias[None, :, None]
    key_abs = jnp.arange(nc)[:, None] * CHUNK - left + jnp.arange(BAND)[None, :]
    valid = (key_abs >= 0)[None, None, :, None, :]
    p = jax.nn.softmax(jnp.where(valid, s, -jnp.inf), axis=-1)
    out = jnp.einsum('bhcqk,bckhd->bcqhd', p.astype(v.dtype), vb)
    return out.reshape(b, seq, h, d)


def stick_breaking_attention(q, k, v):
    seq = q.shape[1]
    scale = HEAD_DIM ** -0.5
    k_pos = jnp.arange(seq)

    def block(i):
        start = i * QBLOCK
        qb = lax.dynamic_slice_in_dim(q, start, QBLOCK, axis=1)
        q_pos = start + jnp.arange(QBLOCK)
        z = jnp.einsum('bqhd,bkhd->bhqk', qb, k).astype(jnp.float32) * scale
        mask = k_pos[None, :] < q_pos[:, None]
        log_beta = jax.nn.log_sigmoid(z)
        log_keep = jnp.where(mask, jax.nn.log_sigmoid(-z), 0.0)
        suffix = lax.cumsum(log_keep, axis=3, reverse=True) - log_keep
        a = jnp.where(mask, jnp.exp(log_beta + suffix), 0.0)
        return jnp.einsum('bhqk,bkhd->bqhd', a.astype(v.dtype), v)

    return _sweep_query_blocks(block, seq)


def mla_attention(q_nope, q_rope, k_nope, k_rope, v):
    seq = q_nope.shape[1]
    scale = (NOPE_DIM + ROPE_DIM) ** -0.5
    k_chunk = jnp.arange(seq) // CHUNK

    def block(i):
        start = i * QBLOCK
        qn = lax.dynamic_slice_in_dim(q_nope, start, QBLOCK, axis=1)
        qr = lax.dynamic_slice_in_dim(q_rope, start, QBLOCK, axis=1)
        q_chunk = (start + jnp.arange(QBLOCK)) // CHUNK
        s = (jnp.einsum('bqhd,bkhd->bhqk', qn, k_nope)
             + jnp.einsum('bqhr,bkr->bhqk', qr, k_rope)).astype(jnp.float32) * scale
        mask = k_chunk[None, :] <= q_chunk[:, None]
        p = jax.nn.softmax(jnp.where(mask, s, -jnp.inf), axis=-1)
        return jnp.einsum('bhqk,bkhd->bqhd', p.astype(v.dtype), v)

    return _sweep_query_blocks(block, seq)


def even_mixer(h, w_in, b_forget, rel_bias, w_out):
    b, s, _ = h.shape
    qa, ka, va, fa, qb, kb, vb = _split(h @ w_in, SPLIT_AB)
    heads = lambda t, n: t.reshape(b, s, n, HEAD_DIM)
    log_f = jax.nn.log_sigmoid((fa + b_forget).astype(jnp.float32))
    o_a = fox_attention(heads(qa, H_FOX), heads(ka, H_FOX), heads(va, H_FOX), log_f)
    o_b = chunked_relpos_attention(heads(qb, H_CHK), heads(kb, H_CHK), heads(vb, H_CHK), rel_bias)
    o = jnp.concatenate([o_a.reshape(b, s, W_FOX), o_b.reshape(b, s, W_CHK)], axis=-1)
    return o @ w_out


def odd_mixer(h, positions, w_in, q_norm, kv_norm, w_uq, w_ukv, w_out):
    b, s, _ = h.shape
    qc, kc, vc, c_q, c_kv, k_r = _split(h @ w_in, SPLIT_CD)
    heads = lambda t, n, d: t.reshape(b, s, n, d)
    o_c = stick_breaking_attention(heads(qc, H_SB, HEAD_DIM), heads(kc, H_SB, HEAD_DIM), heads(vc, H_SB, HEAD_DIM))
    q_full = heads(rmsnorm(c_q, q_norm) @ w_uq, H_MLA, NOPE_DIM + ROPE_DIM)
    q_nope, q_rope = q_full[..., :NOPE_DIM], rope(q_full[..., NOPE_DIM:], positions)
    kv_full = heads(rmsnorm(c_kv, kv_norm) @ w_ukv, H_MLA, NOPE_DIM + V_DIM)
    k_nope, v_d = kv_full[..., :NOPE_DIM], kv_full[..., NOPE_DIM:]
    k_rope = rope(k_r[:, :, None, :], positions)[:, :, 0, :]
    o_d = mla_attention(q_nope, q_rope, k_nope, k_rope, v_d)
    o = jnp.concatenate([o_c.reshape(b, s, W_SB), o_d.reshape(b, s, W_MLA)], axis=-1)
    return o @ w_out


def squared_relu_mlp(h, w_up, w_down):
    return jnp.square(jax.nn.relu(h @ w_up)) @ w_down


def setup_inputs(seed: int = 0) -> dict:
    key = jax.random.key(seed)
    ks = jax.random.split(key, 20)
    nrm = lambda k, shape, fan_in: jax.random.normal(k, shape, jnp.float32) * fan_in ** -0.5
    gain = lambda k, shape: 1.0 + 0.05 * jax.random.normal(k, shape, jnp.float32)
    x = jax.random.normal(ks[0], (BATCH, SEQ, D_MODEL), jnp.float32)
    offset = jax.random.randint(ks[1], (BATCH, 1), 0, 100000, dtype=jnp.int32)
    positions = offset + jnp.arange(SEQ, dtype=jnp.int32)[None, :]
    return {
        "x": x,
        "positions": positions,
        "norm_mix": gain(ks[2], (DEPTH, D_MODEL)),
        "norm_mlp": gain(ks[3], (DEPTH, D_MODEL)),
        "norm_final": gain(ks[4], (D_MODEL,)),
        "w_in_ab": nrm(ks[5], (N_EVEN, D_MODEL, IN_AB), D_MODEL),
        "b_forget": FORGET_BIAS + 0.5 * jax.random.normal(ks[6], (N_EVEN, H_FOX), jnp.float32),
        "rel_bias": 0.2 * jax.random.normal(ks[7], (N_EVEN, H_CHK, N_REL), jnp.float32),
        "w_out_ab": nrm(ks[8], (N_EVEN, MIX_AB, D_MODEL), MIX_AB),
        "w_in_cd": nrm(ks[9], (N_ODD, D_MODEL, IN_CD), D_MODEL),
        "q_norm": gain(ks[10], (N_ODD, Q_LORA)),
        "kv_norm": gain(ks[11], (N_ODD, KV_LORA)),
        "w_uq": nrm(ks[12], (N_ODD, Q_LORA, H_MLA * (NOPE_DIM + ROPE_DIM)), Q_LORA),
        "w_ukv": nrm(ks[13], (N_ODD, KV_LORA, H_MLA * (NOPE_DIM + V_DIM)), KV_LORA),
        "w_out_cd": nrm(ks[14], (N_ODD, MIX_CD, D_MODEL), MIX_CD),
        "w_up": nrm(ks[15], (DEPTH, D_MODEL, D_FF), D_MODEL),
        "w_down": nrm(ks[16], (DEPTH, D_FF, D_MODEL), D_FF),
    }


def reference(x, positions, norm_mix, norm_mlp, norm_final, w_in_ab, b_forget, rel_bias, w_out_ab,
              w_in_cd, q_norm, kv_norm, w_uq, w_ukv, w_out_cd, w_up, w_down):
    for layer in range(DEPTH):
        h = rmsnorm(x, norm_mix[layer])
        if layer % 2 == 0:
            e = layer // 2
            x = x + even_mixer(h, w_in_ab[e], b_forget[e], rel_bias[e], w_out_ab[e])
        else:
            o = layer // 2
            x = x + odd_mixer(h, positions, w_in_cd[o], q_norm[o], kv_norm[o], w_uq[o], w_ukv[o], w_out_cd[o])
        x = x + squared_relu_mlp(rmsnorm(x, norm_mlp[layer]), w_up[layer], w_down[layer])
    return rmsnorm(x, norm_final)
```

```cpp
#include <hip/hip_runtime.h>
#include <hip/hip_cooperative_groups.h>
#include <cstdio>
#include <cstdint>
#include <cmath>
namespace cg = cooperative_groups;
namespace pg8 {
#define PG8_LAS __attribute__((address_space(3)))
typedef unsigned short bf16_t;
typedef short bf16x8 __attribute__((ext_vector_type(8)));
typedef float f32x4 __attribute__((ext_vector_type(4)));
typedef unsigned u32x4 __attribute__((ext_vector_type(4)));
constexpr int BM = 256, BK = 64, HALF = 128, HTB = HALF * BK * 2  , STAGE_BYTES = 8 * HTB, NXCD = 8, WGM = 8;

__host__ __device__ __forceinline__ int lds_byte(int r, int c) { const int st = (r >> 4) * 2 + (c >> 5), rr = r & 15, cc = c & 31, ob = rr * 64 + cc * 2; return st * 1024 + (ob ^ (((ob >> 9) & 1) << 5)); }
__host__ __device__ __forceinline__ void stage_rc(int b, int& R, int& C) { const int st = b / 1024, sb = b % 1024, swz = sb ^ (((sb >> 9) & 1) << 5); R = (st >> 1) * 16 + swz / 64; C = (st & 1) * 32 + (swz % 64) / 2; }
__host__ __device__ __forceinline__ int perm32(int rho) { const int n = rho >> 4, i = rho & 15; return 8 * (i >> 2) + 4 * n + (i & 3); }

struct Unit { int pm, pn; };
struct Gemm { const bf16_t* A; const bf16_t* Bt; int M, N, K; };

struct StaticOrder {
    int nM, nN, nwg, G, c;
    __host__ __device__ void init(int M, int N, int G_, int c_) { nM = M / BM; nN = N / BM; nwg = nM * nN; G = G_; c = c_; }
    __host__ __device__ bool next(int i, Unit& u) const {
        const long L = (long)i * G + c; if (L >= nwg) return false;
        int wgid = (int)L; { const int q = nwg / NXCD, r = nwg % NXCD, xcd = wgid % NXCD, off = wgid / NXCD; wgid = (xcd < r ? xcd * (q + 1) : r * (q + 1) + (xcd - r) * q) + off; }
        const int nig = WGM * nN, gid = wgid / nig, fm = gid * WGM, gsz = (nM - fm) < WGM ? (nM - fm) : WGM;
        u.pm = fm + ((wgid % nig) % gsz); u.pn = (wgid % nig) / gsz; return true;
    }
    __device__ __forceinline__ void a_ready(const Unit&) const {}
    __device__ __forceinline__ void done(const Unit&) const {}
};

__device__ __forceinline__ unsigned cvt_pk_bf16(float lo, float hi) { unsigned r; asm volatile("v_cvt_pk_bf16_f32 %0, %1, %2" : "=v"(r) : "v"(lo), "v"(hi)); return r; }
template <class Epi, class Sched, bool ALIGN_EPI = false, bool SP2 = false>
__device__ __forceinline__ void gemm_phase(PG8_LAS unsigned char* lds, const Gemm g, const Sched& S, const Epi& E) {
    const int tid = threadIdx.x, wid = __builtin_amdgcn_readfirstlane(tid >> 6), lane = tid & 63, wr = wid >> 2, wc = wid & 3, fr = lane & 15, fq = lane >> 4;
    const int K = g.K, nt = K / BK;
    unsigned voffA[2], voffB[2];
#pragma unroll
    for (int i = 0; i < 2; ++i) { int R, C; stage_rc(tid * 16 + i * 8192, R, C); const int Rb = Epi::PERM ? ((R & ~31) + perm32(R & 31)) : R;
        voffA[i] = (unsigned)(R * K + C) * 2u; voffB[i] = (unsigned)(Rb * K + C) * 2u; }
    const size_t kstep = (size_t)(BK * 2);
    const size_t hstep = (size_t)HALF * K * 2;
    const size_t tstep = 2 * hstep;
    const unsigned ldsw = (unsigned)wid * 1024u;
    const int aoff = lds_byte(wr * 64 + fr, fq * 8), boff = lds_byte(wc * 32 + fr, fq * 8);
#define PG8_SA(b, h) (((b) * 2 + (h)) * HTB)
#define PG8_SB(b, h) ((4 + (b) * 2 + (h)) * HTB)
#define PG8_STAGE(bufoff, gbase, voff) do { _Pragma("unroll") for (int _i = 0; _i < 2; ++_i) \
        __builtin_amdgcn_global_load_lds((const unsigned*)((const char*)(gbase) + (voff)[_i]), (PG8_LAS unsigned*)(lds + (bufoff) + ldsw + _i * 8192), 16, 0, 0); } while (0)
#define PG8_LDA(dst, b, h) do { _Pragma("unroll") for (int m = 0; m < 4; ++m) _Pragma("unroll") for (int k = 0; k < 2; ++k) dst[m][k] = *(const PG8_LAS bf16x8*)(lds + PG8_SA(b, h) + aoff + m * 2048 + k * 1024); } while (0)
#define PG8_LDB(dst, b, h) do { _Pragma("unroll") for (int n = 0; n < 2; ++n) _Pragma("unroll") for (int k = 0; k < 2; ++k) dst[n][k] = *(const PG8_LAS bf16x8*)(lds + PG8_SB(b, h) + boff + n * 2048 + k * 1024); } while (0)
#define PG8_MMA(ai, bj, At, Bt) do { __builtin_amdgcn_s_setprio(1); _Pragma("unroll") for (int m = 0; m < 4; ++m) _Pragma("unroll") for (int n = 0; n < 2; ++n) _Pragma("unroll") for (int k = 0; k < 2; ++k) \
        acc[ai][bj][m][n] = __builtin_amdgcn_mfma_f32_16x16x32_bf16(Bt[n][k], At[m][k], acc[ai][bj][m][n], 0, 0, 0); __builtin_amdgcn_s_setprio(0); } while (0)
#define PG8_WAIT_V(n) asm volatile("s_waitcnt vmcnt(" #n ")" ::: "memory")
#define PG8_WAIT_L(n) asm volatile("s_waitcnt lgkmcnt(" #n ")" ::: "memory")
#define PG8_BAR __builtin_amdgcn_s_barrier()
#define PG8_SCHED __builtin_amdgcn_sched_barrier(0)
    Unit cur, nxt; int ui = 0;
    if (!S.next(0, cur)) return;
    f32x4 acc[2][2][4][2];
#pragma unroll
    for (int a = 0; a < 2; ++a)
#pragma unroll
        for (int b = 0; b < 2; ++b)
#pragma unroll
            for (int m = 0; m < 4; ++m)
#pragma unroll
                for (int n = 0; n < 2; ++n) acc[a][b][m][n] = (f32x4){0.f, 0.f, 0.f, 0.f};
    bf16x8 At[4][2], B0[2][2], B1[2][2];
    const char* cA = (const char*)g.A + (size_t)cur.pm * tstep; const char* cB = (const char*)g.Bt + (size_t)cur.pn * tstep;
    S.a_ready(cur);
    if constexpr (SP2) {
        PG8_STAGE(PG8_SB(0, 0), cB, voffB); PG8_STAGE(PG8_SB(0, 1), cB + hstep, voffB); PG8_STAGE(PG8_SA(0, 0), cA, voffA); PG8_STAGE(PG8_SA(0, 1), cA + hstep, voffA);
        if (wr == 1) PG8_BAR;
        PG8_WAIT_V(2); PG8_BAR;
        PG8_STAGE(PG8_SB(1, 0), cB + kstep, voffB); PG8_STAGE(PG8_SA(1, 0), cA + kstep, voffA); PG8_STAGE(PG8_SB(1, 1), cB + hstep + kstep, voffB);
        PG8_WAIT_V(6); PG8_BAR;
    } else {
        PG8_STAGE(PG8_SB(0, 0), cB, voffB); PG8_STAGE(PG8_SA(0, 0), cA, voffA); PG8_STAGE(PG8_SB(0, 1), cB + hstep, voffB); PG8_STAGE(PG8_SA(0, 1), cA + hstep, voffA);
        if (wr == 1) PG8_BAR;
        PG8_WAIT_V(4); PG8_BAR;
        PG8_STAGE(PG8_SB(1, 0), cB + kstep, voffB); PG8_STAGE(PG8_SA(1, 0), cA + kstep, voffA); PG8_STAGE(PG8_SB(1, 1), cB + hstep + kstep, voffB);
        PG8_WAIT_V(6); PG8_BAR;
    }
    for (;;) {
        const bool has_next = S.next(ui + 1, nxt);
        const char* nA = has_next ? (const char*)g.A + (size_t)nxt.pm * tstep : cA; const char* nB = has_next ? (const char*)g.Bt + (size_t)nxt.pn * tstep : cB;
        for (int t = 0; t < nt; t += 2) {
            const bool last = (t == nt - 2);
            const char* a1 = cA + (size_t)(t + 1) * kstep;
            const char* a2 = last ? nA : cA + (size_t)(t + 2) * kstep; const char* b2 = last ? nB : cB + (size_t)(t + 2) * kstep;
            const char* a3 = a2 + kstep; const char* b3 = b2 + kstep;
            if (last && has_next) S.a_ready(nxt);
            if constexpr (SP2) {
            PG8_LDB(B0, 0, 0); PG8_LDB(B1, 0, 1); PG8_SCHED; PG8_LDA(At, 0, 0); PG8_STAGE(PG8_SA(1, 1), a1 + hstep, voffA);
            PG8_WAIT_V(8); PG8_WAIT_L(0); PG8_BAR; PG8_MMA(0, 0, At, B0); PG8_MMA(0, 1, At, B1); PG8_BAR; PG8_SCHED;
            PG8_LDA(At, 0, 1); PG8_STAGE(PG8_SB(0, 0), b2, voffB); PG8_STAGE(PG8_SB(0, 1), b2 + hstep, voffB); PG8_STAGE(PG8_SA(0, 0), a2, voffA);
            PG8_WAIT_V(8); PG8_WAIT_L(0); PG8_BAR; PG8_MMA(1, 0, At, B0); PG8_MMA(1, 1, At, B1); PG8_BAR; PG8_SCHED;
            PG8_LDB(B0, 1, 0); PG8_LDB(B1, 1, 1); PG8_SCHED; PG8_LDA(At, 1, 0); PG8_STAGE(PG8_SA(0, 1), a2 + hstep, voffA);
            PG8_WAIT_V(8); PG8_WAIT_L(0); PG8_BAR; PG8_MMA(0, 0, At, B0); PG8_MMA(0, 1, At, B1); PG8_BAR; PG8_SCHED;
            PG8_LDA(At, 1, 1); PG8_STAGE(PG8_SB(1, 0), b3, voffB); PG8_STAGE(PG8_SB(1, 1), b3 + hstep, voffB); PG8_STAGE(PG8_SA(1, 0), a3, voffA);
            PG8_WAIT_V(8); PG8_WAIT_L(0); PG8_BAR; PG8_MMA(1, 0, At, B0); PG8_MMA(1, 1, At, B1); PG8_BAR; PG8_SCHED;
            } else {
            PG8_LDB(B0, 0, 0); PG8_SCHED; PG8_LDA(At, 0, 0); PG8_STAGE(PG8_SA(1, 1), a1 + hstep, voffA);
            PG8_WAIT_L(8); PG8_BAR; PG8_WAIT_L(0); PG8_MMA(0, 0, At, B0); PG8_BAR; PG8_SCHED;
            PG8_LDB(B1, 0, 1); PG8_STAGE(PG8_SB(0, 0), b2, voffB);
            PG8_BAR; PG8_WAIT_L(0); PG8_MMA(0, 1, At, B1); PG8_BAR;
            PG8_LDA(At, 0, 1); PG8_STAGE(PG8_SA(0, 0), a2, voffA);
            PG8_BAR; PG8_WAIT_L(0); PG8_MMA(1, 0, At, B0); PG8_BAR; PG8_SCHED;
            PG8_STAGE(PG8_SB(0, 1), b2 + hstep, voffB);
            PG8_WAIT_V(6); PG8_BAR; PG8_MMA(1, 1, At, B1); PG8_BAR;
            PG8_LDB(B0, 1, 0); PG8_SCHED; PG8_LDA(At, 1, 0); PG8_STAGE(PG8_SA(0, 1), a2 + hstep, voffA);
            PG8_WAIT_L(8); PG8_BAR; PG8_WAIT_L(0); PG8_MMA(0, 0, At, B0); PG8_BAR; PG8_SCHED;
            PG8_LDB(B1, 1, 1); PG8_STAGE(PG8_SB(1, 0), b3, voffB);
            PG8_BAR; PG8_WAIT_L(0); PG8_MMA(0, 1, At, B1); PG8_BAR;
            PG8_LDA(At, 1, 1); PG8_STAGE(PG8_SA(1, 0), a3, voffA);
            PG8_BAR; PG8_WAIT_L(0); PG8_MMA(1, 0, At, B0); PG8_BAR; PG8_SCHED;
            PG8_STAGE(PG8_SB(1, 1), b3 + hstep, voffB);
            PG8_WAIT_V(6); PG8_BAR; PG8_MMA(1, 1, At, B1); PG8_BAR;
            }
        }
        if constexpr (ALIGN_EPI) { if (wr == 0) PG8_BAR; }
        if constexpr (!Epi::AFTER_DRAIN) { E(acc, cur, wr, wc, fr, fq); S.done(cur); }
        if (!has_next) break;
#pragma unroll
        for (int a = 0; a < 2; ++a)
#pragma unroll
            for (int b = 0; b < 2; ++b)
#pragma unroll
                for (int m = 0; m < 4; ++m)
#pragma unroll
                    for (int n = 0; n < 2; ++n) acc[a][b][m][n] = (f32x4){0.f, 0.f, 0.f, 0.f};
        cur = nxt; cA = nA; cB = nB; ++ui;
        if constexpr (ALIGN_EPI) { if (wr == 1) PG8_BAR; }
    }
    PG8_WAIT_V(0);
    if constexpr (!ALIGN_EPI) { if (wr == 0) PG8_BAR; }
    PG8_BAR;
    if constexpr (Epi::AFTER_DRAIN) { E.fused(acc, cur, wr, wc, fr, fq, lds, wid, lane); S.done(cur); }
#undef PG8_SA
#undef PG8_SB
#undef PG8_STAGE
#undef PG8_LDA
#undef PG8_LDB
#undef PG8_MMA
#undef PG8_WAIT_V
#undef PG8_WAIT_L
#undef PG8_BAR
#undef PG8_SCHED
}
}

namespace pg8 {
template <int RELU2> struct EpiStore {
    static constexpr bool PERM = true, AFTER_DRAIN = false;
    bf16_t* O; int ldc;
    __device__ __forceinline__ void operator()(const f32x4 (&acc)[2][2][4][2], const Unit& u, int wr, int wc, int fr, int fq) const {
        const int row0 = u.pm * BM + wr * 64 + fr, col0 = u.pn * BM + wc * 32 + 8 * fq;
#pragma unroll
        for (int ai = 0; ai < 2; ++ai)
#pragma unroll
            for (int m = 0; m < 4; ++m) { bf16_t* rowp = O + (size_t)(row0 + ai * HALF + m * 16) * ldc + col0;
#pragma unroll
                for (int bj = 0; bj < 2; ++bj) { f32x4 v0 = acc[ai][bj][m][0], v1 = acc[ai][bj][m][1];
                    if (RELU2) {
#pragma unroll
                        for (int e = 0; e < 4; ++e) { const float a = fmaxf(v0[e], 0.f), b = fmaxf(v1[e], 0.f); v0[e] = a * a; v1[e] = b * b; } }
                    u32x4 w; w.x = cvt_pk_bf16(v0[0], v0[1]); w.y = cvt_pk_bf16(v0[2], v0[3]); w.z = cvt_pk_bf16(v1[0], v1[1]); w.w = cvt_pk_bf16(v1[2], v1[3]);
                    *(u32x4*)(rowp + bj * HALF) = w; } }
    }
};
struct EpiResid {
    static constexpr bool PERM = false, AFTER_DRAIN = false;
    const float* base; float* out; int ldc;
    __device__ __forceinline__ void operator()(const f32x4 (&acc)[2][2][4][2], const Unit& u, int wr, int wc, int fr, int fq) const {
        const int row0 = u.pm * BM + wr * 64 + fr, col0 = u.pn * BM + wc * 32 + 4 * fq;
#pragma unroll
        for (int ai = 0; ai < 2; ++ai)
#pragma unroll
            for (int m = 0; m < 4; ++m) { const size_t off = (size_t)(row0 + ai * HALF + m * 16) * ldc + col0;
#pragma unroll
                for (int bj = 0; bj < 2; ++bj)
#pragma unroll
                    for (int n = 0; n < 2; ++n) { const size_t o = off + bj * HALF + n * 16; const f32x4 bs = *(const f32x4*)(base + o); *(f32x4*)(out + o) = bs + acc[ai][bj][m][n]; } }
    }
};
struct EpiQRope {
    static constexpr bool PERM = false, AFTER_DRAIN = false;
    bf16_t* O; int ldc; const float* tab;
    __device__ __forceinline__ void operator()(const f32x4 (&acc)[2][2][4][2], const Unit& u, int wr, int wc, int fr, int fq) const {
        typedef unsigned u32x2 __attribute__((ext_vector_type(2)));
        const int row0 = u.pm * BM + wr * 64 + fr;
#pragma unroll
        for (int ai = 0; ai < 2; ++ai)
#pragma unroll
            for (int m = 0; m < 4; ++m) { const int row = row0 + ai * HALF + m * 16;
                const f32x4 cs = *(const f32x4*)(tab + (size_t)row * 32 + 4 * fq), sn = *(const f32x4*)(tab + (size_t)row * 32 + 16 + 4 * fq);
#pragma unroll
                for (int bj = 0; bj < 2; ++bj) { const int cgp = u.pn * BM + bj * HALF + wc * 32;
                    f32x4 x1 = acc[ai][bj][m][0], x2 = acc[ai][bj][m][1];
                    if ((cgp % 96) == 64) { const f32x4 o1 = x1 * cs - x2 * sn, o2 = x2 * cs + x1 * sn; x1 = o1; x2 = o2; }
                    bf16_t* op = O + (size_t)row * ldc + cgp + 4 * fq;
                    u32x2 w1, w2; w1.x = cvt_pk_bf16(x1[0], x1[1]); w1.y = cvt_pk_bf16(x1[2], x1[3]); w2.x = cvt_pk_bf16(x2[0], x2[1]); w2.y = cvt_pk_bf16(x2[2], x2[3]);
                    *(u32x2*)op = w1; *(u32x2*)(op + 16) = w2; }
                asm volatile("" ::: "memory"); }
    }
};
}

#define DI __device__ __forceinline__
#define LAS __attribute__((address_space(3)))
typedef unsigned short bf16_t;
typedef short bf16x8 __attribute__((ext_vector_type(8)));
typedef short s16x4 __attribute__((ext_vector_type(4)));
typedef float f32x4 __attribute__((ext_vector_type(4)));
typedef float f32x16 __attribute__((ext_vector_type(16)));
typedef unsigned u32x4 __attribute__((ext_vector_type(4)));
typedef unsigned u32x2 __attribute__((ext_vector_type(2)));

constexpr int BATCH = 4, SEQ = 4096, DM = 1024, MT = BATCH * SEQ, DFF = 4096;
constexpr int LD_AB = 3072, LD_CD = 2304, NSRC_AB = 3080, NSRC_CD = 2208;
constexpr int NWAVES = 8, NTHREADS = 512;
constexpr float LOG2E = 1.4426950408889634f, LN2 = 0.6931471805599453f, EPS = 1e-6f;
constexpr size_t MiB = 1u << 20;
constexpr size_t WS_WINAB = 0, WS_WOUTAB = 6 * MiB, WS_WINCD = 8 * MiB, WS_WUQ = 13 * MiB, WS_WUKV = 14 * MiB, WS_WOUTCD = 15 * MiB;
constexpr size_t WS_WUP0 = 17 * MiB, WS_WUP1 = 25 * MiB, WS_WDN0 = 33 * MiB, WS_WDN1 = 41 * MiB;
constexpr size_t WS_LOGF = 49 * MiB, WS_CUM = 49 * MiB + 512 * 1024, WS_TAB = 50 * MiB, WS_KR = 52 * MiB;
constexpr size_t WS_XN = 54 * MiB, WS_CQN = 54 * MiB, WS_CKVN = 66 * MiB, WS_O = 86 * MiB;
constexpr size_t WS_BIG = 118 * MiB, WS_QF = 190 * MiB, WS_KVF = 214 * MiB, WS_END = 246 * MiB;
constexpr int LDS_BYTES = 147456;

DI float bf2f(unsigned short v) { return __uint_as_float((unsigned)v << 16); }
DI unsigned pk2(float lo, float hi) { typedef float f2 __attribute__((ext_vector_type(2))); typedef __bf16 b2 __attribute__((ext_vector_type(2))); f2 v = {lo, hi}; b2 b = __builtin_convertvector(v, b2); return __builtin_bit_cast(unsigned, b); }
DI float wave_sum(float v) {
#pragma unroll
    for (int o = 1; o < 64; o <<= 1) v += __shfl_xor(v, o);
    return v;
}
DI float fexp2(float x) { return __builtin_amdgcn_exp2f(x); }
DI float flog2(float x) { return __builtin_amdgcn_logf(x); }

DI void transpose_item(const float* W, int K, int ldn, int src_col0, bf16_t* WT, int dst_row0, int nblk, LAS float* scr, int item, int lane) {
    const int kb = item / nblk, nb = item % nblk, k0 = 64 * kb, n0 = 32 * nb;
#pragma unroll 8
    for (int i = 0; i < 32; ++i) { const int kk = 2 * i + (lane >> 5); scr[kk * 33 + (lane & 31)] = W[(size_t)(k0 + kk) * ldn + src_col0 + n0 + (lane & 31)]; }
    asm volatile("s_waitcnt lgkmcnt(0)" ::: "memory");
    const int c = lane & 7;
#pragma unroll
    for (int j = 0; j < 4; ++j) { const int n = (lane >> 3) + 8 * j; const LAS float* s = scr + (8 * c) * 33 + n;
        u32x4 o; o.x = pk2(s[0 * 33], s[1 * 33]); o.y = pk2(s[2 * 33], s[3 * 33]); o.z = pk2(s[4 * 33], s[5 * 33]); o.w = pk2(s[6 * 33], s[7 * 33]);
        *(u32x4*)(WT + (size_t)(dst_row0 + n0 + n) * K + k0 + 8 * c) = o; }
    asm volatile("s_waitcnt lgkmcnt(0)" ::: "memory");
}

template <bool FA> DI void norm_rows_bf16(const float* src, const float* gain, bf16_t* dst, int gw, int ngw, int lane, const LAS float* wfaT, const float* b_forget, float* logf_out) {
    f32x4 g[4];
#pragma unroll
    for (int j = 0; j < 4; ++j) g[j] = ((const f32x4*)gain)[64 * j + lane];
    for (int row = gw; row < MT; row += ngw) {
        const f32x4* xr = (const f32x4*)(src + (size_t)row * DM) + lane;
        f32x4 v[4]; float s = 0.f;
#pragma unroll
        for (int j = 0; j < 4; ++j) { v[j] = xr[64 * j]; s += (v[j].x * v[j].x + v[j].y * v[j].y) + (v[j].z * v[j].z + v[j].w * v[j].w); }
        const float rstd = 1.0f / sqrtf(wave_sum(s) * (1.f / DM) + EPS);
#pragma unroll
        for (int j = 0; j < 4; ++j) v[j] = v[j] * rstd * g[j];
        unsigned long long* o8 = (unsigned long long*)(dst + (size_t)row * DM) + lane;
#pragma unroll
        for (int j = 0; j < 4; ++j) o8[64 * j] = (unsigned long long)pk2(v[j].x, v[j].y) | ((unsigned long long)pk2(v[j].z, v[j].w) << 32);
        if (FA) {
            float mine = 0.f;
#pragma unroll
            for (int jj = 0; jj < 8; ++jj) { float a = 0.f;
#pragma unroll
                for (int j = 0; j < 4; ++j) { const f32x4 w = *(const LAS f32x4*)(wfaT + jj * 1024 + 256 * j + 4 * lane); a += (v[j].x * w.x + v[j].y * w.y) + (v[j].z * w.z + v[j].w * w.w); }
                a = wave_sum(a); if (lane == jj) mine = a; }
            if (lane < 8) { const float t = mine + b_forget[lane]; const float ls = fminf(t, 0.f) - log1pf(expf(-fabsf(t))); logf_out[(size_t)row * 8 + lane] = ls; }
        }
    }
}
DI void norm_rows_f32(float* buf, const float* gain, int gw, int ngw, int lane) {
    f32x4 g[4];
#pragma unroll
    for (int j = 0; j < 4; ++j) g[j] = ((const f32x4*)gain)[64 * j + lane];
    for (int row = gw; row < MT; row += ngw) {
        f32x4* xr = (f32x4*)(buf + (size_t)row * DM) + lane;
        f32x4 v[4]; float s = 0.f;
#pragma unroll
        for (int j = 0; j < 4; ++j) { v[j] = xr[64 * j]; s += (v[j].x * v[j].x + v[j].y * v[j].y) + (v[j].z * v[j].z + v[j].w * v[j].w); }
        const float rstd = 1.0f / sqrtf(wave_sum(s) * (1.f / DM) + EPS);
#pragma unroll
        for (int j = 0; j < 4; ++j) xr[64 * j] = v[j] * rstd * g[j];
    }
}

DI void sincos_d(double a, float& sn, float& cs) {
    const double n = rint(a * 0.63661977236758134308);
    const double r = fma(-n, 1.5707963267948966192, a) - n * 6.123233995736766e-17;
    const double r2 = r * r;
    double sp = -2.5052108385441718775e-8; sp = sp * r2 + 2.7557319223985890653e-6; sp = sp * r2 - 1.9841269841269841270e-4; sp = sp * r2 + 8.3333333333333333333e-3; sp = sp * r2 - 1.6666666666666666667e-1; sp = r + r * r2 * sp;
    double cp = 2.0876756987868098979e-9; cp = cp * r2 - 2.7557319223985890653e-7; cp = cp * r2 + 2.4801587301587301587e-5; cp = cp * r2 - 1.3888888888888888889e-3; cp = cp * r2 + 4.1666666666666666667e-2; cp = cp * r2 - 0.5; cp = 1.0 + r2 * cp;
    const int q = (int)((long long)n & 3);
    const double s_ = (q == 0) ? sp : (q == 1) ? cp : (q == 2) ? -sp : -cp;
    const double c_ = (q == 0) ? cp : (q == 1) ? -sp : (q == 2) ? -cp : sp;
    sn = (float)s_; cs = (float)c_;
}
DI float inv_freq_f(int i) {
    float r = 1.0f;
    r = (i == 1) ? 0.56234132519034908f : r;
    r = (i == 2) ? 0.31622776601683794f : r;
    r = (i == 3) ? 0.17782794100389228f : r;
    r = (i == 4) ? 0.1f : r;
    r = (i == 5) ? 0.056234132519034911f : r;
    r = (i == 6) ? 0.031622776601683791f : r;
    r = (i == 7) ? 0.017782794100389229f : r;
    r = (i == 8) ? 0.01f : r;
    r = (i == 9) ? 0.0056234132519034910f : r;
    r = (i == 10) ? 0.0031622776601683794f : r;
    r = (i == 11) ? 0.0017782794100389228f : r;
    r = (i == 12) ? 0.001f : r;
    r = (i == 13) ? 0.00056234132519034907f : r;
    r = (i == 14) ? 0.00031622776601683794f : r;
    r = (i == 15) ? 0.00017782794100389227f : r;
    return r;
}
DI void mla_prep_rows(const bf16_t* PC, const int* pos, const float* q_norm, const float* kv_norm, bf16_t* cqn, bf16_t* ckvn, float* tab, bf16_t* KR, int gw, int ngw, int lane) {
    for (int row = gw; row < MT; row += ngw) {
        const bf16_t* pr = PC + (size_t)row * LD_CD;
        {
            float v[8]; float s = 0.f;
            if (lane < 48) { const u32x4 w = *(const u32x4*)(pr + 1536 + 8 * lane);
#pragma unroll
                for (int e = 0; e < 4; ++e) { v[2 * e] = __uint_as_float(w[e] << 16); v[2 * e + 1] = __uint_as_float(w[e] & 0xffff0000u); s += v[2 * e] * v[2 * e] + v[2 * e + 1] * v[2 * e + 1]; } }
            else {
#pragma unroll
                for (int e = 0; e < 8; ++e) v[e] = 0.f; }
            const float rstd = 1.0f / sqrtf(wave_sum(s) * (1.f / 384.f) + EPS);
            if (lane < 48) { const f32x4 g0 = *(const f32x4*)(q_norm + 8 * lane), g1 = *(const f32x4*)(q_norm + 8 * lane + 4);
                u32x4 o; o.x = pk2(v[0] * rstd * g0.x, v[1] * rstd * g0.y); o.y = pk2(v[2] * rstd * g0.z, v[3] * rstd * g0.w); o.z = pk2(v[4] * rstd * g1.x, v[5] * rstd * g1.y); o.w = pk2(v[6] * rstd * g1.z, v[7] * rstd * g1.w);
                *(u32x4*)(cqn + (size_t)row * 384 + 8 * lane) = o; }
        }
        {
            float v[8]; float s = 0.f;
            if (lane < 32) { const u32x4 w = *(const u32x4*)(pr + 1920 + 8 * lane);
#pragma unroll
                for (int e = 0; e < 4; ++e) { v[2 * e] = __uint_as_float(w[e] << 16); v[2 * e + 1] = __uint_as_float(w[e] & 0xffff0000u); s += v[2 * e] * v[2 * e] + v[2 * e + 1] * v[2 * e + 1]; } }
            else {
#pragma unroll
                for (int e = 0; e < 8; ++e) v[e] = 0.f; }
            const float rstd = 1.0f / sqrtf(wave_sum(s) * (1.f / 256.f) + EPS);
            if (lane < 32) { const f32x4 g0 = *(const f32x4*)(kv_norm + 8 * lane), g1 = *(const f32x4*)(kv_norm + 8 * lane + 4);
                u32x4 o; o.x = pk2(v[0] * rstd * g0.x, v[1] * rstd * g0.y); o.y = pk2(v[2] * rstd * g0.z, v[3] * rstd * g0.w); o.z = pk2(v[4] * rstd * g1.x, v[5] * rstd * g1.y); o.w = pk2(v[6] * rstd * g1.z, v[7] * rstd * g1.w);
                *(u32x4*)(ckvn + (size_t)row * 256 + 8 * lane) = o; }
        }
        if (lane < 16) {
            const float ang = (float)pos[row] * inv_freq_f(lane);
            float sn, cs; sincos_d((double)ang, sn, cs);
            tab[(size_t)row * 32 + lane] = cs; tab[(size_t)row * 32 + 16 + lane] = sn;
            const float x1 = bf2f(pr[2176 + lane]), x2 = bf2f(pr[2176 + 16 + lane]);
            KR[(size_t)row * 32 + lane] = (bf16_t)(pk2(x1 * cs - x2 * sn, 0.f) & 0xffffu);
            KR[(size_t)row * 32 + 16 + lane] = (bf16_t)(pk2(x2 * cs + x1 * sn, 0.f) & 0xffffu);
        }
    }
}

namespace att {
constexpr int KBUF = 13312, VBUF = 9216;
constexpr int OFF_K = 0, OFF_V = 2 * KBUF, OFF_C = OFF_V + 2 * VBUF, OFF_RB = OFF_C + 512, OFF_FLAG = OFF_RB + 1280, ATT_LDS = OFF_FLAG + 64;
DI f32x16 mfma(bf16x8 a, bf16x8 b, f32x16 c) { return __builtin_amdgcn_mfma_f32_32x32x16_bf16(a, b, c, 0, 0, 0); }
DI int crow(int i, int hh) { return (i & 3) + 8 * (i >> 2) + 4 * hh; }
DI bf16x8 packfrag(const f32x16& p, int s) { u32x4 w; w.x = pk2(p[8 * s], p[8 * s + 1]); w.y = pk2(p[8 * s + 2], p[8 * s + 3]); w.z = pk2(p[8 * s + 4], p[8 * s + 5]); w.w = pk2(p[8 * s + 6], p[8 * s + 7]); return __builtin_bit_cast(bf16x8, w); }
typedef short v4i16_t __attribute__((ext_vector_type(4)));
DI s16x4 vtr(const LAS unsigned char* p) { return __builtin_bit_cast(s16x4, __builtin_amdgcn_ds_read_tr16_b64_v4i16((LAS v4i16_t*)p)); }

struct Lane { int tid, lane, wid, r, hh, q4, p4, blk, srow, sch; };
DI Lane mklane() { Lane L; L.tid = threadIdx.x; L.lane = L.tid & 63; L.wid = __builtin_amdgcn_readfirstlane(L.tid >> 6); L.r = L.lane & 31; L.hh = L.lane >> 5;
    const int i16 = L.lane & 15; L.q4 = i16 >> 2; L.p4 = i16 & 3; L.blk = (L.lane >> 4) & 1; L.srow = L.tid >> 3; L.sch = L.tid & 7; return L; }

template <int NDS, int KSTRIDE> DI void qk_tile(f32x16& p0, f32x16& p1, const LAS unsigned char* Kb, const bf16x8* qf, const Lane& L) {
    const LAS unsigned char* ka = Kb + L.r * KSTRIDE + L.hh * 16;
#pragma unroll
    for (int i = 0; i < 16; ++i) { p0[i] = 0.f; p1[i] = 0.f; }
#pragma unroll
    for (int ds = 0; ds < NDS; ++ds) {
        const bf16x8 a0 = *(const LAS bf16x8*)(ka + ds * 32), a1 = *(const LAS bf16x8*)(ka + 32 * KSTRIDE + ds * 32);
        p0 = mfma(a0, qf[ds], p0); p1 = mfma(a1, qf[ds], p1); }
}
DI void pv_tile(f32x16& o0, f32x16& o1, const LAS unsigned char* Vb, const bf16x8 (&pf)[4], const Lane& L) {
    const LAS unsigned char* vb = Vb + (4 * L.hh + L.q4) * 144 + (16 * L.blk + 4 * L.p4) * 2;
#pragma unroll
    for (int f = 0; f < 4; ++f) { const LAS unsigned char* base = vb + (16 * f) * 144;
        { const s16x4 lo = vtr(base), hi = vtr(base + 8 * 144); const bf16x8 vf = __builtin_shufflevector(lo, hi, 0, 1, 2, 3, 4, 5, 6, 7); o0 = mfma(vf, pf[f], o0); }
        { const s16x4 lo = vtr(base + 64), hi = vtr(base + 8 * 144 + 64); const bf16x8 vf = __builtin_shufflevector(lo, hi, 0, 1, 2, 3, 4, 5, 6, 7); o1 = mfma(vf, pf[f], o1); } }
}
DI void online_softmax(f32x16& p0, f32x16& p1, float& m, float& l, f32x16& o0, f32x16& o1, bf16x8 (&pf)[4]) {
    float mt = fmaxf(p0[0], p1[0]);
#pragma unroll
    for (int i = 1; i < 16; ++i) mt = fmaxf(mt, fmaxf(p0[i], p1[i]));
    mt = fmaxf(mt, __shfl_xor(mt, 32));
    const float mn = fmaxf(m, mt), alpha = fexp2(m - mn); m = mn;
    float rs = 0.f;
#pragma unroll
    for (int i = 0; i < 16; ++i) { p0[i] = fexp2(p0[i] - mn); p1[i] = fexp2(p1[i] - mn); rs += p0[i] + p1[i]; }
    l = l * alpha + rs;
#pragma unroll
    for (int i = 0; i < 16; ++i) { o0[i] *= alpha; o1[i] *= alpha; }
    pf[0] = packfrag(p0, 0); pf[1] = packfrag(p0, 1); pf[2] = packfrag(p1, 0); pf[3] = packfrag(p1, 1);
}
DI void store_o(bf16_t* orow, const f32x16& o0, const f32x16& o1, float inv, int hh) {
#pragma unroll
    for (int g = 0; g < 4; ++g) {
        u32x2 w0, w1; w0.x = pk2(o0[4 * g] * inv, o0[4 * g + 1] * inv); w0.y = pk2(o0[4 * g + 2] * inv, o0[4 * g + 3] * inv);
        w1.x = pk2(o1[4 * g] * inv, o1[4 * g + 1] * inv); w1.y = pk2(o1[4 * g + 2] * inv, o1[4 * g + 3] * inv);
        *(u32x2*)(orow + 8 * g + 4 * hh) = w0; *(u32x2*)(orow + 32 + 8 * g + 4 * hh) = w1; }
}

DI void fox_unit(LAS unsigned char* lds, const bf16_t* PA, const float* cum, bf16_t* O, int b, int h, int qb) {
    const Lane L = mklane();
    const size_t rowbase = (size_t)b * SEQ;
    const int q0 = qb * 256, q0w = q0 + L.wid * 32, myq = q0w + L.r;
    const bf16_t* Qp = PA + (rowbase + myq) * LD_AB + h * 64;
    const bf16_t* Kp = PA + rowbase * LD_AB + 512 + h * 64;
    const bf16_t* Vp = Kp + 512;
    const float* cumh = cum + (size_t)(b * 8 + h) * SEQ;
    bf16x8 qf[4];
#pragma unroll
    for (int ds = 0; ds < 4; ++ds) qf[ds] = *(const bf16x8*)(Qp + 16 * ds + 8 * L.hh);
    const float cq2 = cumh[myq] * LOG2E, c1 = 0.125f * LOG2E;
    const int NT = (q0 + 256) / 64;
    float m = -INFINITY, l = 0.f; f32x16 o0, o1;
#pragma unroll
    for (int i = 0; i < 16; ++i) { o0[i] = 0.f; o1[i] = 0.f; }
    u32x4 kreg, vreg; float creg = 0.f;
#define FOX_LOAD(t) do { kreg = *(const u32x4*)(Kp + (size_t)((t) * 64 + L.srow) * LD_AB + L.sch * 8); vreg = *(const u32x4*)(Vp + (size_t)((t) * 64 + L.srow) * LD_AB + L.sch * 8); \
        if (L.tid < 64) creg = cumh[(t) * 64 + L.tid] * (-LOG2E); } while (0)
#define FOX_WRITE(bf) do { *(LAS u32x4*)(lds + OFF_K + (bf) * KBUF + L.srow * 144 + L.sch * 16) = kreg; *(LAS u32x4*)(lds + OFF_V + (bf) * VBUF + L.srow * 144 + L.sch * 16) = vreg; \
        if (L.tid < 64) *(LAS float*)(lds + OFF_C + (bf) * 256 + L.tid * 4) = creg; } while (0)
    FOX_LOAD(0); FOX_WRITE(0); __syncthreads();
    for (int t = 0; t < NT; ++t) {
        if (t + 1 < NT) FOX_LOAD(t + 1);
        const int k0 = t * 64, bf = t & 1;
        if (k0 <= q0w + 31) {
            f32x16 p0, p1;
            qk_tile<4, 144>(p0, p1, lds + OFF_K + bf * KBUF, qf, L);
            const LAS unsigned char* Cb = lds + OFF_C + bf * 256;
#pragma unroll
            for (int g = 0; g < 4; ++g) { const f32x4 ca = *(const LAS f32x4*)(Cb + (8 * g + 4 * L.hh) * 4), cb = *(const LAS f32x4*)(Cb + (32 + 8 * g + 4 * L.hh) * 4);
#pragma unroll
                for (int e = 0; e < 4; ++e) { p0[4 * g + e] = fmaf(p0[4 * g + e], c1, cq2 + ca[e]); p1[4 * g + e] = fmaf(p1[4 * g + e], c1, cq2 + cb[e]); } }
            if (k0 + 63 > q0w) {
#pragma unroll
                for (int i = 0; i < 16; ++i) { const int key = k0 + crow(i, L.hh); if (key > myq) p0[i] = -INFINITY; if (key + 32 > myq) p1[i] = -INFINITY; } }
            bf16x8 pf[4];
            online_softmax(p0, p1, m, l, o0, o1, pf);
            pv_tile(o0, o1, lds + OFF_V + bf * VBUF, pf, L);
        }
        if (t + 1 < NT) FOX_WRITE((t + 1) & 1);
        __syncthreads();
    }
#undef FOX_LOAD
#undef FOX_WRITE
    const float lt = l + __shfl_xor(l, 32);
    store_o(O + (rowbase + myq) * DM + h * 64, o0, o1, 1.0f / lt, L.hh);
}

DI void chk_unit(LAS unsigned char* lds, const bf16_t* PA, const float* rel_bias, bf16_t* O, int b, int h, int g4) {
    const Lane L = mklane();
    const size_t rowbase = (size_t)b * SEQ;
    const int cw = 4 * g4 + (L.wid >> 1), myq = 64 * cw + 32 * (L.wid & 1) + L.r;
    const bf16_t* Qp = PA + (rowbase + myq) * LD_AB + 1536 + h * 64;
    const bf16_t* Kp = PA + rowbase * LD_AB + 2048 + h * 64;
    const bf16_t* Vp = Kp + 512;
    bf16x8 qf[4];
#pragma unroll
    for (int ds = 0; ds < 4; ++ds) qf[ds] = *(const bf16x8*)(Qp + 16 * ds + 8 * L.hh);
    const float c1 = 0.125f * LOG2E;
    const int c_lo = (4 * g4 - 8) > 0 ? (4 * g4 - 8) : 0, NT = 4 * g4 + 4 - c_lo;
    LAS float* rb = (LAS float*)(lds + OFF_RB);
    if (L.tid < 320) rb[L.tid] = rel_bias[h * 320 + L.tid] * LOG2E;
    float m = -INFINITY, l = 0.f; f32x16 o0, o1;
#pragma unroll
    for (int i = 0; i < 16; ++i) { o0[i] = 0.f; o1[i] = 0.f; }
    u32x4 kreg, vreg;
#define CHK_LOAD(t) do { kreg = *(const u32x4*)(Kp + (size_t)((c_lo + (t)) * 64 + L.srow) * LD_AB + L.sch * 8); vreg = *(const u32x4*)(Vp + (size_t)((c_lo + (t)) * 64 + L.srow) * LD_AB + L.sch * 8); } while (0)
#define CHK_WRITE(bf) do { *(LAS u32x4*)(lds + OFF_K + (bf) * KBUF + L.srow * 144 + L.sch * 16) = kreg; *(LAS u32x4*)(lds + OFF_V + (bf) * VBUF + L.srow * 144 + L.sch * 16) = vreg; } while (0)
    CHK_LOAD(0); CHK_WRITE(0); __syncthreads();
    for (int t = 0; t < NT; ++t) {
        if (t + 1 < NT) CHK_LOAD(t + 1);
        const int kc = c_lo + t, bf = t & 1;
        if (kc >= cw - 8 && kc <= cw) {
            f32x16 p0, p1;
            qk_tile<4, 144>(p0, p1, lds + OFF_K + bf * KBUF, qf, L);
            if (cw - kc >= 5) { const float bb = rb[319];
#pragma unroll
                for (int i = 0; i < 16; ++i) { p0[i] = fmaf(p0[i], c1, bb); p1[i] = fmaf(p1[i], c1, bb); } }
            else {
#pragma unroll
                for (int i = 0; i < 16; ++i) { const int rel = myq - (64 * kc + crow(i, L.hh));
                    const int i0 = (rel < 256 ? rel : 256) + 63, i1 = (rel - 32 < 256 ? rel - 32 : 256) + 63;
                    p0[i] = fmaf(p0[i], c1, rb[i0]); p1[i] = fmaf(p1[i], c1, rb[i1]); } }
            bf16x8 pf[4];
            online_softmax(p0, p1, m, l, o0, o1, pf);
            pv_tile(o0, o1, lds + OFF_V + bf * VBUF, pf, L);
        }
        if (t + 1 < NT) CHK_WRITE((t + 1) & 1);
        __syncthreads();
    }
#undef CHK_LOAD
#undef CHK_WRITE
    const float lt = l + __shfl_xor(l, 32);
    store_o(O + (rowbase + myq) * DM + 512 + h * 64, o0, o1, 1.0f / lt, L.hh);
}

DI void mla_unit(LAS unsigned char* lds, const bf16_t* QF, const bf16_t* KVF, const bf16_t* KR, bf16_t* O, int b, int h, int qb) {
    const Lane L = mklane();
    const size_t rowbase = (size_t)b * SEQ;
    const int cw = 4 * qb + (L.wid >> 1), myq = 64 * cw + 32 * (L.wid & 1) + L.r;
    const bf16_t* Qp = QF + (rowbase + myq) * 768 + h * 96;
    const bf16_t* Kp = KVF + rowbase * 1024 + h * 128;
    const bf16_t* Vp = Kp + 64;
    const bf16_t* Rp = KR + rowbase * 32;
    bf16x8 qf[6];
#pragma unroll
    for (int ds = 0; ds < 6; ++ds) qf[ds] = *(const bf16x8*)(Qp + 16 * ds + 8 * L.hh);
    const float c1 = 0.10206207261596577f * LOG2E;
    const int NT = 4 * qb + 4;
    float m = -INFINITY, l = 0.f; f32x16 o0, o1;
#pragma unroll
    for (int i = 0; i < 16; ++i) { o0[i] = 0.f; o1[i] = 0.f; }
    u32x4 kreg, vreg, rreg;
#define MLA_LOAD(t) do { kreg = *(const u32x4*)(Kp + (size_t)((t) * 64 + L.srow) * 1024 + L.sch * 8); vreg = *(const u32x4*)(Vp + (size_t)((t) * 64 + L.srow) * 1024 + L.sch * 8); \
        if (L.tid < 256) rreg = *(const u32x4*)(Rp + (size_t)((t) * 64 + (L.tid >> 2)) * 32 + (L.tid & 3) * 8); } while (0)
#define MLA_WRITE(bf) do { *(LAS u32x4*)(lds + OFF_K + (bf) * KBUF + L.srow * 208 + L.sch * 16) = kreg; *(LAS u32x4*)(lds + OFF_V + (bf) * VBUF + L.srow * 144 + L.sch * 16) = vreg; \
        if (L.tid < 256) *(LAS u32x4*)(lds + OFF_K + (bf) * KBUF + (L.tid >> 2) * 208 + 128 + (L.tid & 3) * 16) = rreg; } while (0)
    MLA_LOAD(0); MLA_WRITE(0); __syncthreads();
    for (int t = 0; t < NT; ++t) {
        if (t + 1 < NT) MLA_LOAD(t + 1);
        const int bf = t & 1;
        if (t <= cw) {
            f32x16 p0, p1;
            qk_tile<6, 208>(p0, p1, lds + OFF_K + bf * KBUF, qf, L);
#pragma unroll
            for (int i = 0; i < 16; ++i) { p0[i] *= c1; p1[i] *= c1; }
            bf16x8 pf[4];
            online_softmax(p0, p1, m, l, o0, o1, pf);
            pv_tile(o0, o1, lds + OFF_V + bf * VBUF, pf, L);
        }
        if (t + 1 < NT) MLA_WRITE((t + 1) & 1);
        __syncthreads();
    }
#undef MLA_LOAD
#undef MLA_WRITE
    const float lt = l + __shfl_xor(l, 32);
    store_o(O + (rowbase + myq) * DM + 512 + h * 64, o0, o1, 1.0f / lt, L.hh);
}

DI void sb_sub(f32x16& p, float& R, int keybase, int myq, int hh, bool need_mask) {
    float lk[16], lb[16];
#pragma unroll
    for (int i = 0; i < 16; ++i) {
        const float z = p[i] * 0.125f, u = fexp2(-fabsf(z) * LOG2E), sp = fmaxf(z, 0.f) + flog2(1.0f + u) * LN2;
        const bool valid = !need_mask || (keybase + crow(i, hh)) < myq;
        lk[i] = valid ? -sp : 0.f; lb[i] = valid ? (z - sp) : -INFINITY; }
    float G[4], Gp[4];
#pragma unroll
    for (int g = 0; g < 4; ++g) { G[g] = (lk[4 * g] + lk[4 * g + 1]) + (lk[4 * g + 2] + lk[4 * g + 3]); Gp[g] = __shfl_xor(G[g], 32); }
    float acc = R;
#pragma unroll
    for (int g = 3; g >= 0; --g) {
        const float s3 = hh ? acc : acc + Gp[g];
        acc += G[g] + Gp[g];
        const float s2 = s3 + lk[4 * g + 3], s1 = s2 + lk[4 * g + 2], s0 = s1 + lk[4 * g + 1];
        p[4 * g + 3] = fexp2((lb[4 * g + 3] + s3) * LOG2E); p[4 * g + 2] = fexp2((lb[4 * g + 2] + s2) * LOG2E);
        p[4 * g + 1] = fexp2((lb[4 * g + 1] + s1) * LOG2E); p[4 * g] = fexp2((lb[4 * g] + s0) * LOG2E); }
    R = acc;
}
DI void sb_unit(LAS unsigned char* lds, const bf16_t* PC, bf16_t* O, int b, int h, int qb) {
    const Lane L = mklane();
    const size_t rowbase = (size_t)b * SEQ;
    const int q0 = qb * 256, q0w = q0 + L.wid * 32, myq = q0w + L.r;
    const bf16_t* Qp = PC + (rowbase + myq) * LD_CD + h * 64;
    const bf16_t* Kp = PC + rowbase * LD_CD + 512 + h * 64;
    const bf16_t* Vp = Kp + 512;
    bf16x8 qf[4];
#pragma unroll
    for (int ds = 0; ds < 4; ++ds) qf[ds] = *(const bf16x8*)(Qp + 16 * ds + 8 * L.hh);
    const int NT = (q0 + 256) / 64;
    float R = 0.f; f32x16 o0, o1;
#pragma unroll
    for (int i = 0; i < 16; ++i) { o0[i] = 0.f; o1[i] = 0.f; }
    bool seen = false;
    LAS int* flags = (LAS int*)(lds + OFF_FLAG);
    u32x4 kreg, vreg;
#define SB_LOAD(t) do { kreg = *(const u32x4*)(Kp + (size_t)((t) * 64 + L.srow) * LD_CD + L.sch * 8); vreg = *(const u32x4*)(Vp + (size_t)((t) * 64 + L.srow) * LD_CD + L.sch * 8); } while (0)
#define SB_WRITE(bf) do { *(LAS u32x4*)(lds + OFF_K + (bf) * KBUF + L.srow * 144 + L.sch * 16) = kreg; *(LAS u32x4*)(lds + OFF_V + (bf) * VBUF + L.srow * 144 + L.sch * 16) = vreg; } while (0)
    SB_LOAD(NT - 1); SB_WRITE(0); __syncthreads();
    for (int it = 0; it < NT; ++it) {
        const int t = NT - 1 - it, k0 = t * 64, bf = it & 1;
        if (t > 0) SB_LOAD(t - 1);
        bool done = false;
        if (k0 <= q0w + 31) {
            done = seen && __all(R < -110.0f);
            if (!done) {
                f32x16 p0, p1;
                qk_tile<4, 144>(p0, p1, lds + OFF_K + bf * KBUF, qf, L);
                const bool nm = (k0 + 63 >= q0w);
                sb_sub(p1, R, k0 + 32, myq, L.hh, nm);
                sb_sub(p0, R, k0, myq, L.hh, nm);
                bf16x8 pf[4];
                pf[0] = packfrag(p0, 0); pf[1] = packfrag(p0, 1); pf[2] = packfrag(p1, 0); pf[3] = packfrag(p1, 1);
                pv_tile(o0, o1, lds + OFF_V + bf * VBUF, pf, L);
                seen = true;
                done = __all(R < -110.0f);
            }
        }
        if (L.lane == 0) flags[(it & 1) * 8 + L.wid] = done ? 1 : 0;
        if (t > 0) SB_WRITE((it + 1) & 1);
        __syncthreads();
        int alld = 1;
#pragma unroll
        for (int w = 0; w < 8; ++w) alld &= flags[(it & 1) * 8 + w];
        if (alld) break;
    }
#undef SB_LOAD
#undef SB_WRITE
    store_o(O + (rowbase + myq) * DM + h * 64, o0, o1, 1.0f, L.hh);
    __syncthreads();
}
}

struct Params {
    const float* x; const int* pos; const float* norm_mix; const float* norm_mlp; const float* norm_final;
    const float* w_in_ab; const float* b_forget; const float* rel_bias; const float* w_out_ab;
    const float* w_in_cd; const float* q_norm; const float* kv_norm; const float* w_uq; const float* w_ukv; const float* w_out_cd;
    const float* w_up; const float* w_down;
    float* out; unsigned char* ws; int ph_lo, ph_hi, coop, pad;
};
constexpr int N_PHASES = 17;

__global__ void __launch_bounds__(NTHREADS) fwd_kernel(Params P) {
    extern __shared__ __attribute__((aligned(16))) unsigned char lds_raw[];
    LAS unsigned char* lds = (LAS unsigned char*)lds_raw;
    const int tid = threadIdx.x, lane = tid & 63, wave = __builtin_amdgcn_readfirstlane(tid >> 6);
    const int G = gridDim.x, bx = blockIdx.x;
    const int vcu = (G % 8 == 0) ? (bx % 8) * (G / 8) + bx / 8 : bx;
    const int gw = vcu * NWAVES + wave, ngw = G * NWAVES;
    unsigned char* ws = P.ws;
    bf16_t* WinAB = (bf16_t*)(ws + WS_WINAB); bf16_t* WoutAB = (bf16_t*)(ws + WS_WOUTAB); bf16_t* WinCD = (bf16_t*)(ws + WS_WINCD);
    bf16_t* Wuq = (bf16_t*)(ws + WS_WUQ); bf16_t* Wukv = (bf16_t*)(ws + WS_WUKV); bf16_t* WoutCD = (bf16_t*)(ws + WS_WOUTCD);
    bf16_t* Wup0 = (bf16_t*)(ws + WS_WUP0); bf16_t* Wup1 = (bf16_t*)(ws + WS_WUP1); bf16_t* Wdn0 = (bf16_t*)(ws + WS_WDN0); bf16_t* Wdn1 = (bf16_t*)(ws + WS_WDN1);
    float* LOGF = (float*)(ws + WS_LOGF); float* CUM = (float*)(ws + WS_CUM); float* TAB = (float*)(ws + WS_TAB); bf16_t* KR = (bf16_t*)(ws + WS_KR);
    bf16_t* XN = (bf16_t*)(ws + WS_XN); bf16_t* CQN = (bf16_t*)(ws + WS_CQN); bf16_t* CKVN = (bf16_t*)(ws + WS_CKVN); bf16_t* OB = (bf16_t*)(ws + WS_O);
    bf16_t* BIG = (bf16_t*)(ws + WS_BIG); bf16_t* QF = (bf16_t*)(ws + WS_QF); bf16_t* KVF = (bf16_t*)(ws + WS_KVF);
    cg::grid_group grid = cg::this_grid();
    const int lo = P.ph_lo, hi = P.ph_hi;
#ifndef PHMASK
#define PHMASK 0x1ffff
#endif
#define IN(k) (((PHMASK >> (k)) & 1) && lo <= (k) && (k) < hi)
#define SEAM(k) do { if (P.coop && (k) + 1 < hi) grid.sync(); } while (0)

    if (IN(0)) {
        LAS float* scr = (LAS float*)(lds + wave * 8704);
        for (int it = gw; ; it += ngw) {
            int r = it; bool hit = false;
#define TR(W, K, LDN, C0, NC, WT, R0) if (!hit) { const int n_it = ((K) / 64) * ((NC) / 32); if (r < n_it) { transpose_item((W), (K), (LDN), (C0), (WT), (R0), (NC) / 32, scr, r, lane); hit = true; } else r -= n_it; }
            TR(P.w_in_ab, 1024, NSRC_AB, 0, 1536, WinAB, 0)
            TR(P.w_in_ab, 1024, NSRC_AB, 1544, 1536, WinAB, 1536)
            TR(P.w_out_ab, 1024, 1024, 0, 1024, WoutAB, 0)
            TR(P.w_in_cd, 1024, NSRC_CD, 0, NSRC_CD, WinCD, 0)
            TR(P.w_uq, 384, 768, 0, 768, Wuq, 0)
            TR(P.w_ukv, 256, 1024, 0, 1024, Wukv, 0)
            TR(P.w_out_cd, 1024, 1024, 0, 1024, WoutCD, 0)
            TR(P.w_up, 1024, 4096, 0, 4096, Wup0, 0)
            TR(P.w_up + (size_t)1024 * 4096, 1024, 4096, 0, 4096, Wup1, 0)
            TR(P.w_down, 4096, 1024, 0, 1024, Wdn0, 0)
            TR(P.w_down + (size_t)4096 * 1024, 4096, 1024, 0, 1024, Wdn1, 0)
#undef TR
            if (!hit) break;
        }
        for (int i = (vcu * NTHREADS + tid); i < 96 * 1024 / 8; i += G * NTHREADS) ((u32x4*)(WinCD + (size_t)2208 * 1024))[i] = (u32x4){0u, 0u, 0u, 0u};
        __syncthreads();
        LAS float* wfaT = (LAS float*)lds;
        for (int i = tid; i < 8192; i += NTHREADS) { const int k = i >> 3, j = i & 7; wfaT[j * 1024 + k] = P.w_in_ab[(size_t)k * NSRC_AB + 1536 + j]; }
        __syncthreads();
        norm_rows_bf16<true>(P.x, P.norm_mix, XN, gw, ngw, lane, wfaT, P.b_forget, LOGF);
        __syncthreads();
        SEAM(0);
    }
    if (IN(1)) {
        if (vcu < 32) {
            const int b = vcu >> 3, h = vcu & 7; LAS float* sc = (LAS float*)lds;
            float v[8]; float run = 0.f;
#pragma unroll
            for (int e = 0; e < 8; ++e) { run += LOGF[((size_t)b * SEQ + tid * 8 + e) * 8 + h]; v[e] = run; }
            sc[tid] = run; __syncthreads();
            for (int off = 1; off < NTHREADS; off <<= 1) { const float add = (tid >= off) ? sc[tid - off] : 0.f; __syncthreads(); sc[tid] += add; __syncthreads(); }
            const float base = sc[tid] - run;
#pragma unroll
            for (int e = 0; e < 8; ++e) CUM[(size_t)(b * 8 + h) * SEQ + tid * 8 + e] = base + v[e];
            __syncthreads();
        }
        pg8::Gemm g{XN, WinAB, MT, LD_AB, DM}; pg8::StaticOrder S; S.init(MT, LD_AB, G, bx);
        pg8::EpiStore<0> E{BIG, LD_AB};
        pg8::gemm_phase<pg8::EpiStore<0>, pg8::StaticOrder, true, true>(lds, g, S, E);
        SEAM(1);
    }
    if (IN(2)) {
        const int bh = vcu >> 3, s = vcu & 7, b = bh >> 3, h = bh & 7;
        if (vcu < 256) {
            att::fox_unit(lds, BIG, CUM, OB, b, h, 15 - s);
            att::fox_unit(lds, BIG, CUM, OB, b, h, s);
            att::chk_unit(lds, BIG, P.rel_bias, OB, b, h, 2 * s);
            att::chk_unit(lds, BIG, P.rel_bias, OB, b, h, 2 * s + 1);
        }
        SEAM(2);
    }
    if (IN(3)) {
        pg8::Gemm g{OB, WoutAB, MT, DM, DM}; pg8::StaticOrder S; S.init(MT, DM, G, bx);
        pg8::EpiResid E{P.x, P.out, DM};
        pg8::gemm_phase<pg8::EpiResid, pg8::StaticOrder, true, true>(lds, g, S, E);
        SEAM(3);
    }
    if (IN(4)) { norm_rows_bf16<false>(P.out, P.norm_mlp, XN, gw, ngw, lane, nullptr, nullptr, nullptr); SEAM(4); }
    if (IN(5)) {
        pg8::Gemm g{XN, Wup0, MT, DFF, DM}; pg8::StaticOrder S; S.init(MT, DFF, G, bx);
        pg8::EpiStore<1> E{BIG, DFF};
        pg8::gemm_phase<pg8::EpiStore<1>, pg8::StaticOrder, true, true>(lds, g, S, E);
        SEAM(5);
    }
    if (IN(6)) {
        pg8::Gemm g{BIG, Wdn0, MT, DM, DFF}; pg8::StaticOrder S; S.init(MT, DM, G, bx);
        pg8::EpiResid E{P.out, P.out, DM};
        pg8::gemm_phase<pg8::EpiResid, pg8::StaticOrder, true, true>(lds, g, S, E);
        SEAM(6);
    }
    if (IN(7)) { norm_rows_bf16<false>(P.out, P.norm_mix + DM, XN, gw, ngw, lane, nullptr, nullptr, nullptr); SEAM(7); }
    if (IN(8)) {
        pg8::Gemm g{XN, WinCD, MT, LD_CD, DM}; pg8::StaticOrder S; S.init(MT, LD_CD, G, bx);
        pg8::EpiStore<0> E{BIG, LD_CD};
        pg8::gemm_phase<pg8::EpiStore<0>, pg8::StaticOrder, true, true>(lds, g, S, E);
        SEAM(8);
    }
    if (IN(9)) { mla_prep_rows(BIG, P.pos, P.q_norm, P.kv_norm, CQN, CKVN, TAB, KR, gw, ngw, lane); SEAM(9); }
    if (IN(10)) {
#ifndef P10SEL
#define P10SEL 3
#endif
        if (P10SEL & 1) { pg8::Gemm g{CQN, Wuq, MT, 768, 384 + P.pad};     pg8::StaticOrder S; S.init(MT, 768, G, bx);
          pg8::EpiQRope E{QF, 768, TAB};
          pg8::gemm_phase<pg8::EpiQRope, pg8::StaticOrder, true, true>(lds, g, S, E); }
        if (P10SEL & 2) { pg8::Gemm g{CKVN, Wukv, MT, 1024, 256 + P.pad}; pg8::StaticOrder S; S.init(MT, 1024, G, bx);
          pg8::EpiStore<0> E{KVF, 1024};
          pg8::gemm_phase<pg8::EpiStore<0>, pg8::StaticOrder, true, true>(lds, g, S, E); }
        SEAM(10);
    }
    if (IN(11)) {
        const int bh = vcu >> 3, s = vcu & 7, b = bh >> 3, h = bh & 7;
        if (vcu < 256) {
            att::mla_unit(lds, QF, KVF, KR, OB, b, h, 15 - s);
            att::mla_unit(lds, QF, KVF, KR, OB, b, h, s);
            att::sb_unit(lds, BIG, OB, b, h, 15 - s);
            att::sb_unit(lds, BIG, OB, b, h, s);
        }
        SEAM(11);
    }
    if (IN(12)) {
        pg8::Gemm g{OB, WoutCD, MT, DM, DM}; pg8::StaticOrder S; S.init(MT, DM, G, bx);
        pg8::EpiResid E{P.out, P.out, DM};
        pg8::gemm_phase<pg8::EpiResid, pg8::StaticOrder, true, true>(lds, g, S, E);
        SEAM(12);
    }
    if (IN(13)) { norm_rows_bf16<false>(P.out, P.norm_mlp + DM, XN, gw, ngw, lane, nullptr, nullptr, nullptr); SEAM(13); }
    if (IN(14)) {
        pg8::Gemm g{XN, Wup1, MT, DFF, DM}; pg8::StaticOrder S; S.init(MT, DFF, G, bx);
        pg8::EpiStore<1> E{BIG, DFF};
        pg8::gemm_phase<pg8::EpiStore<1>, pg8::StaticOrder, true, true>(lds, g, S, E);
        SEAM(14);
    }
    if (IN(15)) {
        pg8::Gemm g{BIG, Wdn1, MT, DM, DFF}; pg8::StaticOrder S; S.init(MT, DM, G, bx);
        pg8::EpiResid E{P.out, P.out, DM};
        pg8::gemm_phase<pg8::EpiResid, pg8::StaticOrder, true, true>(lds, g, S, E);
        SEAM(15);
    }
    if (IN(16)) { norm_rows_f32(P.out, P.norm_final, gw, ngw, lane); }
#undef IN
#undef SEAM
}

#ifndef MK_MULTI_LAUNCH
#define MK_MULTI_LAUNCH 0
#endif
extern "C" void kernel_launch(void* const* d_in, const int* in_sizes, int n_in, void* d_out, int out_size, void* d_ws, size_t ws_size, hipStream_t stream) {
    static int grid = 0;
    if (grid == 0) {
        if (n_in != 17 || out_size != MT * DM || ws_size < WS_END) { fprintf(stderr, "kernel_launch: unexpected problem (n_in %d out %d ws %zu)\n", n_in, out_size, ws_size); grid = -1; return; }
        int dev = 0, cus = 0, per_cu = 0;
        hipGetDevice(&dev); hipDeviceGetAttribute(&cus, hipDeviceAttributeMultiprocessorCount, dev);
        if (hipFuncSetAttribute((const void*)fwd_kernel, hipFuncAttributeMaxDynamicSharedMemorySize, LDS_BYTES) != hipSuccess) { fprintf(stderr, "kernel_launch: hipFuncSetAttribute failed\n"); grid = -1; return; }
        if (hipOccupancyMaxActiveBlocksPerMultiprocessor(&per_cu, (const void*)fwd_kernel, NTHREADS, LDS_BYTES) != hipSuccess || per_cu < 1) { fprintf(stderr, "kernel_launch: occupancy query says %d\n", per_cu); per_cu = 1; }
        (void)hipGetLastError();
        grid = cus;
        if (grid != 256) fprintf(stderr, "kernel_launch: note: %d CUs\n", grid);
    }
    if (grid < 0) return;
    Params p{};
    p.x = (const float*)d_in[0]; p.pos = (const int*)d_in[1]; p.norm_mix = (const float*)d_in[2]; p.norm_mlp = (const float*)d_in[3]; p.norm_final = (const float*)d_in[4];
    p.w_in_ab = (const float*)d_in[5]; p.b_forget = (const float*)d_in[6]; p.rel_bias = (const float*)d_in[7]; p.w_out_ab = (const float*)d_in[8];
    p.w_in_cd = (const float*)d_in[9]; p.q_norm = (const float*)d_in[10]; p.kv_norm = (const float*)d_in[11]; p.w_uq = (const float*)d_in[12]; p.w_ukv = (const float*)d_in[13]; p.w_out_cd = (const float*)d_in[14];
    p.w_up = (const float*)d_in[15]; p.w_down = (const float*)d_in[16];
    p.out = (float*)d_out; p.ws = (unsigned char*)d_ws;
#if MK_MULTI_LAUNCH
    for (int ph = 0; ph < N_PHASES; ++ph) {
        p.ph_lo = ph; p.ph_hi = ph + 1; p.coop = 0;
        hipLaunchKernelGGL(fwd_kernel, dim3(grid), dim3(NTHREADS), LDS_BYTES, stream, p);
    }
#else
    p.ph_lo = 0; p.ph_hi = N_PHASES; p.coop = 1;
    void* args[] = {&p};
    hipError_t e = hipLaunchCooperativeKernel((const void*)fwd_kernel, dim3(grid), dim3(NTHREADS), args, LDS_BYTES, stream);
    if (e != hipSuccess) fprintf(stderr, "cooperative launch failed: %s (grid %d)\n", hipGetErrorString(e), grid);
#endif
}
```

```cpp
#include <hip/hip_runtime.h>
#include <hip/hip_cooperative_groups.h>
#include <cstdio>
#include <cstdint>
#include <cmath>
namespace cg = cooperative_groups;
namespace pg8 {
#define PG8_LAS __attribute__((address_space(3)))
typedef unsigned short bf16_t;
typedef short bf16x8 __attribute__((ext_vector_type(8)));
typedef float f32x4 __attribute__((ext_vector_type(4)));
typedef unsigned u32x4 __attribute__((ext_vector_type(4)));
constexpr int BM = 256, BK = 64, HALF = 128, HTB = HALF * BK * 2  , STAGE_BYTES = 8 * HTB, NXCD = 8, WGM = 8;

__host__ __device__ __forceinline__ int lds_byte(int r, int c) { const int st = (r >> 4) * 2 + (c >> 5), rr = r & 15, cc = c & 31, ob = rr * 64 + cc * 2; return st * 1024 + (ob ^ (((ob >> 9) & 1) << 5)); }
__host__ __device__ __forceinline__ void stage_rc(int b, int& R, int& C) { const int st = b / 1024, sb = b % 1024, swz = sb ^ (((sb >> 9) & 1) << 5); R = (st >> 1) * 16 + swz / 64; C = (st & 1) * 32 + (swz % 64) / 2; }
__host__ __device__ __forceinline__ int perm32(int rho) { const int n = rho >> 4, i = rho & 15; return 8 * (i >> 2) + 4 * n + (i & 3); }

struct Unit { int pm, pn; };
struct Gemm { const bf16_t* A; const bf16_t* Bt; int M, N, K; };

struct StaticOrder {
    int nM, nN, nwg, G, c;
    __host__ __device__ void init(int M, int N, int G_, int c_) { nM = M / BM; nN = N / BM; nwg = nM * nN; G = G_; c = c_; }
    __host__ __device__ bool next(int i, Unit& u) const {
        const long L = (long)i * G + c; if (L >= nwg) return false;
        int wgid = (int)L; { const int q = nwg / NXCD, r = nwg % NXCD, xcd = wgid % NXCD, off = wgid / NXCD; wgid = (xcd < r ? xcd * (q + 1) : r * (q + 1) + (xcd - r) * q) + off; }
        const int nig = WGM * nN, gid = wgid / nig, fm = gid * WGM, gsz = (nM - fm) < WGM ? (nM - fm) : WGM;
        u.pm = fm + ((wgid % nig) % gsz); u.pn = (wgid % nig) / gsz; return true;
    }
    __device__ __forceinline__ void a_ready(const Unit&) const {}
    __device__ __forceinline__ void done(const Unit&) const {}
};

__device__ __forceinline__ unsigned cvt_pk_bf16(float lo, float hi) { unsigned r; asm volatile("v_cvt_pk_bf16_f32 %0, %1, %2" : "=v"(r) : "v"(lo), "v"(hi)); return r; }
template <class Epi, class Sched, bool ALIGN_EPI = false, bool SP2 = false>
__device__ __forceinline__ void gemm_phase(PG8_LAS unsigned char* lds, const Gemm g, const Sched& S, const Epi& E) {
    const int tid = threadIdx.x, wid = __builtin_amdgcn_readfirstlane(tid >> 6), lane = tid & 63, wr = wid >> 2, wc = wid & 3, fr = lane & 15, fq = lane >> 4;
    const int K = g.K, nt = K / BK;
    unsigned voffA[2], voffB[2];
#pragma unroll
    for (int i = 0; i < 2; ++i) { int R, C; stage_rc(tid * 16 + i * 8192, R, C); const int Rb = Epi::PERM ? ((R & ~31) + perm32(R & 31)) : R;
        voffA[i] = (unsigned)(R * K + C) * 2u; voffB[i] = (unsigned)(Rb * K + C) * 2u; }
    const size_t kstep = (size_t)(BK * 2);
    const size_t hstep = (size_t)HALF * K * 2;
    const size_t tstep = 2 * hstep;
    const unsigned ldsw = (unsigned)wid * 1024u;
    const int aoff = lds_byte(wr * 64 + fr, fq * 8), boff = lds_byte(wc * 32 + fr, fq * 8);
#define PG8_SA(b, h) (((b) * 2 + (h)) * HTB)
#define PG8_SB(b, h) ((4 + (b) * 2 + (h)) * HTB)
#define PG8_STAGE(bufoff, gbase, voff) do { _Pragma("unroll") for (int _i = 0; _i < 2; ++_i) \
        __builtin_amdgcn_global_load_lds((const unsigned*)((const char*)(gbase) + (voff)[_i]), (PG8_LAS unsigned*)(lds + (bufoff) + ldsw + _i * 8192), 16, 0, 0); } while (0)
#define PG8_LDA(dst, b, h) do { _Pragma("unroll") for (int m = 0; m < 4; ++m) _Pragma("unroll") for (int k = 0; k < 2; ++k) dst[m][k] = *(const PG8_LAS bf16x8*)(lds + PG8_SA(b, h) + aoff + m * 2048 + k * 1024); } while (0)
#define PG8_LDB(dst, b, h) do { _Pragma("unroll") for (int n = 0; n < 2; ++n) _Pragma("unroll") for (int k = 0; k < 2; ++k) dst[n][k] = *(const PG8_LAS bf16x8*)(lds + PG8_SB(b, h) + boff + n * 2048 + k * 1024); } while (0)
#define PG8_MMA(ai, bj, At, Bt) do { __builtin_amdgcn_s_setprio(1); _Pragma("unroll") for (int m = 0; m < 4; ++m) _Pragma("unroll") for (int n = 0; n < 2; ++n) _Pragma("unroll") for (int k = 0; k < 2; ++k) \
        acc[ai][bj][m][n] = __builtin_amdgcn_mfma_f32_16x16x32_bf16(Bt[n][k], At[m][k], acc[ai][bj][m][n], 0, 0, 0); __builtin_amdgcn_s_setprio(0); } while (0)
#define PG8_WAIT_V(n) asm volatile("s_waitcnt vmcnt(" #n ")" ::: "memory")
#define PG8_WAIT_L(n) asm volatile("s_waitcnt lgkmcnt(" #n ")" ::: "memory")
#define PG8_BAR __builtin_amdgcn_s_barrier()
#define PG8_SCHED __builtin_amdgcn_sched_barrier(0)
    Unit cur, nxt; int ui = 0;
    if (!S.next(0, cur)) return;
    f32x4 acc[2][2][4][2];
#pragma unroll
    for (int a = 0; a < 2; ++a)
#pragma unroll
        for (int b = 0; b < 2; ++b)
#pragma unroll
            for (int m = 0; m < 4; ++m)
#pragma unroll
                for (int n = 0; n < 2; ++n) acc[a][b][m][n] = (f32x4){0.f, 0.f, 0.f, 0.f};
    bf16x8 At[4][2], B0[2][2], B1[2][2];
    const char* cA = (const char*)g.A + (size_t)cur.pm * tstep; const char* cB = (const char*)g.Bt + (size_t)cur.pn * tstep;
    S.a_ready(cur);
    if constexpr (SP2) {
        PG8_STAGE(PG8_SB(0, 0), cB, voffB); PG8_STAGE(PG8_SB(0, 1), cB + hstep, voffB); PG8_STAGE(PG8_SA(0, 0), cA, voffA); PG8_STAGE(PG8_SA(0, 1), cA + hstep, voffA);
        if (wr == 1) PG8_BAR;
        PG8_WAIT_V(2); PG8_BAR;
        PG8_STAGE(PG8_SB(1, 0), cB + kstep, voffB); PG8_STAGE(PG8_SA(1, 0), cA + kstep, voffA); PG8_STAGE(PG8_SB(1, 1), cB + hstep + kstep, voffB);
        PG8_WAIT_V(6); PG8_BAR;
    } else {
        PG8_STAGE(PG8_SB(0, 0), cB, voffB); PG8_STAGE(PG8_SA(0, 0), cA, voffA); PG8_STAGE(PG8_SB(0, 1), cB + hstep, voffB); PG8_STAGE(PG8_SA(0, 1), cA + hstep, voffA);
        if (wr == 1) PG8_BAR;
        PG8_WAIT_V(4); PG8_BAR;
        PG8_STAGE(PG8_SB(1, 0), cB + kstep, voffB); PG8_STAGE(PG8_SA(1, 0), cA + kstep, voffA); PG8_STAGE(PG8_SB(1, 1), cB + hstep + kstep, voffB);
        PG8_WAIT_V(6); PG8_BAR;
    }
    for (;;) {
        const bool has_next = S.next(ui + 1, nxt);
        const char* nA = has_next ? (const char*)g.A + (size_t)nxt.pm * tstep : cA; const char* nB = has_next ? (const char*)g.Bt + (size_t)nxt.pn * tstep : cB;
        for (int t = 0; t < nt; t += 2) {
            const bool last = (t == nt - 2);
            const char* a1 = cA + (size_t)(t + 1) * kstep;
            const char* a2 = last ? nA : cA + (size_t)(t + 2) * kstep; const char* b2 = last ? nB : cB + (size_t)(t + 2) * kstep;
            const char* a3 = a2 + kstep; const char* b3 = b2 + kstep;
            if (last && has_next) S.a_ready(nxt);
            if constexpr (SP2) {
            PG8_LDB(B0, 0, 0); PG8_LDB(B1, 0, 1); PG8_SCHED; PG8_LDA(At, 0, 0); PG8_STAGE(PG8_SA(1, 1), a1 + hstep, voffA);
            PG8_WAIT_V(8); PG8_WAIT_L(0); PG8_BAR; PG8_MMA(0, 0, At, B0); PG8_MMA(0, 1, At, B1); PG8_BAR; PG8_SCHED;
            PG8_LDA(At, 0, 1); PG8_STAGE(PG8_SB(0, 0), b2, voffB); PG8_STAGE(PG8_SB(0, 1), b2 + hstep, voffB); PG8_STAGE(PG8_SA(0, 0), a2, voffA);
            PG8_WAIT_V(8); PG8_WAIT_L(0); PG8_BAR; PG8_MMA(1, 0, At, B0); PG8_MMA(1, 1, At, B1); PG8_BAR; PG8_SCHED;
            PG8_LDB(B0, 1, 0); PG8_LDB(B1, 1, 1); PG8_SCHED; PG8_LDA(At, 1, 0); PG8_STAGE(PG8_SA(0, 1), a2 + hstep, voffA);
            PG8_WAIT_V(8); PG8_WAIT_L(0); PG8_BAR; PG8_MMA(0, 0, At, B0); PG8_MMA(0, 1, At, B1); PG8_BAR; PG8_SCHED;
            PG8_LDA(At, 1, 1); PG8_STAGE(PG8_SB(1, 0), b3, voffB); PG8_STAGE(PG8_SB(1, 1), b3 + hstep, voffB); PG8_STAGE(PG8_SA(1, 0), a3, voffA);
            PG8_WAIT_V(8); PG8_WAIT_L(0); PG8_BAR; PG8_MMA(1, 0, At, B0); PG8_MMA(1, 1, At, B1); PG8_BAR; PG8_SCHED;
            } else {
            PG8_LDB(B0, 0, 0); PG8_SCHED; PG8_LDA(At, 0, 0); PG8_STAGE(PG8_SA(1, 1), a1 + hstep, voffA);
            PG8_WAIT_L(8); PG8_BAR; PG8_WAIT_L(0); PG8_MMA(0, 0, At, B0); PG8_BAR; PG8_SCHED;
            PG8_LDB(B1, 0, 1); PG8_STAGE(PG8_SB(0, 0), b2, voffB);
            PG8_BAR; PG8_WAIT_L(0); PG8_MMA(0, 1, At, B1); PG8_BAR;
            PG8_LDA(At, 0, 1); PG8_STAGE(PG8_SA(0, 0), a2, voffA);
            PG8_BAR; PG8_WAIT_L(0); PG8_MMA(1, 0, At, B0); PG8_BAR; PG8_SCHED;
            PG8_STAGE(PG8_SB(0, 1), b2 + hstep, voffB);
            PG8_WAIT_V(6); PG8_BAR; PG8_MMA(1, 1, At, B1); PG8_BAR;
            PG8_LDB(B0, 1, 0); PG8_SCHED; PG8_LDA(At, 1, 0); PG8_STAGE(PG8_SA(0, 1), a2 + hstep, voffA);
            PG8_WAIT_L(8); PG8_BAR; PG8_WAIT_L(0); PG8_MMA(0, 0, At, B0); PG8_BAR; PG8_SCHED;
            PG8_LDB(B1, 1, 1); PG8_STAGE(PG8_SB(1, 0), b3, voffB);
            PG8_BAR; PG8_WAIT_L(0); PG8_MMA(0, 1, At, B1); PG8_BAR;
            PG8_LDA(At, 1, 1); PG8_STAGE(PG8_SA(1, 0), a3, voffA);
            PG8_BAR; PG8_WAIT_L(0); PG8_MMA(1, 0, At, B0); PG8_BAR; PG8_SCHED;
            PG8_STAGE(PG8_SB(1, 1), b3 + hstep, voffB);
            PG8_WAIT_V(6); PG8_BAR; PG8_MMA(1, 1, At, B1); PG8_BAR;
            }
        }
        if constexpr (ALIGN_EPI) { if (wr == 0) PG8_BAR; }
        if constexpr (!Epi::AFTER_DRAIN) { E(acc, cur, wr, wc, fr, fq); S.done(cur); }
        if (!has_next) break;
#pragma unroll
        for (int a = 0; a < 2; ++a)
#pragma unroll
            for (int b = 0; b < 2; ++b)
#pragma unroll
                for (int m = 0; m < 4; ++m)
#pragma unroll
                    for (int n = 0; n < 2; ++n) acc[a][b][m][n] = (f32x4){0.f, 0.f, 0.f, 0.f};
        cur = nxt; cA = nA; cB = nB; ++ui;
        if constexpr (ALIGN_EPI) { if (wr == 1) PG8_BAR; }
    }
    PG8_WAIT_V(0);
    if constexpr (!ALIGN_EPI) { if (wr == 0) PG8_BAR; }
    PG8_BAR;
    if constexpr (Epi::AFTER_DRAIN) { E.fused(acc, cur, wr, wc, fr, fq, lds, wid, lane); S.done(cur); }
#undef PG8_SA
#undef PG8_SB
#undef PG8_STAGE
#undef PG8_LDA
#undef PG8_LDB
#undef PG8_MMA
#undef PG8_WAIT_V
#undef PG8_WAIT_L
#undef PG8_BAR
#undef PG8_SCHED
}
}

namespace pg8 {
template <int RELU2> struct EpiStore {
    static constexpr bool PERM = true, AFTER_DRAIN = false;
    bf16_t* O; int ldc;
    __device__ __forceinline__ void operator()(const f32x4 (&acc)[2][2][4][2], const Unit& u, int wr, int wc, int fr, int fq) const {
        const int row0 = u.pm * BM + wr * 64 + fr, col0 = u.pn * BM + wc * 32 + 8 * fq;
#pragma unroll
        for (int ai = 0; ai < 2; ++ai)
#pragma unroll
            for (int m = 0; m < 4; ++m) { bf16_t* rowp = O + (size_t)(row0 + ai * HALF + m * 16) * ldc + col0;
#pragma unroll
                for (int bj = 0; bj < 2; ++bj) { f32x4 v0 = acc[ai][bj][m][0], v1 = acc[ai][bj][m][1];
                    if (RELU2) {
#pragma unroll
                        for (int e = 0; e < 4; ++e) { const float a = fmaxf(v0[e], 0.f), b = fmaxf(v1[e], 0.f); v0[e] = a * a; v1[e] = b * b; } }
                    u32x4 w; w.x = cvt_pk_bf16(v0[0], v0[1]); w.y = cvt_pk_bf16(v0[2], v0[3]); w.z = cvt_pk_bf16(v1[0], v1[1]); w.w = cvt_pk_bf16(v1[2], v1[3]);
                    *(u32x4*)(rowp + bj * HALF) = w; } }
    }
};
struct EpiResid {
    static constexpr bool PERM = false, AFTER_DRAIN = false;
    const float* base; float* out; int ldc;
    __device__ __forceinline__ void operator()(const f32x4 (&acc)[2][2][4][2], const Unit& u, int wr, int wc, int fr, int fq) const {
        const int row0 = u.pm * BM + wr * 64 + fr, col0 = u.pn * BM + wc * 32 + 4 * fq;
#pragma unroll
        for (int ai = 0; ai < 2; ++ai)
#pragma unroll
            for (int m = 0; m < 4; ++m) { const size_t off = (size_t)(row0 + ai * HALF + m * 16) * ldc + col0;
#pragma unroll
                for (int bj = 0; bj < 2; ++bj)
#pragma unroll
                    for (int n = 0; n < 2; ++n) { const size_t o = off + bj * HALF + n * 16; const f32x4 bs = *(const f32x4*)(base + o); *(f32x4*)(out + o) = bs + acc[ai][bj][m][n]; } }
    }
};
struct EpiQRope {
    static constexpr bool PERM = false, AFTER_DRAIN = false;
    bf16_t* O; int ldc; const float* tab;
    __device__ __forceinline__ void operator()(const f32x4 (&acc)[2][2][4][2], const Unit& u, int wr, int wc, int fr, int fq) const {
        typedef unsigned u32x2 __attribute__((ext_vector_type(2)));
        const int row0 = u.pm * BM + wr * 64 + fr;
#pragma unroll
        for (int ai = 0; ai < 2; ++ai)
#pragma unroll
            for (int m = 0; m < 4; ++m) { const int row = row0 + ai * HALF + m * 16;
                const f32x4 cs = *(const f32x4*)(tab + (size_t)row * 32 + 4 * fq), sn = *(const f32x4*)(tab + (size_t)row * 32 + 16 + 4 * fq);
#pragma unroll
                for (int bj = 0; bj < 2; ++bj) { const int cgp = u.pn * BM + bj * HALF + wc * 32;
                    f32x4 x1 = acc[ai][bj][m][0], x2 = acc[ai][bj][m][1];
                    if ((cgp % 96) == 64) { const f32x4 o1 = x1 * cs - x2 * sn, o2 = x2 * cs + x1 * sn; x1 = o1; x2 = o2; }
                    bf16_t* op = O + (size_t)row * ldc + cgp + 4 * fq;
                    u32x2 w1, w2; w1.x = cvt_pk_bf16(x1[0], x1[1]); w1.y = cvt_pk_bf16(x1[2], x1[3]); w2.x = cvt_pk_bf16(x2[0], x2[1]); w2.y = cvt_pk_bf16(x2[2], x2[3]);
                    *(u32x2*)op = w1; *(u32x2*)(op + 16) = w2; }
                asm volatile("" ::: "memory"); }
    }
};
}

#define DI __device__ __forceinline__
#define LAS __attribute__((address_space(3)))
typedef unsigned short bf16_t;
typedef short bf16x8 __attribute__((ext_vector_type(8)));
typedef short s16x4 __attribute__((ext_vector_type(4)));
typedef float f32x4 __attribute__((ext_vector_type(4)));
typedef float f32x16 __attribute__((ext_vector_type(16)));
typedef unsigned u32x4 __attribute__((ext_vector_type(4)));
typedef unsigned u32x2 __attribute__((ext_vector_type(2)));

constexpr int BATCH = 4, SEQ = 4096, DM = 1024, MT = BATCH * SEQ, DFF = 4096;
constexpr int LD_AB = 3072, LD_CD = 2304, NSRC_AB = 3080, NSRC_CD = 2208;
constexpr int NWAVES = 8, NTHREADS = 512;
constexpr float LOG2E = 1.4426950408889634f, LN2 = 0.6931471805599453f, EPS = 1e-6f;
constexpr size_t MiB = 1u << 20;
constexpr size_t WS_WINAB = 0, WS_WOUTAB = 6 * MiB, WS_WINCD = 8 * MiB, WS_WUQ = 13 * MiB, WS_WUKV = 14 * MiB, WS_WOUTCD = 15 * MiB;
constexpr size_t WS_WUP0 = 17 * MiB, WS_WUP1 = 25 * MiB, WS_WDN0 = 33 * MiB, WS_WDN1 = 41 * MiB;
constexpr size_t WS_LOGF = 49 * MiB, WS_CUM = 49 * MiB + 512 * 1024, WS_TAB = 50 * MiB, WS_KR = 52 * MiB;
constexpr size_t WS_XN = 54 * MiB, WS_CQN = 54 * MiB, WS_CKVN = 66 * MiB, WS_O = 86 * MiB;
constexpr size_t WS_BIG = 118 * MiB, WS_QF = 190 * MiB, WS_KVF = 214 * MiB, WS_CTL = 246 * MiB, CTL_BYTES = 65536, WS_END = 247 * MiB;
constexpr int LDS_BYTES = 147456, MISC_OFF = 131072 + 320;

DI float bf2f(unsigned short v) { return __uint_as_float((unsigned)v << 16); }
DI unsigned pk2(float lo, float hi) { typedef float f2 __attribute__((ext_vector_type(2))); typedef __bf16 b2 __attribute__((ext_vector_type(2))); f2 v = {lo, hi}; b2 b = __builtin_convertvector(v, b2); return __builtin_bit_cast(unsigned, b); }
DI float wave_sum(float v) {
#pragma unroll
    for (int o = 1; o < 64; o <<= 1) v += __shfl_xor(v, o);
    return v;
}
DI float fexp2(float x) { return __builtin_amdgcn_exp2f(x); }
DI float flog2(float x) { return __builtin_amdgcn_logf(x); }

DI void transpose_item(const float* W, int K, int ldn, int src_col0, bf16_t* WT, int dst_row0, int nblk, LAS float* scr, int item, int lane) {
    const int kb = item / nblk, nb = item % nblk, k0 = 64 * kb, n0 = 32 * nb;
#pragma unroll 8
    for (int i = 0; i < 32; ++i) { const int kk = 2 * i + (lane >> 5); scr[kk * 33 + (lane & 31)] = W[(size_t)(k0 + kk) * ldn + src_col0 + n0 + (lane & 31)]; }
    asm volatile("s_waitcnt lgkmcnt(0)" ::: "memory");
    const int c = lane & 7;
#pragma unroll
    for (int j = 0; j < 4; ++j) { const int n = (lane >> 3) + 8 * j; const LAS float* s = scr + (8 * c) * 33 + n;
        u32x4 o; o.x = pk2(s[0 * 33], s[1 * 33]); o.y = pk2(s[2 * 33], s[3 * 33]); o.z = pk2(s[4 * 33], s[5 * 33]); o.w = pk2(s[6 * 33], s[7 * 33]);
        *(u32x4*)(WT + (size_t)(dst_row0 + n0 + n) * K + k0 + 8 * c) = o; }
    asm volatile("s_waitcnt lgkmcnt(0)" ::: "memory");
}

template <bool FA> DI void norm_rows_bf16(const float* src, const float* gain, bf16_t* dst, int gw, int ngw, int lane, const LAS float* wfaT, const float* b_forget, float* logf_out) {
    f32x4 g[4];
#pragma unroll
    for (int j = 0; j < 4; ++j) g[j] = ((const f32x4*)gain)[64 * j + lane];
    for (int row = gw; row < MT; row += ngw) {
        const f32x4* xr = (const f32x4*)(src + (size_t)row * DM) + lane;
        f32x4 v[4]; float s = 0.f;
#pragma unroll
        for (int j = 0; j < 4; ++j) { v[j] = xr[64 * j]; s += (v[j].x * v[j].x + v[j].y * v[j].y) + (v[j].z * v[j].z + v[j].w * v[j].w); }
        const float rstd = 1.0f / sqrtf(wave_sum(s) * (1.f / DM) + EPS);
#pragma unroll
        for (int j = 0; j < 4; ++j) v[j] = v[j] * rstd * g[j];
        unsigned long long* o8 = (unsigned long long*)(dst + (size_t)row * DM) + lane;
#pragma unroll
        for (int j = 0; j < 4; ++j) o8[64 * j] = (unsigned long long)pk2(v[j].x, v[j].y) | ((unsigned long long)pk2(v[j].z, v[j].w) << 32);
        if (FA) {
            float mine = 0.f;
#pragma unroll
            for (int jj = 0; jj < 8; ++jj) { float a = 0.f;
#pragma unroll
                for (int j = 0; j < 4; ++j) { const f32x4 w = *(const LAS f32x4*)(wfaT + jj * 1024 + 256 * j + 4 * lane); a += (v[j].x * w.x + v[j].y * w.y) + (v[j].z * w.z + v[j].w * w.w); }
                a = wave_sum(a); if (lane == jj) mine = a; }
            if (lane < 8) { const float t = mine + b_forget[lane]; const float ls = fminf(t, 0.f) - log1pf(expf(-fabsf(t))); logf_out[(size_t)row * 8 + lane] = ls; }
        }
    }
}
DI void norm_rows_f32(float* buf, const float* gain, int gw, int ngw, int lane) {
    f32x4 g[4];
#pragma unroll
    for (int j = 0; j < 4; ++j) g[j] = ((const f32x4*)gain)[64 * j + lane];
    for (int row = gw; row < MT; row += ngw) {
        f32x4* xr = (f32x4*)(buf + (size_t)row * DM) + lane;
        f32x4 v[4]; float s = 0.f;
#pragma unroll
        for (int j = 0; j < 4; ++j) { v[j] = xr[64 * j]; s += (v[j].x * v[j].x + v[j].y * v[j].y) + (v[j].z * v[j].z + v[j].w * v[j].w); }
        const float rstd = 1.0f / sqrtf(wave_sum(s) * (1.f / DM) + EPS);
#pragma unroll
        for (int j = 0; j < 4; ++j) xr[64 * j] = v[j] * rstd * g[j];
    }
}

DI void sincos_d(double a, float& sn, float& cs) {
    const double n = rint(a * 0.63661977236758134308);
    const double r = fma(-n, 1.5707963267948966192, a) - n * 6.123233995736766e-17;
    const double r2 = r * r;
    double sp = -2.5052108385441718775e-8; sp = sp * r2 + 2.7557319223985890653e-6; sp = sp * r2 - 1.9841269841269841270e-4; sp = sp * r2 + 8.3333333333333333333e-3; sp = sp * r2 - 1.6666666666666666667e-1; sp = r + r * r2 * sp;
    double cp = 2.0876756987868098979e-9; cp = cp * r2 - 2.7557319223985890653e-7; cp = cp * r2 + 2.4801587301587301587e-5; cp = cp * r2 - 1.3888888888888888889e-3; cp = cp * r2 + 4.1666666666666666667e-2; cp = cp * r2 - 0.5; cp = 1.0 + r2 * cp;
    const int q = (int)((long long)n & 3);
    const double s_ = (q == 0) ? sp : (q == 1) ? cp : (q == 2) ? -sp : -cp;
    const double c_ = (q == 0) ? cp : (q == 1) ? -sp : (q == 2) ? -cp : sp;
    sn = (float)s_; cs = (float)c_;
}
DI float inv_freq_f(int i) {
    float r = 1.0f;
    r = (i == 1) ? 0.56234132519034908f : r;
    r = (i == 2) ? 0.31622776601683794f : r;
    r = (i == 3) ? 0.17782794100389228f : r;
    r = (i == 4) ? 0.1f : r;
    r = (i == 5) ? 0.056234132519034911f : r;
    r = (i == 6) ? 0.031622776601683791f : r;
    r = (i == 7) ? 0.017782794100389229f : r;
    r = (i == 8) ? 0.01f : r;
    r = (i == 9) ? 0.0056234132519034910f : r;
    r = (i == 10) ? 0.0031622776601683794f : r;
    r = (i == 11) ? 0.0017782794100389228f : r;
    r = (i == 12) ? 0.001f : r;
    r = (i == 13) ? 0.00056234132519034907f : r;
    r = (i == 14) ? 0.00031622776601683794f : r;
    r = (i == 15) ? 0.00017782794100389227f : r;
    return r;
}
DI void mla_prep_rows(const bf16_t* PC, const int* pos, const float* q_norm, const float* kv_norm, bf16_t* cqn, bf16_t* ckvn, float* tab, bf16_t* KR, int gw, int ngw, int lane) {
    for (int row = gw; row < MT; row += ngw) {
        const bf16_t* pr = PC + (size_t)row * LD_CD;
        {
            float v[8]; float s = 0.f;
            if (lane < 48) { const u32x4 w = *(const u32x4*)(pr + 1536 + 8 * lane);
#pragma unroll
                for (int e = 0; e < 4; ++e) { v[2 * e] = __uint_as_float(w[e] << 16); v[2 * e + 1] = __uint_as_float(w[e] & 0xffff0000u); s += v[2 * e] * v[2 * e] + v[2 * e + 1] * v[2 * e + 1]; } }
            else {
#pragma unroll
                for (int e = 0; e < 8; ++e) v[e] = 0.f; }
            const float rstd = 1.0f / sqrtf(wave_sum(s) * (1.f / 384.f) + EPS);
            if (lane < 48) { const f32x4 g0 = *(const f32x4*)(q_norm + 8 * lane), g1 = *(const f32x4*)(q_norm + 8 * lane + 4);
                u32x4 o; o.x = pk2(v[0] * rstd * g0.x, v[1] * rstd * g0.y); o.y = pk2(v[2] * rstd * g0.z, v[3] * rstd * g0.w); o.z = pk2(v[4] * rstd * g1.x, v[5] * rstd * g1.y); o.w = pk2(v[6] * rstd * g1.z, v[7] * rstd * g1.w);
                *(u32x4*)(cqn + (size_t)row * 384 + 8 * lane) = o; }
        }
        {
            float v[8]; float s = 0.f;
            if (lane < 32) { const u32x4 w = *(const u32x4*)(pr + 1920 + 8 * lane);
#pragma unroll
                for (int e = 0; e < 4; ++e) { v[2 * e] = __uint_as_float(w[e] << 16); v[2 * e + 1] = __uint_as_float(w[e] & 0xffff0000u); s += v[2 * e] * v[2 * e] + v[2 * e + 1] * v[2 * e + 1]; } }
            else {
#pragma unroll
                for (int e = 0; e < 8; ++e) v[e] = 0.f; }
            const float rstd = 1.0f / sqrtf(wave_sum(s) * (1.f / 256.f) + EPS);
            if (lane < 32) { const f32x4 g0 = *(const f32x4*)(kv_norm + 8 * lane), g1 = *(const f32x4*)(kv_norm + 8 * lane + 4);
                u32x4 o; o.x = pk2(v[0] * rstd * g0.x, v[1] * rstd * g0.y); o.y = pk2(v[2] * rstd * g0.z, v[3] * rstd * g0.w); o.z = pk2(v[4] * rstd * g1.x, v[5] * rstd * g1.y); o.w = pk2(v[6] * rstd * g1.z, v[7] * rstd * g1.w);
                *(u32x4*)(ckvn + (size_t)row * 256 + 8 * lane) = o; }
        }
        if (lane < 16) {
            const float ang = (float)pos[row] * inv_freq_f(lane);
            float sn, cs; sincos_d((double)ang, sn, cs);
            tab[(size_t)row * 32 + lane] = cs; tab[(size_t)row * 32 + 16 + lane] = sn;
            const float x1 = bf2f(pr[2176 + lane]), x2 = bf2f(pr[2176 + 16 + lane]);
            KR[(size_t)row * 32 + lane] = (bf16_t)(pk2(x1 * cs - x2 * sn, 0.f) & 0xffffu);
            KR[(size_t)row * 32 + 16 + lane] = (bf16_t)(pk2(x2 * cs + x1 * sn, 0.f) & 0xffffu);
        }
    }
}

namespace att {
constexpr int KBUF = 13312, VBUF = 9216;
constexpr int OFF_K = 0, OFF_V = 2 * KBUF, OFF_C = OFF_V + 2 * VBUF, OFF_RB = OFF_C + 512, OFF_FLAG = OFF_RB + 1280, ATT_LDS = OFF_FLAG + 64;
DI f32x16 mfma(bf16x8 a, bf16x8 b, f32x16 c) { return __builtin_amdgcn_mfma_f32_32x32x16_bf16(a, b, c, 0, 0, 0); }
DI int crow(int i, int hh) { return (i & 3) + 8 * (i >> 2) + 4 * hh; }
DI bf16x8 packfrag(const f32x16& p, int s) { u32x4 w; w.x = pk2(p[8 * s], p[8 * s + 1]); w.y = pk2(p[8 * s + 2], p[8 * s + 3]); w.z = pk2(p[8 * s + 4], p[8 * s + 5]); w.w = pk2(p[8 * s + 6], p[8 * s + 7]); return __builtin_bit_cast(bf16x8, w); }
typedef short v4i16_t __attribute__((ext_vector_type(4)));
DI s16x4 vtr(const LAS unsigned char* p) { return __builtin_bit_cast(s16x4, __builtin_amdgcn_ds_read_tr16_b64_v4i16((LAS v4i16_t*)p)); }

struct Lane { int tid, lane, wid, r, hh, q4, p4, blk, srow, sch; };
DI Lane mklane() { Lane L; L.tid = threadIdx.x; L.lane = L.tid & 63; L.wid = __builtin_amdgcn_readfirstlane(L.tid >> 6); L.r = L.lane & 31; L.hh = L.lane >> 5;
    const int i16 = L.lane & 15; L.q4 = i16 >> 2; L.p4 = i16 & 3; L.blk = (L.lane >> 4) & 1; L.srow = L.tid >> 3; L.sch = L.tid & 7; return L; }

template <int NDS, int KSTRIDE> DI void qk_tile(f32x16& p0, f32x16& p1, const LAS unsigned char* Kb, const bf16x8* qf, const Lane& L) {
    const LAS unsigned char* ka = Kb + L.r * KSTRIDE + L.hh * 16;
#pragma unroll
    for (int i = 0; i < 16; ++i) { p0[i] = 0.f; p1[i] = 0.f; }
#pragma unroll
    for (int ds = 0; ds < NDS; ++ds) {
        const bf16x8 a0 = *(const LAS bf16x8*)(ka + ds * 32), a1 = *(const LAS bf16x8*)(ka + 32 * KSTRIDE + ds * 32);
        p0 = mfma(a0, qf[ds], p0); p1 = mfma(a1, qf[ds], p1); }
}
DI void pv_tile(f32x16& o0, f32x16& o1, const LAS unsigned char* Vb, const bf16x8 (&pf)[4], const Lane& L) {
    const LAS unsigned char* vb = Vb + (4 * L.hh + L.q4) * 144 + (16 * L.blk + 4 * L.p4) * 2;
#pragma unroll
    for (int f = 0; f < 4; ++f) { const LAS unsigned char* base = vb + (16 * f) * 144;
        { const s16x4 lo = vtr(base), hi = vtr(base + 8 * 144); const bf16x8 vf = __builtin_shufflevector(lo, hi, 0, 1, 2, 3, 4, 5, 6, 7); o0 = mfma(vf, pf[f], o0); }
        { const s16x4 lo = vtr(base + 64), hi = vtr(base + 8 * 144 + 64); const bf16x8 vf = __builtin_shufflevector(lo, hi, 0, 1, 2, 3, 4, 5, 6, 7); o1 = mfma(vf, pf[f], o1); } }
}
DI void online_softmax(f32x16& p0, f32x16& p1, float& m, float& l, f32x16& o0, f32x16& o1, bf16x8 (&pf)[4]) {
    float mt = fmaxf(p0[0], p1[0]);
#pragma unroll
    for (int i = 1; i < 16; ++i) mt = fmaxf(mt, fmaxf(p0[i], p1[i]));
    mt = fmaxf(mt, __shfl_xor(mt, 32));
    const float mn = fmaxf(m, mt), alpha = fexp2(m - mn); m = mn;
    float rs = 0.f;
#pragma unroll
    for (int i = 0; i < 16; ++i) { p0[i] = fexp2(p0[i] - mn); p1[i] = fexp2(p1[i] - mn); rs += p0[i] + p1[i]; }
    l = l * alpha + rs;
#pragma unroll
    for (int i = 0; i < 16; ++i) { o0[i] *= alpha; o1[i] *= alpha; }
    pf[0] = packfrag(p0, 0); pf[1] = packfrag(p0, 1); pf[2] = packfrag(p1, 0); pf[3] = packfrag(p1, 1);
}
DI void store_o(bf16_t* orow, const f32x16& o0, const f32x16& o1, float inv, int hh) {
#pragma unroll
    for (int g = 0; g < 4; ++g) {
        u32x2 w0, w1; w0.x = pk2(o0[4 * g] * inv, o0[4 * g + 1] * inv); w0.y = pk2(o0[4 * g + 2] * inv, o0[4 * g + 3] * inv);
        w1.x = pk2(o1[4 * g] * inv, o1[4 * g + 1] * inv); w1.y = pk2(o1[4 * g + 2] * inv, o1[4 * g + 3] * inv);
        *(u32x2*)(orow + 8 * g + 4 * hh) = w0; *(u32x2*)(orow + 32 + 8 * g + 4 * hh) = w1; }
}

DI void fox_unit(LAS unsigned char* lds, const bf16_t* PA, const float* cum, bf16_t* O, int b, int h, int qb) {
    const Lane L = mklane();
    const size_t rowbase = (size_t)b * SEQ;
    const int q0 = qb * 256, q0w = q0 + L.wid * 32, myq = q0w + L.r;
    const bf16_t* Qp = PA + (rowbase + myq) * LD_AB + h * 64;
    const bf16_t* Kp = PA + rowbase * LD_AB + 512 + h * 64;
    const bf16_t* Vp = Kp + 512;
    const float* cumh = cum + (size_t)(b * 8 + h) * SEQ;
    bf16x8 qf[4];
#pragma unroll
    for (int ds = 0; ds < 4; ++ds) qf[ds] = *(const bf16x8*)(Qp + 16 * ds + 8 * L.hh);
    const float cq2 = cumh[myq] * LOG2E, c1 = 0.125f * LOG2E;
    const int NT = (q0 + 256) / 64;
    float m = -INFINITY, l = 0.f; f32x16 o0, o1;
#pragma unroll
    for (int i = 0; i < 16; ++i) { o0[i] = 0.f; o1[i] = 0.f; }
    u32x4 kreg, vreg; float creg = 0.f;
#define FOX_LOAD(t) do { kreg = *(const u32x4*)(Kp + (size_t)((t) * 64 + L.srow) * LD_AB + L.sch * 8); vreg = *(const u32x4*)(Vp + (size_t)((t) * 64 + L.srow) * LD_AB + L.sch * 8); \
        if (L.tid < 64) creg = cumh[(t) * 64 + L.tid] * (-LOG2E); } while (0)
#define FOX_WRITE(bf) do { *(LAS u32x4*)(lds + OFF_K + (bf) * KBUF + L.srow * 144 + L.sch * 16) = kreg; *(LAS u32x4*)(lds + OFF_V + (bf) * VBUF + L.srow * 144 + L.sch * 16) = vreg; \
        if (L.tid < 64) *(LAS float*)(lds + OFF_C + (bf) * 256 + L.tid * 4) = creg; } while (0)
    FOX_LOAD(0); FOX_WRITE(0); __syncthreads();
    for (int t = 0; t < NT; ++t) {
        if (t + 1 < NT) FOX_LOAD(t + 1);
        const int k0 = t * 64, bf = t & 1;
        if (k0 <= q0w + 31) {
            f32x16 p0, p1;
            qk_tile<4, 144>(p0, p1, lds + OFF_K + bf * KBUF, qf, L);
            const LAS unsigned char* Cb = lds + OFF_C + bf * 256;
#pragma unroll
            for (int g = 0; g < 4; ++g) { const f32x4 ca = *(const LAS f32x4*)(Cb + (8 * g + 4 * L.hh) * 4), cb = *(const LAS f32x4*)(Cb + (32 + 8 * g + 4 * L.hh) * 4);
#pragma unroll
                for (int e = 0; e < 4; ++e) { p0[4 * g + e] = fmaf(p0[4 * g + e], c1, cq2 + ca[e]); p1[4 * g + e] = fmaf(p1[4 * g + e], c1, cq2 + cb[e]); } }
            if (k0 + 63 > q0w) {
#pragma unroll
                for (int i = 0; i < 16; ++i) { const int key = k0 + crow(i, L.hh); if (key > myq) p0[i] = -INFINITY; if (key + 32 > myq) p1[i] = -INFINITY; } }
            bf16x8 pf[4];
            online_softmax(p0, p1, m, l, o0, o1, pf);
            pv_tile(o0, o1, lds + OFF_V + bf * VBUF, pf, L);
        }
        if (t + 1 < NT) FOX_WRITE((t + 1) & 1);
        __syncthreads();
    }
#undef FOX_LOAD
#undef FOX_WRITE
    const float lt = l + __shfl_xor(l, 32);
    store_o(O + (rowbase + myq) * DM + h * 64, o0, o1, 1.0f / lt, L.hh);
}

DI void chk_unit(LAS unsigned char* lds, const bf16_t* PA, const float* rel_bias, bf16_t* O, int b, int h, int g4) {
    const Lane L = mklane();
    const size_t rowbase = (size_t)b * SEQ;
    const int cw = 4 * g4 + (L.wid >> 1), myq = 64 * cw + 32 * (L.wid & 1) + L.r;
    const bf16_t* Qp = PA + (rowbase + myq) * LD_AB + 1536 + h * 64;
    const bf16_t* Kp = PA + rowbase * LD_AB + 2048 + h * 64;
    const bf16_t* Vp = Kp + 512;
    bf16x8 qf[4];
#pragma unroll
    for (int ds = 0; ds < 4; ++ds) qf[ds] = *(const bf16x8*)(Qp + 16 * ds + 8 * L.hh);
    const float c1 = 0.125f * LOG2E;
    const int c_lo = (4 * g4 - 8) > 0 ? (4 * g4 - 8) : 0, NT = 4 * g4 + 4 - c_lo;
    LAS float* rb = (LAS float*)(lds + OFF_RB);
    if (L.tid < 320) rb[L.tid] = rel_bias[h * 320 + L.tid] * LOG2E;
    float m = -INFINITY, l = 0.f; f32x16 o0, o1;
#pragma unroll
    for (int i = 0; i < 16; ++i) { o0[i] = 0.f; o1[i] = 0.f; }
    u32x4 kreg, vreg;
#define CHK_LOAD(t) do { kreg = *(const u32x4*)(Kp + (size_t)((c_lo + (t)) * 64 + L.srow) * LD_AB + L.sch * 8); vreg = *(const u32x4*)(Vp + (size_t)((c_lo + (t)) * 64 + L.srow) * LD_AB + L.sch * 8); } while (0)
#define CHK_WRITE(bf) do { *(LAS u32x4*)(lds + OFF_K + (bf) * KBUF + L.srow * 144 + L.sch * 16) = kreg; *(LAS u32x4*)(lds + OFF_V + (bf) * VBUF + L.srow * 144 + L.sch * 16) = vreg; } while (0)
    CHK_LOAD(0); CHK_WRITE(0); __syncthreads();
    for (int t = 0; t < NT; ++t) {
        if (t + 1 < NT) CHK_LOAD(t + 1);
        const int kc = c_lo + t, bf = t & 1;
        if (kc >= cw - 8 && kc <= cw) {
            f32x16 p0, p1;
            qk_tile<4, 144>(p0, p1, lds + OFF_K + bf * KBUF, qf, L);
            if (cw - kc >= 5) { const float bb = rb[319];
#pragma unroll
                for (int i = 0; i < 16; ++i) { p0[i] = fmaf(p0[i], c1, bb); p1[i] = fmaf(p1[i], c1, bb); } }
            else {
#pragma unroll
                for (int i = 0; i < 16; ++i) { const int rel = myq - (64 * kc + crow(i, L.hh));
                    const int i0 = (rel < 256 ? rel : 256) + 63, i1 = (rel - 32 < 256 ? rel - 32 : 256) + 63;
                    p0[i] = fmaf(p0[i], c1, rb[i0]); p1[i] = fmaf(p1[i], c1, rb[i1]); } }
            bf16x8 pf[4];
            online_softmax(p0, p1, m, l, o0, o1, pf);
            pv_tile(o0, o1, lds + OFF_V + bf * VBUF, pf, L);
        }
        if (t + 1 < NT) CHK_WRITE((t + 1) & 1);
        __syncthreads();
    }
#undef CHK_LOAD
#undef CHK_WRITE
    const float lt = l + __shfl_xor(l, 32);
    store_o(O + (rowbase + myq) * DM + 512 + h * 64, o0, o1, 1.0f / lt, L.hh);
}

DI void mla_unit(LAS unsigned char* lds, const bf16_t* QF, const bf16_t* KVF, const bf16_t* KR, bf16_t* O, int b, int h, int qb) {
    const Lane L = mklane();
    const size_t rowbase = (size_t)b * SEQ;
    const int cw = 4 * qb + (L.wid >> 1), myq = 64 * cw + 32 * (L.wid & 1) + L.r;
    const bf16_t* Qp = QF + (rowbase + myq) * 768 + h * 96;
    const bf16_t* Kp = KVF + rowbase * 1024 + h * 128;
    const bf16_t* Vp = Kp + 64;
    const bf16_t* Rp = KR + rowbase * 32;
    bf16x8 qf[6];
#pragma unroll
    for (int ds = 0; ds < 6; ++ds) qf[ds] = *(const bf16x8*)(Qp + 16 * ds + 8 * L.hh);
    const float c1 = 0.10206207261596577f * LOG2E;
    const int NT = 4 * qb + 4;
    float m = -INFINITY, l = 0.f; f32x16 o0, o1;
#pragma unroll
    for (int i = 0; i < 16; ++i) { o0[i] = 0.f; o1[i] = 0.f; }
    u32x4 kreg, vreg, rreg;
#define MLA_LOAD(t) do { kreg = *(const u32x4*)(Kp + (size_t)((t) * 64 + L.srow) * 1024 + L.sch * 8); vreg = *(const u32x4*)(Vp + (size_t)((t) * 64 + L.srow) * 1024 + L.sch * 8); \
        if (L.tid < 256) rreg = *(const u32x4*)(Rp + (size_t)((t) * 64 + (L.tid >> 2)) * 32 + (L.tid & 3) * 8); } while (0)
#define MLA_WRITE(bf) do { *(LAS u32x4*)(lds + OFF_K + (bf) * KBUF + L.srow * 208 + L.sch * 16) = kreg; *(LAS u32x4*)(lds + OFF_V + (bf) * VBUF + L.srow * 144 + L.sch * 16) = vreg; \
        if (L.tid < 256) *(LAS u32x4*)(lds + OFF_K + (bf) * KBUF + (L.tid >> 2) * 208 + 128 + (L.tid & 3) * 16) = rreg; } while (0)
    MLA_LOAD(0); MLA_WRITE(0); __syncthreads();
    for (int t = 0; t < NT; ++t) {
        if (t + 1 < NT) MLA_LOAD(t + 1);
        const int bf = t & 1;
        if (t <= cw) {
            f32x16 p0, p1;
            qk_tile<6, 208>(p0, p1, lds + OFF_K + bf * KBUF, qf, L);
#pragma unroll
            for (int i = 0; i < 16; ++i) { p0[i] *= c1; p1[i] *= c1; }
            bf16x8 pf[4];
            online_softmax(p0, p1, m, l, o0, o1, pf);
            pv_tile(o0, o1, lds + OFF_V + bf * VBUF, pf, L);
        }
        if (t + 1 < NT) MLA_WRITE((t + 1) & 1);
        __syncthreads();
    }
#undef MLA_LOAD
#undef MLA_WRITE
    const float lt = l + __shfl_xor(l, 32);
    store_o(O + (rowbase + myq) * DM + 512 + h * 64, o0, o1, 1.0f / lt, L.hh);
}

DI void sb_sub(f32x16& p, float& R, int keybase, int myq, int hh, bool need_mask) {
    float lk[16], lb[16];
#pragma unroll
    for (int i = 0; i < 16; ++i) {
        const float z = p[i] * 0.125f, u = fexp2(-fabsf(z) * LOG2E), sp = fmaxf(z, 0.f) + flog2(1.0f + u) * LN2;
        const bool valid = !need_mask || (keybase + crow(i, hh)) < myq;
        lk[i] = valid ? -sp : 0.f; lb[i] = valid ? (z - sp) : -INFINITY; }
    float G[4], Gp[4];
#pragma unroll
    for (int g = 0; g < 4; ++g) { G[g] = (lk[4 * g] + lk[4 * g + 1]) + (lk[4 * g + 2] + lk[4 * g + 3]); Gp[g] = __shfl_xor(G[g], 32); }
    float acc = R;
#pragma unroll
    for (int g = 3; g >= 0; --g) {
        const float s3 = hh ? acc : acc + Gp[g];
        acc += G[g] + Gp[g];
        const float s2 = s3 + lk[4 * g + 3], s1 = s2 + lk[4 * g + 2], s0 = s1 + lk[4 * g + 1];
        p[4 * g + 3] = fexp2((lb[4 * g + 3] + s3) * LOG2E); p[4 * g + 2] = fexp2((lb[4 * g + 2] + s2) * LOG2E);
        p[4 * g + 1] = fexp2((lb[4 * g + 1] + s1) * LOG2E); p[4 * g] = fexp2((lb[4 * g] + s0) * LOG2E); }
    R = acc;
}
DI void sb_unit(LAS unsigned char* lds, const bf16_t* PC, bf16_t* O, int b, int h, int qb) {
    const Lane L = mklane();
    const size_t rowbase = (size_t)b * SEQ;
    const int q0 = qb * 256, q0w = q0 + L.wid * 32, myq = q0w + L.r;
    const bf16_t* Qp = PC + (rowbase + myq) * LD_CD + h * 64;
    const bf16_t* Kp = PC + rowbase * LD_CD + 512 + h * 64;
    const bf16_t* Vp = Kp + 512;
    bf16x8 qf[4];
#pragma unroll
    for (int ds = 0; ds < 4; ++ds) qf[ds] = *(const bf16x8*)(Qp + 16 * ds + 8 * L.hh);
    const int NT = (q0 + 256) / 64;
    float R = 0.f; f32x16 o0, o1;
#pragma unroll
    for (int i = 0; i < 16; ++i) { o0[i] = 0.f; o1[i] = 0.f; }
    bool seen = false;
    LAS int* flags = (LAS int*)(lds + OFF_FLAG);
    u32x4 kreg, vreg;
#define SB_LOAD(t) do { kreg = *(const u32x4*)(Kp + (size_t)((t) * 64 + L.srow) * LD_CD + L.sch * 8); vreg = *(const u32x4*)(Vp + (size_t)((t) * 64 + L.srow) * LD_CD + L.sch * 8); } while (0)
#define SB_WRITE(bf) do { *(LAS u32x4*)(lds + OFF_K + (bf) * KBUF + L.srow * 144 + L.sch * 16) = kreg; *(LAS u32x4*)(lds + OFF_V + (bf) * VBUF + L.srow * 144 + L.sch * 16) = vreg; } while (0)
    SB_LOAD(NT - 1); SB_WRITE(0); __syncthreads();
    for (int it = 0; it < NT; ++it) {
        const int t = NT - 1 - it, k0 = t * 64, bf = it & 1;
        if (t > 0) SB_LOAD(t - 1);
        bool done = false;
        if (k0 <= q0w + 31) {
            done = seen && __all(R < -110.0f);
            if (!done) {
                f32x16 p0, p1;
                qk_tile<4, 144>(p0, p1, lds + OFF_K + bf * KBUF, qf, L);
                const bool nm = (k0 + 63 >= q0w);
                sb_sub(p1, R, k0 + 32, myq, L.hh, nm);
                sb_sub(p0, R, k0, myq, L.hh, nm);
                bf16x8 pf[4];
                pf[0] = packfrag(p0, 0); pf[1] = packfrag(p0, 1); pf[2] = packfrag(p1, 0); pf[3] = packfrag(p1, 1);
                pv_tile(o0, o1, lds + OFF_V + bf * VBUF, pf, L);
                seen = true;
                done = __all(R < -110.0f);
            }
        }
        if (L.lane == 0) flags[(it & 1) * 8 + L.wid] = done ? 1 : 0;
        if (t > 0) SB_WRITE((it + 1) & 1);
        __syncthreads();
        int alld = 1;
#pragma unroll
        for (int w = 0; w < 8; ++w) alld &= flags[(it & 1) * 8 + w];
        if (alld) break;
    }
#undef SB_LOAD
#undef SB_WRITE
    store_o(O + (rowbase + myq) * DM + h * 64, o0, o1, 1.0f, L.hh);
    __syncthreads();
}
}

#define XB_TMO      128
#define XB_XCNT(j)  (256  + 64 * (j))
#define XB_XSUB(j)  (1280 + 64 * (j))
#define XB_XGEN(j)  (2304 + 64 * (j))
#define XB_TOP      3328
#define XB_TOPGEN   3392
#define XCD_BAR_WORDS 3456
#define XB_SPIN_CAP (1u << 18)

__device__ __forceinline__ unsigned xb_ld(unsigned* p)              { return __hip_atomic_load(p, __ATOMIC_RELAXED, __HIP_MEMORY_SCOPE_AGENT); }
__device__ __forceinline__ unsigned xb_add(unsigned* p, unsigned v) { return __hip_atomic_fetch_add(p, v, __ATOMIC_RELAXED, __HIP_MEMORY_SCOPE_AGENT); }
__device__ __forceinline__ unsigned xb_xcc_id() { return (unsigned)__builtin_amdgcn_s_getreg((3 << 11) | 20) & 0xFu; }
#define XB_SPIN(cond, bar) do { unsigned _sp = 0; while (cond) { __builtin_amdgcn_s_sleep(1); \
    if ((++_sp & 255u) == 0u) { if (xb_ld(&(bar)[XB_TMO])) break; if (_sp > XB_SPIN_CAP) { atomicAdd(&(bar)[XB_TMO], 1u); break; } } } } while (0)

struct XcdBarrier {
    unsigned* bar; unsigned x;
    volatile LAS unsigned* st;
};

__device__ __forceinline__ XcdBarrier xcd_barrier_post(unsigned* bar, volatile LAS unsigned* st) {
    XcdBarrier b; b.bar = bar; b.x = xb_xcc_id(); b.st = st;
    if (threadIdx.x == 0) (void)xb_add(&bar[XB_XCNT(b.x)], 1u);
    return b;
}
__device__ __forceinline__ void xcd_barrier_complete(unsigned* bar, unsigned x, unsigned& nloc, unsigned& nx) {
    const unsigned G = gridDim.x * gridDim.y * gridDim.z;
    unsigned sum, cnt, mine, sp = 0u;
    for (;;) {
        sum = 0u; cnt = 0u; mine = 0u;
#pragma unroll
        for (unsigned j = 0; j < 16; ++j) { const unsigned c = xb_ld(&bar[XB_XCNT(j)]); sum += c; cnt += (c > 0u) ? 1u : 0u; mine = (j == x) ? c : mine; }
        if (sum == G) break;
        __builtin_amdgcn_s_sleep(1);
        if ((++sp & 255u) == 0u) { if (xb_ld(&bar[XB_TMO])) break; if (sp > XB_SPIN_CAP) { atomicAdd(&bar[XB_TMO], 1u); break; } }
    }
    nloc = mine > 0u ? mine : 1u; nx = cnt > 0u ? cnt : 1u;
}

__device__ __forceinline__ void xcd_barrier(const XcdBarrier& b) {
    asm volatile("s_waitcnt vmcnt(0)" ::: "memory");
    __syncthreads();
    if (threadIdx.x == 0) {
        unsigned* bar = b.bar;
        __builtin_amdgcn_s_waitcnt(0);
        unsigned nloc = b.st[0], nx = b.st[1];
        if (nloc == 0u) { xcd_barrier_complete(bar, b.x, nloc, nx); b.st[0] = nloc; b.st[1] = nx; }
        const unsigned old = xb_add(&bar[XB_XSUB(b.x)], 1u);
        const unsigned gen = old / nloc;
        if (old + 1u == (gen + 1u) * nloc) {
            __builtin_amdgcn_fence(__ATOMIC_RELEASE, "agent");
            asm volatile("s_waitcnt vmcnt(0)" ::: "memory");
            const unsigned og = xb_add(&bar[XB_TOP], 1u);
            const unsigned tg = og / nx;
            if (og + 1u == (tg + 1u) * nx) xb_add(&bar[XB_TOPGEN], 1u);
            else XB_SPIN(xb_ld(&bar[XB_TOPGEN]) == tg, bar);
            __builtin_amdgcn_fence(__ATOMIC_ACQUIRE, "agent");
            xb_add(&bar[XB_XGEN(b.x)], 1u);
            asm volatile("s_waitcnt vmcnt(0)" ::: "memory");
        } else {
            XB_SPIN(xb_ld(&bar[XB_XGEN(b.x)]) == gen, bar);
            __builtin_amdgcn_fence(__ATOMIC_ACQUIRE, "agent");
            asm volatile("s_waitcnt vmcnt(0)" ::: "memory");
        }
    }
    __syncthreads();
}

struct Params {
    const float* x; const int* pos; const float* norm_mix; const float* norm_mlp; const float* norm_final;
    const float* w_in_ab; const float* b_forget; const float* rel_bias; const float* w_out_ab;
    const float* w_in_cd; const float* q_norm; const float* kv_norm; const float* w_uq; const float* w_ukv; const float* w_out_cd;
    const float* w_up; const float* w_down;
    float* out; unsigned char* ws; int ph_lo, ph_hi, coop, pad;
};
constexpr int N_PHASES = 17;

__global__ void __launch_bounds__(NTHREADS) fwd_kernel(Params P) {
    extern __shared__ __attribute__((aligned(16))) unsigned char lds_raw[];
    LAS unsigned char* lds = (LAS unsigned char*)lds_raw;
    const int tid = threadIdx.x, lane = tid & 63, wave = __builtin_amdgcn_readfirstlane(tid >> 6);
    const int G = gridDim.x, bx = blockIdx.x;
    const int vcu = (G % 8 == 0) ? (bx % 8) * (G / 8) + bx / 8 : bx;
    const int gw = vcu * NWAVES + wave, ngw = G * NWAVES;
    unsigned char* ws = P.ws;
    bf16_t* WinAB = (bf16_t*)(ws + WS_WINAB); bf16_t* WoutAB = (bf16_t*)(ws + WS_WOUTAB); bf16_t* WinCD = (bf16_t*)(ws + WS_WINCD);
    bf16_t* Wuq = (bf16_t*)(ws + WS_WUQ); bf16_t* Wukv = (bf16_t*)(ws + WS_WUKV); bf16_t* WoutCD = (bf16_t*)(ws + WS_WOUTCD);
    bf16_t* Wup0 = (bf16_t*)(ws + WS_WUP0); bf16_t* Wup1 = (bf16_t*)(ws + WS_WUP1); bf16_t* Wdn0 = (bf16_t*)(ws + WS_WDN0); bf16_t* Wdn1 = (bf16_t*)(ws + WS_WDN1);
    float* LOGF = (float*)(ws + WS_LOGF); float* CUM = (float*)(ws + WS_CUM); float* TAB = (float*)(ws + WS_TAB); bf16_t* KR = (bf16_t*)(ws + WS_KR);
    bf16_t* XN = (bf16_t*)(ws + WS_XN); bf16_t* CQN = (bf16_t*)(ws + WS_CQN); bf16_t* CKVN = (bf16_t*)(ws + WS_CKVN); bf16_t* OB = (bf16_t*)(ws + WS_O);
    bf16_t* BIG = (bf16_t*)(ws + WS_BIG); bf16_t* QF = (bf16_t*)(ws + WS_QF); bf16_t* KVF = (bf16_t*)(ws + WS_KVF);
    cg::grid_group grid = cg::this_grid();
    volatile LAS unsigned* MISC = (volatile LAS unsigned*)(lds + MISC_OFF);
    if (tid < 32) MISC[tid] = 0u;
    __syncthreads();
    XcdBarrier bar; bar.bar = (unsigned*)(ws + WS_CTL); bar.x = 0; bar.st = nullptr;
    if (P.coop) bar = xcd_barrier_post((unsigned*)(ws + WS_CTL), MISC + 8);
    const int lo = P.ph_lo, hi = P.ph_hi;
#ifndef PHMASK
#define PHMASK 0x1ffff
#endif
#define IN(k) (((PHMASK >> (k)) & 1) && lo <= (k) && (k) < hi)
#ifndef REPMASK
#define REPMASK 0
#endif
#define REP(k) ((REPMASK >> (k)) & 1)
#define SEAM(k) do { if (P.coop && (k) + 1 < hi) { if (P.coop == 2) grid.sync(); else xcd_barrier(bar); } } while (0)

    if (IN(0)) {
        LAS float* scr = (LAS float*)(lds + wave * 8704);
        for (int it = gw; ; it += ngw) {
            int r = it; bool hit = false;
#define TR(W, K, LDN, C0, NC, WT, R0) if (!hit) { const int n_it = ((K) / 64) * ((NC) / 32); if (r < n_it) { transpose_item((W), (K), (LDN), (C0), (WT), (R0), (NC) / 32, scr, r, lane); hit = true; } else r -= n_it; }
            TR(P.w_in_ab, 1024, NSRC_AB, 0, 1536, WinAB, 0)
            TR(P.w_in_ab, 1024, NSRC_AB, 1544, 1536, WinAB, 1536)
            TR(P.w_out_ab, 1024, 1024, 0, 1024, WoutAB, 0)
            TR(P.w_in_cd, 1024, NSRC_CD, 0, NSRC_CD, WinCD, 0)
            TR(P.w_uq, 384, 768, 0, 768, Wuq, 0)
            TR(P.w_ukv, 256, 1024, 0, 1024, Wukv, 0)
            TR(P.w_out_cd, 1024, 1024, 0, 1024, WoutCD, 0)
            TR(P.w_up, 1024, 4096, 0, 4096, Wup0, 0)
            TR(P.w_up + (size_t)1024 * 4096, 1024, 4096, 0, 4096, Wup1, 0)
            TR(P.w_down, 4096, 1024, 0, 1024, Wdn0, 0)
            TR(P.w_down + (size_t)4096 * 1024, 4096, 1024, 0, 1024, Wdn1, 0)
#undef TR
            if (!hit) break;
        }
        for (int i = (vcu * NTHREADS + tid); i < 96 * 1024 / 8; i += G * NTHREADS) ((u32x4*)(WinCD + (size_t)2208 * 1024))[i] = (u32x4){0u, 0u, 0u, 0u};
        __syncthreads();
        LAS float* wfaT = (LAS float*)lds;
        for (int i = tid; i < 8192; i += NTHREADS) { const int k = i >> 3, j = i & 7; wfaT[j * 1024 + k] = P.w_in_ab[(size_t)k * NSRC_AB + 1536 + j]; }
        __syncthreads();
        norm_rows_bf16<true>(P.x, P.norm_mix, XN, gw, ngw, lane, wfaT, P.b_forget, LOGF);
        __syncthreads();
        SEAM(0);
    }
    if (IN(1)) {
        if (vcu < 32) {
            const int b = vcu >> 3, h = vcu & 7; LAS float* sc = (LAS float*)lds;
            float v[8]; float run = 0.f;
#pragma unroll
            for (int e = 0; e < 8; ++e) { run += LOGF[((size_t)b * SEQ + tid * 8 + e) * 8 + h]; v[e] = run; }
            sc[tid] = run; __syncthreads();
            for (int off = 1; off < NTHREADS; off <<= 1) { const float add = (tid >= off) ? sc[tid - off] : 0.f; __syncthreads(); sc[tid] += add; __syncthreads(); }
            const float base = sc[tid] - run;
#pragma unroll
            for (int e = 0; e < 8; ++e) CUM[(size_t)(b * 8 + h) * SEQ + tid * 8 + e] = base + v[e];
            __syncthreads();
        }
        pg8::Gemm g{XN, WinAB, MT, LD_AB, DM}; pg8::StaticOrder S; S.init(MT, LD_AB, G, bx);
        pg8::EpiStore<0> E{BIG, LD_AB};
        pg8::gemm_phase<pg8::EpiStore<0>, pg8::StaticOrder, true, true>(lds, g, S, E);
        SEAM(1);
    }
    if (IN(2)) {
        const int bh = vcu >> 3, s = vcu & 7, b = bh >> 3, h = bh & 7;
        {
            att::fox_unit(lds, BIG, CUM, OB, b, h, 15 - s);
            att::fox_unit(lds, BIG, CUM, OB, b, h, s);
            att::chk_unit(lds, BIG, P.rel_bias, OB, b, h, 2 * s);
            att::chk_unit(lds, BIG, P.rel_bias, OB, b, h, 2 * s + 1);
        }
        SEAM(2);
    }
    if (IN(3)) {
        pg8::Gemm g{OB, WoutAB, MT, DM, DM}; pg8::StaticOrder S; S.init(MT, DM, G, bx);
        pg8::EpiResid E{P.x, P.out, DM};
        pg8::gemm_phase<pg8::EpiResid, pg8::StaticOrder, true, true>(lds, g, S, E);
        SEAM(3);
    }
    if (IN(4)) { norm_rows_bf16<false>(P.out, P.norm_mlp, XN, gw, ngw, lane, nullptr, nullptr, nullptr); SEAM(4); }
    if (IN(5)) {
        pg8::Gemm g{XN, Wup0, MT, DFF, DM}; pg8::StaticOrder S; S.init(MT, DFF, G, bx);
        pg8::EpiStore<1> E{BIG, DFF};
        pg8::gemm_phase<pg8::EpiStore<1>, pg8::StaticOrder, true, true>(lds, g, S, E);
        SEAM(5);
    }
    if (IN(6)) {
        pg8::Gemm g{BIG, Wdn0, MT, DM, DFF}; pg8::StaticOrder S; S.init(MT, DM, G, bx);
        pg8::EpiResid E{P.out, P.out, DM};
        pg8::gemm_phase<pg8::EpiResid, pg8::StaticOrder, true, true>(lds, g, S, E);
        SEAM(6);
    }
    if (IN(7)) { norm_rows_bf16<false>(P.out, P.norm_mix + DM, XN, gw, ngw, lane, nullptr, nullptr, nullptr); SEAM(7); }
    if (IN(8)) {
        pg8::Gemm g{XN, WinCD, MT, LD_CD, DM}; pg8::StaticOrder S; S.init(MT, LD_CD, G, bx);
        pg8::EpiStore<0> E{BIG, LD_CD};
        pg8::gemm_phase<pg8::EpiStore<0>, pg8::StaticOrder, true, true>(lds, g, S, E);
        SEAM(8);
    }
    if (IN(9)) { mla_prep_rows(BIG, P.pos, P.q_norm, P.kv_norm, CQN, CKVN, TAB, KR, gw, ngw, lane); SEAM(9); }
    if (IN(10)) {
#ifndef P10SEL
#define P10SEL 3
#endif
        if (P10SEL & 1) { pg8::Gemm g{CQN, Wuq, MT, 768, 384 + P.pad};     pg8::StaticOrder S; S.init(MT, 768, G, bx);
          pg8::EpiQRope E{QF, 768, TAB};
          pg8::gemm_phase<pg8::EpiQRope, pg8::StaticOrder, true, true>(lds, g, S, E); }
        if (P10SEL & 2) { pg8::Gemm g{CKVN, Wukv, MT, 1024, 256 + P.pad}; pg8::StaticOrder S; S.init(MT, 1024, G, bx);
          pg8::EpiStore<0> E{KVF, 1024};
          pg8::gemm_phase<pg8::EpiStore<0>, pg8::StaticOrder, true, true>(lds, g, S, E); }
        SEAM(10);
    }
    if (IN(11)) {
        const int bh = vcu >> 3, s = vcu & 7, b = bh >> 3, h = bh & 7;
        {
            att::mla_unit(lds, QF, KVF, KR, OB, b, h, 15 - s);
            att::mla_unit(lds, QF, KVF, KR, OB, b, h, s);
            att::sb_unit(lds, BIG, OB, b, h, 15 - s);
            att::sb_unit(lds, BIG, OB, b, h, s);
        }
        SEAM(11);
    }
    if (IN(12)) {
        pg8::Gemm g{OB, WoutCD, MT, DM, DM}; pg8::StaticOrder S; S.init(MT, DM, G, bx);
        pg8::EpiResid E{P.out, P.out, DM};
        pg8::gemm_phase<pg8::EpiResid, pg8::StaticOrder, true, true>(lds, g, S, E);
        SEAM(12);
    }
    if (IN(13)) { norm_rows_bf16<false>(P.out, P.norm_mlp + DM, XN, gw, ngw, lane, nullptr, nullptr, nullptr); SEAM(13); }
    if (IN(14)) {
        pg8::Gemm g{XN, Wup1, MT, DFF, DM}; pg8::StaticOrder S; S.init(MT, DFF, G, bx);
        pg8::EpiStore<1> E{BIG, DFF};
        pg8::gemm_phase<pg8::EpiStore<1>, pg8::StaticOrder, true, true>(lds, g, S, E);
        SEAM(14);
    }
    if (IN(15)) {
        pg8::Gemm g{BIG, Wdn1, MT, DM, DFF}; pg8::StaticOrder S; S.init(MT, DM, G, bx);
        pg8::EpiResid E{P.out, P.out, DM};
        pg8::gemm_phase<pg8::EpiResid, pg8::StaticOrder, true, true>(lds, g, S, E);
        SEAM(15);
    }
    if (IN(16)) { norm_rows_f32(P.out, P.norm_final, gw, ngw, lane); }
#undef IN
#undef SEAM
}

#ifndef MK_MULTI_LAUNCH
#define MK_MULTI_LAUNCH 0
#endif
extern "C" void kernel_launch(void* const* d_in, const int* in_sizes, int n_in, void* d_out, int out_size, void* d_ws, size_t ws_size, hipStream_t stream) {
    static int grid = 0;
    if (grid == 0) {
        if (n_in != 17 || out_size != MT * DM || ws_size < WS_END) { fprintf(stderr, "kernel_launch: unexpected problem (n_in %d out %d ws %zu)\n", n_in, out_size, ws_size); grid = -1; return; }
        int dev = 0, cus = 0, per_cu = 0;
        hipGetDevice(&dev); hipDeviceGetAttribute(&cus, hipDeviceAttributeMultiprocessorCount, dev);
        if (hipFuncSetAttribute((const void*)fwd_kernel, hipFuncAttributeMaxDynamicSharedMemorySize, LDS_BYTES) != hipSuccess) { fprintf(stderr, "kernel_launch: hipFuncSetAttribute failed\n"); grid = -1; return; }
        if (hipOccupancyMaxActiveBlocksPerMultiprocessor(&per_cu, (const void*)fwd_kernel, NTHREADS, LDS_BYTES) != hipSuccess || per_cu < 1) { fprintf(stderr, "kernel_launch: occupancy query says %d\n", per_cu); per_cu = 1; }
        (void)hipGetLastError();
        grid = cus;
        if (grid != 256) fprintf(stderr, "kernel_launch: note: %d CUs\n", grid);
    }
    if (grid < 0) return;
    Params p{};
    p.x = (const float*)d_in[0]; p.pos = (const int*)d_in[1]; p.norm_mix = (const float*)d_in[2]; p.norm_mlp = (const float*)d_in[3]; p.norm_final = (const float*)d_in[4];
    p.w_in_ab = (const float*)d_in[5]; p.b_forget = (const float*)d_in[6]; p.rel_bias = (const float*)d_in[7]; p.w_out_ab = (const float*)d_in[8];
    p.w_in_cd = (const float*)d_in[9]; p.q_norm = (const float*)d_in[10]; p.kv_norm = (const float*)d_in[11]; p.w_uq = (const float*)d_in[12]; p.w_ukv = (const float*)d_in[13]; p.w_out_cd = (const float*)d_in[14];
    p.w_up = (const float*)d_in[15]; p.w_down = (const float*)d_in[16];
    p.out = (float*)d_out; p.ws = (unsigned char*)d_ws;
#if MK_MULTI_LAUNCH
    for (int ph = 0; ph < N_PHASES; ++ph) {
        p.ph_lo = ph; p.ph_hi = ph + 1; p.coop = 0;
        hipLaunchKernelGGL(fwd_kernel, dim3(grid), dim3(NTHREADS), LDS_BYTES, stream, p);
        if (REP(ph)) hipLaunchKernelGGL(fwd_kernel, dim3(grid), dim3(NTHREADS), LDS_BYTES, stream, p);
    }
#else
    p.ph_lo = 0; p.ph_hi = N_PHASES; p.coop = 1;
    if (hipMemsetAsync((char*)d_ws + WS_CTL, 0, CTL_BYTES, stream) != hipSuccess) { fprintf(stderr, "kernel_launch: hipMemsetAsync failed\n"); return; }
    void* args[] = {&p};
    hipError_t e = hipLaunchCooperativeKernel((const void*)fwd_kernel, dim3(grid), dim3(NTHREADS), args, LDS_BYTES, stream);
    if (e != hipSuccess) fprintf(stderr, "cooperative launch failed: %s (grid %d)\n", hipGetErrorString(e), grid);
#endif
}
```

```cpp
#include <hip/hip_runtime.h>
#include <hip/hip_cooperative_groups.h>
#include <cstdio>
#include <cstdint>
#include <cmath>
namespace cg = cooperative_groups;
namespace pg8 {
#define PG8_LAS __attribute__((address_space(3)))
typedef unsigned short bf16_t;
typedef short bf16x8 __attribute__((ext_vector_type(8)));
typedef float f32x4 __attribute__((ext_vector_type(4)));
typedef unsigned u32x4 __attribute__((ext_vector_type(4)));
constexpr int BM = 256, BK = 64, HALF = 128, HTB = HALF * BK * 2  , STAGE_BYTES = 8 * HTB, NXCD = 8, WGM = 8;

__host__ __device__ __forceinline__ int lds_byte(int r, int c) { const int st = (r >> 4) * 2 + (c >> 5), rr = r & 15, cc = c & 31, ob = rr * 64 + cc * 2; return st * 1024 + (ob ^ (((ob >> 9) & 1) << 5)); }
__host__ __device__ __forceinline__ void stage_rc(int b, int& R, int& C) { const int st = b / 1024, sb = b % 1024, swz = sb ^ (((sb >> 9) & 1) << 5); R = (st >> 1) * 16 + swz / 64; C = (st & 1) * 32 + (swz % 64) / 2; }
__host__ __device__ __forceinline__ int perm32(int rho) { const int n = rho >> 4, i = rho & 15; return 8 * (i >> 2) + 4 * n + (i & 3); }

struct Unit { int pm, pn; };
struct Gemm { const bf16_t* A; const bf16_t* Bt; int M, N, K; };

struct StaticOrder {
    int nM, nN, nwg, G, c;
    __host__ __device__ void init(int M, int N, int G_, int c_) { nM = M / BM; nN = N / BM; nwg = nM * nN; G = G_; c = c_; }
    __host__ __device__ bool next(int i, Unit& u) const {
        const long L = (long)i * G + c; if (L >= nwg) return false;
        int wgid = (int)L; { const int q = nwg / NXCD, r = nwg % NXCD, xcd = wgid % NXCD, off = wgid / NXCD; wgid = (xcd < r ? xcd * (q + 1) : r * (q + 1) + (xcd - r) * q) + off; }
        const int nig = WGM * nN, gid = wgid / nig, fm = gid * WGM, gsz = (nM - fm) < WGM ? (nM - fm) : WGM;
        u.pm = fm + ((wgid % nig) % gsz); u.pn = (wgid % nig) / gsz; return true;
    }
    __device__ __forceinline__ void a_ready(const Unit&) const {}
    __device__ __forceinline__ void done(const Unit&) const {}
};

__device__ __forceinline__ unsigned cvt_pk_bf16(float lo, float hi) { unsigned r; asm volatile("v_cvt_pk_bf16_f32 %0, %1, %2" : "=v"(r) : "v"(lo), "v"(hi)); return r; }
template <class Epi, class Sched, bool ALIGN_EPI = false, bool SP2 = false>
__device__ __forceinline__ void gemm_phase(PG8_LAS unsigned char* lds, const Gemm g, const Sched& S, const Epi& E) {
    const int tid = threadIdx.x, wid = __builtin_amdgcn_readfirstlane(tid >> 6), lane = tid & 63, wr = wid >> 2, wc = wid & 3, fr = lane & 15, fq = lane >> 4;
    const int K = g.K, nt = K / BK;
    unsigned voffA[2], voffB[2];
#pragma unroll
    for (int i = 0; i < 2; ++i) { int R, C; stage_rc(tid * 16 + i * 8192, R, C); const int Rb = Epi::PERM ? ((R & ~31) + perm32(R & 31)) : R;
        voffA[i] = (unsigned)(R * K + C) * 2u; voffB[i] = (unsigned)(Rb * K + C) * 2u; }
    const size_t kstep = (size_t)(BK * 2);
    const size_t hstep = (size_t)HALF * K * 2;
    const size_t tstep = 2 * hstep;
    const unsigned ldsw = (unsigned)wid * 1024u;
    const int aoff = lds_byte(wr * 64 + fr, fq * 8), boff = lds_byte(wc * 32 + fr, fq * 8);
#define PG8_SA(b, h) (((b) * 2 + (h)) * HTB)
#define PG8_SB(b, h) ((4 + (b) * 2 + (h)) * HTB)
#define PG8_STAGE(bufoff, gbase, voff) do { _Pragma("unroll") for (int _i = 0; _i < 2; ++_i) \
        __builtin_amdgcn_global_load_lds((const unsigned*)((const char*)(gbase) + (voff)[_i]), (PG8_LAS unsigned*)(lds + (bufoff) + ldsw + _i * 8192), 16, 0, 0); } while (0)
#define PG8_LDA(dst, b, h) do { _Pragma("unroll") for (int m = 0; m < 4; ++m) _Pragma("unroll") for (int k = 0; k < 2; ++k) dst[m][k] = *(const PG8_LAS bf16x8*)(lds + PG8_SA(b, h) + aoff + m * 2048 + k * 1024); } while (0)
#define PG8_LDB(dst, b, h) do { _Pragma("unroll") for (int n = 0; n < 2; ++n) _Pragma("unroll") for (int k = 0; k < 2; ++k) dst[n][k] = *(const PG8_LAS bf16x8*)(lds + PG8_SB(b, h) + boff + n * 2048 + k * 1024); } while (0)
#define PG8_MMA(ai, bj, At, Bt) do { __builtin_amdgcn_s_setprio(1); _Pragma("unroll") for (int m = 0; m < 4; ++m) _Pragma("unroll") for (int n = 0; n < 2; ++n) _Pragma("unroll") for (int k = 0; k < 2; ++k) \
        acc[ai][bj][m][n] = __builtin_amdgcn_mfma_f32_16x16x32_bf16(Bt[n][k], At[m][k], acc[ai][bj][m][n], 0, 0, 0); __builtin_amdgcn_s_setprio(0); } while (0)
#define PG8_WAIT_V(n) asm volatile("s_waitcnt vmcnt(" #n ")" ::: "memory")
#define PG8_WAIT_L(n) asm volatile("s_waitcnt lgkmcnt(" #n ")" ::: "memory")
#define PG8_BAR __builtin_amdgcn_s_barrier()
#define PG8_SCHED __builtin_amdgcn_sched_barrier(0)
    Unit cur, nxt; int ui = 0;
    if (!S.next(0, cur)) return;
    f32x4 acc[2][2][4][2];
#pragma unroll
    for (int a = 0; a < 2; ++a)
#pragma unroll
        for (int b = 0; b < 2; ++b)
#pragma unroll
            for (int m = 0; m < 4; ++m)
#pragma unroll
                for (int n = 0; n < 2; ++n) acc[a][b][m][n] = (f32x4){0.f, 0.f, 0.f, 0.f};
    bf16x8 At[4][2], B0[2][2], B1[2][2];
    const char* cA = (const char*)g.A + (size_t)cur.pm * tstep; const char* cB = (const char*)g.Bt + (size_t)cur.pn * tstep;
    S.a_ready(cur);
    if constexpr (SP2) {
        PG8_STAGE(PG8_SB(0, 0), cB, voffB); PG8_STAGE(PG8_SB(0, 1), cB + hstep, voffB); PG8_STAGE(PG8_SA(0, 0), cA, voffA); PG8_STAGE(PG8_SA(0, 1), cA + hstep, voffA);
        if (wr == 1) PG8_BAR;
        PG8_WAIT_V(2); PG8_BAR;
        PG8_STAGE(PG8_SB(1, 0), cB + kstep, voffB); PG8_STAGE(PG8_SA(1, 0), cA + kstep, voffA); PG8_STAGE(PG8_SB(1, 1), cB + hstep + kstep, voffB);
        PG8_WAIT_V(6); PG8_BAR;
    } else {
        PG8_STAGE(PG8_SB(0, 0), cB, voffB); PG8_STAGE(PG8_SA(0, 0), cA, voffA); PG8_STAGE(PG8_SB(0, 1), cB + hstep, voffB); PG8_STAGE(PG8_SA(0, 1), cA + hstep, voffA);
        if (wr == 1) PG8_BAR;
        PG8_WAIT_V(4); PG8_BAR;
        PG8_STAGE(PG8_SB(1, 0), cB + kstep, voffB); PG8_STAGE(PG8_SA(1, 0), cA + kstep, voffA); PG8_STAGE(PG8_SB(1, 1), cB + hstep + kstep, voffB);
        PG8_WAIT_V(6); PG8_BAR;
    }
    for (;;) {
        const bool has_next = S.next(ui + 1, nxt);
        const char* nA = has_next ? (const char*)g.A + (size_t)nxt.pm * tstep : cA; const char* nB = has_next ? (const char*)g.Bt + (size_t)nxt.pn * tstep : cB;
        for (int t = 0; t < nt; t += 2) {
            const bool last = (t == nt - 2);
            const char* a1 = cA + (size_t)(t + 1) * kstep;
            const char* a2 = last ? nA : cA + (size_t)(t + 2) * kstep; const char* b2 = last ? nB : cB + (size_t)(t + 2) * kstep;
            const char* a3 = a2 + kstep; const char* b3 = b2 + kstep;
            if (last && has_next) S.a_ready(nxt);
            if constexpr (SP2) {
            PG8_LDB(B0, 0, 0); PG8_LDB(B1, 0, 1); PG8_SCHED; PG8_LDA(At, 0, 0); PG8_STAGE(PG8_SA(1, 1), a1 + hstep, voffA);
            PG8_WAIT_V(8); PG8_WAIT_L(0); PG8_BAR; PG8_MMA(0, 0, At, B0); PG8_MMA(0, 1, At, B1); PG8_BAR; PG8_SCHED;
            PG8_LDA(At, 0, 1); PG8_STAGE(PG8_SB(0, 0), b2, voffB); PG8_STAGE(PG8_SB(0, 1), b2 + hstep, voffB); PG8_STAGE(PG8_SA(0, 0), a2, voffA);
            PG8_WAIT_V(8); PG8_WAIT_L(0); PG8_BAR; PG8_MMA(1, 0, At, B0); PG8_MMA(1, 1, At, B1); PG8_BAR; PG8_SCHED;
            PG8_LDB(B0, 1, 0); PG8_LDB(B1, 1, 1); PG8_SCHED; PG8_LDA(At, 1, 0); PG8_STAGE(PG8_SA(0, 1), a2 + hstep, voffA);
            PG8_WAIT_V(8); PG8_WAIT_L(0); PG8_BAR; PG8_MMA(0, 0, At, B0); PG8_MMA(0, 1, At, B1); PG8_BAR; PG8_SCHED;
            PG8_LDA(At, 1, 1); PG8_STAGE(PG8_SB(1, 0), b3, voffB); PG8_STAGE(PG8_SB(1, 1), b3 + hstep, voffB); PG8_STAGE(PG8_SA(1, 0), a3, voffA);
            PG8_WAIT_V(8); PG8_WAIT_L(0); PG8_BAR; PG8_MMA(1, 0, At, B0); PG8_MMA(1, 1, At, B1); PG8_BAR; PG8_SCHED;
            } else {
            PG8_LDB(B0, 0, 0); PG8_SCHED; PG8_LDA(At, 0, 0); PG8_STAGE(PG8_SA(1, 1), a1 + hstep, voffA);
            PG8_WAIT_L(8); PG8_BAR; PG8_WAIT_L(0); PG8_MMA(0, 0, At, B0); PG8_BAR; PG8_SCHED;
            PG8_LDB(B1, 0, 1); PG8_STAGE(PG8_SB(0, 0), b2, voffB);
            PG8_BAR; PG8_WAIT_L(0); PG8_MMA(0, 1, At, B1); PG8_BAR;
            PG8_LDA(At, 0, 1); PG8_STAGE(PG8_SA(0, 0), a2, voffA);
            PG8_BAR; PG8_WAIT_L(0); PG8_MMA(1, 0, At, B0); PG8_BAR; PG8_SCHED;
            PG8_STAGE(PG8_SB(0, 1), b2 + hstep, voffB);
            PG8_WAIT_V(6); PG8_BAR; PG8_MMA(1, 1, At, B1); PG8_BAR;
            PG8_LDB(B0, 1, 0); PG8_SCHED; PG8_LDA(At, 1, 0); PG8_STAGE(PG8_SA(0, 1), a2 + hstep, voffA);
            PG8_WAIT_L(8); PG8_BAR; PG8_WAIT_L(0); PG8_MMA(0, 0, At, B0); PG8_BAR; PG8_SCHED;
            PG8_LDB(B1, 1, 1); PG8_STAGE(PG8_SB(1, 0), b3, voffB);
            PG8_BAR; PG8_WAIT_L(0); PG8_MMA(0, 1, At, B1); PG8_BAR;
            PG8_LDA(At, 1, 1); PG8_STAGE(PG8_SA(1, 0), a3, voffA);
            PG8_BAR; PG8_WAIT_L(0); PG8_MMA(1, 0, At, B0); PG8_BAR; PG8_SCHED;
            PG8_STAGE(PG8_SB(1, 1), b3 + hstep, voffB);
            PG8_WAIT_V(6); PG8_BAR; PG8_MMA(1, 1, At, B1); PG8_BAR;
            }
        }
        if constexpr (ALIGN_EPI) { if (wr == 0) PG8_BAR; }
        if constexpr (!Epi::AFTER_DRAIN) { E(acc, cur, wr, wc, fr, fq); S.done(cur); }
        if (!has_next) break;
#pragma unroll
        for (int a = 0; a < 2; ++a)
#pragma unroll
            for (int b = 0; b < 2; ++b)
#pragma unroll
                for (int m = 0; m < 4; ++m)
#pragma unroll
                    for (int n = 0; n < 2; ++n) acc[a][b][m][n] = (f32x4){0.f, 0.f, 0.f, 0.f};
        cur = nxt; cA = nA; cB = nB; ++ui;
        if constexpr (ALIGN_EPI) { if (wr == 1) PG8_BAR; }
    }
    PG8_WAIT_V(0);
    if constexpr (!ALIGN_EPI) { if (wr == 0) PG8_BAR; }
    PG8_BAR;
    if constexpr (Epi::AFTER_DRAIN) { E.fused(acc, cur, wr, wc, fr, fq, lds, wid, lane); S.done(cur); }
#undef PG8_SA
#undef PG8_SB
#undef PG8_STAGE
#undef PG8_LDA
#undef PG8_LDB
#undef PG8_MMA
#undef PG8_WAIT_V
#undef PG8_WAIT_L
#undef PG8_BAR
#undef PG8_SCHED
}
}

namespace pg8 {
template <int RELU2, int SCALE = 0> struct EpiStore {
    static constexpr bool PERM = true, AFTER_DRAIN = false;
    bf16_t* O; int ldc; const PG8_LAS float* rstd; mutable int cnt;
    __device__ __forceinline__ void operator()(const f32x4 (&acc)[2][2][4][2], const Unit& u, int wr, int wc, int fr, int fq) const {
        const int row0 = u.pm * BM + wr * 64 + fr, col0 = u.pn * BM + wc * 32 + 8 * fq;
#pragma unroll
        for (int ai = 0; ai < 2; ++ai)
#pragma unroll
            for (int m = 0; m < 4; ++m) { const int row = row0 + ai * HALF + m * 16; bf16_t* rowp = O + (size_t)row * ldc + col0;
                float rs = 1.f;
                if (SCALE) rs = rstd[cnt * 256 + wr * 64 + fr + ai * HALF + m * 16];
#pragma unroll
                for (int bj = 0; bj < 2; ++bj) { f32x4 v0 = acc[ai][bj][m][0] * rs, v1 = acc[ai][bj][m][1] * rs;
                    if (RELU2) {
#pragma unroll
                        for (int e = 0; e < 4; ++e) { const float a = fmaxf(v0[e], 0.f), b = fmaxf(v1[e], 0.f); v0[e] = a * a; v1[e] = b * b; } }
                    u32x4 w; w.x = cvt_pk_bf16(v0[0], v0[1]); w.y = cvt_pk_bf16(v0[2], v0[3]); w.z = cvt_pk_bf16(v1[0], v1[1]); w.w = cvt_pk_bf16(v1[2], v1[3]);
                    *(u32x4*)(rowp + bj * HALF) = w; } }
        if (SCALE) ++cnt;
    }
};

struct EpiStoreAB {
    static constexpr bool PERM = true, AFTER_DRAIN = false;
    bf16_t* O; int ldc; unsigned* kn2;
    __device__ __forceinline__ void operator()(const f32x4 (&acc)[2][2][4][2], const Unit& u, int wr, int wc, int fr, int fq) const {
        const int row0 = u.pm * BM + wr * 64 + fr, col0 = u.pn * BM + wc * 32 + 8 * fq;
#pragma unroll
        for (int ai = 0; ai < 2; ++ai)
#pragma unroll
            for (int m = 0; m < 4; ++m) { bf16_t* rowp = O + (size_t)(row0 + ai * HALF + m * 16) * ldc + col0;
#pragma unroll
                for (int bj = 0; bj < 2; ++bj) { const f32x4 v0 = acc[ai][bj][m][0], v1 = acc[ai][bj][m][1];
                    u32x4 w; w.x = cvt_pk_bf16(v0[0], v0[1]); w.y = cvt_pk_bf16(v0[2], v0[3]); w.z = cvt_pk_bf16(v1[0], v1[1]); w.w = cvt_pk_bf16(v1[2], v1[3]);
                    *(u32x4*)(rowp + bj * HALF) = w; } }
        if (u.pn == 2 || u.pn == 3) {
#pragma unroll
            for (int bj = 0; bj < 2; ++bj) { float mx = 0.f;
#pragma unroll
                for (int ai = 0; ai < 2; ++ai)
#pragma unroll
                    for (int m = 0; m < 4; ++m) { const f32x4 v0 = acc[ai][bj][m][0], v1 = acc[ai][bj][m][1];
                        float s = ((v0[0] * v0[0] + v0[1] * v0[1]) + (v0[2] * v0[2] + v0[3] * v0[3])) + ((v1[0] * v1[0] + v1[1] * v1[1]) + (v1[2] * v1[2] + v1[3] * v1[3]));
                        s += __shfl_xor(s, 16); s += __shfl_xor(s, 32); mx = fmaxf(mx, s); }
                mx = fmaxf(mx, __shfl_xor(mx, 1)); mx = fmaxf(mx, __shfl_xor(mx, 2)); mx = fmaxf(mx, __shfl_xor(mx, 4)); mx = fmaxf(mx, __shfl_xor(mx, 8));
                const int colb = u.pn * BM + bj * HALF + wc * 32 - 512, head = colb >> 6, half = (colb >> 5) & 1, b = u.pm >> 4;
                if (fr == 0 && fq == 0) atomicMax(kn2 + ((b * 8 + head) * 2 + half), __float_as_uint(mx * 1.02f)); }
        }
    }
};
struct EpiResid {
    static constexpr bool PERM = false, AFTER_DRAIN = false;
    const float* base; float* out; int ldc;
    __device__ __forceinline__ void operator()(const f32x4 (&acc)[2][2][4][2], const Unit& u, int wr, int wc, int fr, int fq) const {
        const int row0 = u.pm * BM + wr * 64 + fr, col0 = u.pn * BM + wc * 32 + 4 * fq;
#pragma unroll
        for (int ai = 0; ai < 2; ++ai)
#pragma unroll
            for (int m = 0; m < 4; ++m) { const size_t off = (size_t)(row0 + ai * HALF + m * 16) * ldc + col0;
#pragma unroll
                for (int bj = 0; bj < 2; ++bj)
#pragma unroll
                    for (int n = 0; n < 2; ++n) { const size_t o = off + bj * HALF + n * 16; const f32x4 bs = *(const f32x4*)(base + o); *(f32x4*)(out + o) = bs + acc[ai][bj][m][n]; } }
    }
};

struct EpiResidN {
    static constexpr bool PERM = false, AFTER_DRAIN = false;
    const float* base; float* out; bf16_t* xn; float* ssq; int ldc;
    __device__ __forceinline__ void operator()(const f32x4 (&acc)[2][2][4][2], const Unit& u, int wr, int wc, int fr, int fq) const {
        typedef unsigned u32x2 __attribute__((ext_vector_type(2)));
        const int row0 = u.pm * BM + wr * 64 + fr, col0 = u.pn * BM + wc * 32 + 4 * fq;
#pragma unroll
        for (int ai = 0; ai < 2; ++ai)
#pragma unroll
            for (int m = 0; m < 4; ++m) { const int row = row0 + ai * HALF + m * 16; const size_t off = (size_t)row * ldc + col0; float s = 0.f;
#pragma unroll
                for (int bj = 0; bj < 2; ++bj)
#pragma unroll
                    for (int n = 0; n < 2; ++n) { const size_t o = off + bj * HALF + n * 16; const f32x4 v = *(const f32x4*)(base + o) + acc[ai][bj][m][n]; *(f32x4*)(out + o) = v;
                        u32x2 w; w.x = cvt_pk_bf16(v[0], v[1]); w.y = cvt_pk_bf16(v[2], v[3]); *(u32x2*)(xn + o) = w;
                        s += (v[0] * v[0] + v[1] * v[1]) + (v[2] * v[2] + v[3] * v[3]); }
                s += __shfl_xor(s, 16); s += __shfl_xor(s, 32);
                if (fq == 0) ssq[(size_t)row * 16 + u.pn * 4 + wc] = s; }
    }
};
struct EpiQRope {
    static constexpr bool PERM = false, AFTER_DRAIN = false;
    bf16_t* O; int ldc; const float* tab;
    __device__ __forceinline__ void operator()(const f32x4 (&acc)[2][2][4][2], const Unit& u, int wr, int wc, int fr, int fq) const {
        typedef unsigned u32x2 __attribute__((ext_vector_type(2)));
        const int row0 = u.pm * BM + wr * 64 + fr;
#pragma unroll
        for (int ai = 0; ai < 2; ++ai)
#pragma unroll
            for (int m = 0; m < 4; ++m) { const int row = row0 + ai * HALF + m * 16;
                const f32x4 cs = *(const f32x4*)(tab + (size_t)row * 32 + 4 * fq), sn = *(const f32x4*)(tab + (size_t)row * 32 + 16 + 4 * fq);
#pragma unroll
                for (int bj = 0; bj < 2; ++bj) { const int cgp = u.pn * BM + bj * HALF + wc * 32;
                    f32x4 x1 = acc[ai][bj][m][0], x2 = acc[ai][bj][m][1];
                    if ((cgp % 96) == 64) { const f32x4 o1 = x1 * cs - x2 * sn, o2 = x2 * cs + x1 * sn; x1 = o1; x2 = o2; }
                    bf16_t* op = O + (size_t)row * ldc + cgp + 4 * fq;
                    u32x2 w1, w2; w1.x = cvt_pk_bf16(x1[0], x1[1]); w1.y = cvt_pk_bf16(x1[2], x1[3]); w2.x = cvt_pk_bf16(x2[0], x2[1]); w2.y = cvt_pk_bf16(x2[2], x2[3]);
                    *(u32x2*)op = w1; *(u32x2*)(op + 16) = w2; }
                asm volatile("" ::: "memory"); }
    }
};
}

#define DI __device__ __forceinline__
#define LAS __attribute__((address_space(3)))
typedef unsigned short bf16_t;
typedef short bf16x8 __attribute__((ext_vector_type(8)));
typedef short s16x4 __attribute__((ext_vector_type(4)));
typedef float f32x4 __attribute__((ext_vector_type(4)));
typedef float f32x16 __attribute__((ext_vector_type(16)));
typedef unsigned u32x4 __attribute__((ext_vector_type(4)));
typedef unsigned u32x2 __attribute__((ext_vector_type(2)));

constexpr int BATCH = 4, SEQ = 4096, DM = 1024, MT = BATCH * SEQ, DFF = 4096;
constexpr int LD_AB = 3072, LD_CD = 2304, NSRC_AB = 3080, NSRC_CD = 2208;
constexpr int NWAVES = 8, NTHREADS = 512;
constexpr float LOG2E = 1.4426950408889634f, LN2 = 0.6931471805599453f, EPS = 1e-6f;
constexpr size_t MiB = 1u << 20;
constexpr size_t WS_WINAB = 0, WS_WOUTAB = 6 * MiB, WS_WINCD = 8 * MiB, WS_WUQ = 13 * MiB, WS_WUKV = 14 * MiB, WS_WOUTCD = 15 * MiB;
constexpr size_t WS_WUP0 = 17 * MiB, WS_WUP1 = 25 * MiB, WS_WDN0 = 33 * MiB, WS_WDN1 = 41 * MiB;
constexpr size_t WS_LOGF = 49 * MiB, WS_CUM = 49 * MiB + 512 * 1024, WS_TAB = 50 * MiB, WS_KR = 52 * MiB, WS_SSQ = 53 * MiB;
constexpr size_t WS_XN = 54 * MiB, WS_CQN = 54 * MiB, WS_CKVN = 66 * MiB, WS_O = 86 * MiB;
constexpr size_t WS_BIG = 118 * MiB, WS_QF = 190 * MiB, WS_KVF = 214 * MiB, WS_CTL = 246 * MiB, CTL_BYTES = 65536, CTL_KN2 = 32768, WS_END = 247 * MiB;
constexpr int LDS_BYTES = 147456, MISC_OFF = 131072 + 320;

DI float bf2f(unsigned short v) { return __uint_as_float((unsigned)v << 16); }
DI unsigned pk2(float lo, float hi) { typedef float f2 __attribute__((ext_vector_type(2))); typedef __bf16 b2 __attribute__((ext_vector_type(2))); f2 v = {lo, hi}; b2 b = __builtin_convertvector(v, b2); return __builtin_bit_cast(unsigned, b); }
DI float wave_sum(float v) {
#pragma unroll
    for (int o = 1; o < 64; o <<= 1) v += __shfl_xor(v, o);
    return v;
}
DI float fexp2(float x) { return __builtin_amdgcn_exp2f(x); }
DI float flog2(float x) { return __builtin_amdgcn_logf(x); }

DI void transpose_item(const float* W, int K, int ldn, int src_col0, bf16_t* WT, int dst_row0, int nblk, LAS float* scr, int item, int lane, const float* gain) {
    const int kb = item / nblk, nb = item % nblk, k0 = 64 * kb, n0 = 32 * nb;
    float wv[32];
#pragma unroll
    for (int i = 0; i < 32; ++i) { const int kk = 2 * i + (lane >> 5); wv[i] = W[(size_t)(k0 + kk) * ldn + src_col0 + n0 + (lane & 31)]; }
    if (gain) {
#pragma unroll
        for (int i = 0; i < 32; ++i) wv[i] *= gain[k0 + 2 * i + (lane >> 5)]; }
#pragma unroll
    for (int i = 0; i < 32; ++i) { const int kk = 2 * i + (lane >> 5); scr[kk * 33 + (lane & 31)] = wv[i]; }
    asm volatile("s_waitcnt lgkmcnt(0)" ::: "memory");
    const int c = lane & 7;
#pragma unroll
    for (int j = 0; j < 4; ++j) { const int n = (lane >> 3) + 8 * j; const LAS float* s = scr + (8 * c) * 33 + n;
        u32x4 o; o.x = pk2(s[0 * 33], s[1 * 33]); o.y = pk2(s[2 * 33], s[3 * 33]); o.z = pk2(s[4 * 33], s[5 * 33]); o.w = pk2(s[6 * 33], s[7 * 33]);
        *(u32x4*)(WT + (size_t)(dst_row0 + n0 + n) * K + k0 + 8 * c) = o; }
    asm volatile("s_waitcnt lgkmcnt(0)" ::: "memory");
}

DI void sincos_d(double a, float& sn, float& cs);
DI float inv_freq_f(int i);
template <bool FA> DI void norm_rows_bf16(const float* src, const float* gain, bf16_t* dst, int gw, int ngw, int lane, const LAS float* wfaT, const float* b_forget, float* logf_out, const int* pos, float* tab) {
    f32x4 g[4];
#pragma unroll
    for (int j = 0; j < 4; ++j) g[j] = ((const f32x4*)gain)[64 * j + lane];
    f32x4 nx[4];
    if (gw < MT) {
#pragma unroll
        for (int j = 0; j < 4; ++j) nx[j] = ((const f32x4*)(src + (size_t)gw * DM) + lane)[64 * j]; }
    for (int row = gw; row < MT; row += ngw) {
        f32x4 v[4]; float s = 0.f;
#pragma unroll
        for (int j = 0; j < 4; ++j) v[j] = nx[j];
        if (row + ngw < MT) {
#pragma unroll
            for (int j = 0; j < 4; ++j) nx[j] = ((const f32x4*)(src + (size_t)(row + ngw) * DM) + lane)[64 * j]; }
#pragma unroll
        for (int j = 0; j < 4; ++j) { s += (v[j].x * v[j].x + v[j].y * v[j].y) + (v[j].z * v[j].z + v[j].w * v[j].w); v[j] = v[j] * g[j]; }
        float a8[8];
        if (FA) {
#pragma unroll
            for (int jj = 0; jj < 8; ++jj) { float a = 0.f;
#pragma unroll
                for (int j = 0; j < 4; ++j) { const f32x4 w = *(const LAS f32x4*)(wfaT + jj * 1024 + 256 * j + 4 * lane); a += (v[j].x * w.x + v[j].y * w.y) + (v[j].z * w.z + v[j].w * w.w); }
                a8[jj] = a; }
        }
        const float rstd = 1.0f / sqrtf(wave_sum(s) * (1.f / DM) + EPS);
        unsigned long long* o8 = (unsigned long long*)(dst + (size_t)row * DM) + lane;
#pragma unroll
        for (int j = 0; j < 4; ++j) { const f32x4 y = v[j] * rstd; o8[64 * j] = (unsigned long long)pk2(y.x, y.y) | ((unsigned long long)pk2(y.z, y.w) << 32); }
        if (FA) {
            float b4[4], c2[2], d;
            { const bool up = (lane & 32) != 0;
#pragma unroll
              for (int i = 0; i < 4; ++i) { const float keep = up ? a8[i + 4] : a8[i], send = up ? a8[i] : a8[i + 4]; b4[i] = keep + __shfl_xor(send, 32); } }
            { const bool up = (lane & 16) != 0;
#pragma unroll
              for (int i = 0; i < 2; ++i) { const float keep = up ? b4[i + 2] : b4[i], send = up ? b4[i] : b4[i + 2]; c2[i] = keep + __shfl_xor(send, 16); } }
            { const bool up = (lane & 8) != 0; const float keep = up ? c2[1] : c2[0], send = up ? c2[0] : c2[1]; d = keep + __shfl_xor(send, 8); }
            d += __shfl_xor(d, 4); d += __shfl_xor(d, 2); d += __shfl_xor(d, 1);
            if ((lane & 7) == 0) { const int j = lane >> 3; const float t = d * rstd + b_forget[j]; const float ls = fminf(t, 0.f) - log1pf(expf(-fabsf(t))); logf_out[(size_t)row * 8 + j] = ls; }
            if (lane < 16) { const float ang = (float)pos[row] * inv_freq_f(lane); float sn, cs; sincos_d((double)ang, sn, cs); tab[(size_t)row * 32 + lane] = cs; tab[(size_t)row * 32 + 16 + lane] = sn; }
        }
    }
}
DI void norm_rows_f32(float* buf, const float* gain, int gw, int ngw, int lane) {
    f32x4 g[4];
#pragma unroll
    for (int j = 0; j < 4; ++j) g[j] = ((const f32x4*)gain)[64 * j + lane];
    for (int row = gw; row < MT; row += ngw) {
        f32x4* xr = (f32x4*)(buf + (size_t)row * DM) + lane;
        f32x4 v[4]; float s = 0.f;
#pragma unroll
        for (int j = 0; j < 4; ++j) { v[j] = xr[64 * j]; s += (v[j].x * v[j].x + v[j].y * v[j].y) + (v[j].z * v[j].z + v[j].w * v[j].w); }
        const float rstd = 1.0f / sqrtf(wave_sum(s) * (1.f / DM) + EPS);
#pragma unroll
        for (int j = 0; j < 4; ++j) xr[64 * j] = v[j] * rstd * g[j];
    }
}

DI void sincos_d(double a, float& sn, float& cs) {
    const double n = rint(a * 0.63661977236758134308);
    const double r = fma(-n, 1.5707963267948966192, a) - n * 6.123233995736766e-17;
    const double r2 = r * r;
    double sp = -2.5052108385441718775e-8; sp = sp * r2 + 2.7557319223985890653e-6; sp = sp * r2 - 1.9841269841269841270e-4; sp = sp * r2 + 8.3333333333333333333e-3; sp = sp * r2 - 1.6666666666666666667e-1; sp = r + r * r2 * sp;
    double cp = 2.0876756987868098979e-9; cp = cp * r2 - 2.7557319223985890653e-7; cp = cp * r2 + 2.4801587301587301587e-5; cp = cp * r2 - 1.3888888888888888889e-3; cp = cp * r2 + 4.1666666666666666667e-2; cp = cp * r2 - 0.5; cp = 1.0 + r2 * cp;
    const int q = (int)((long long)n & 3);
    const double s_ = (q == 0) ? sp : (q == 1) ? cp : (q == 2) ? -sp : -cp;
    const double c_ = (q == 0) ? cp : (q == 1) ? -sp : (q == 2) ? -cp : sp;
    sn = (float)s_; cs = (float)c_;
}
DI float inv_freq_f(int i) {
    float r = 1.0f;
    r = (i == 1) ? 0.56234132519034908f : r;
    r = (i == 2) ? 0.31622776601683794f : r;
    r = (i == 3) ? 0.17782794100389228f : r;
    r = (i == 4) ? 0.1f : r;
    r = (i == 5) ? 0.056234132519034911f : r;
    r = (i == 6) ? 0.031622776601683791f : r;
    r = (i == 7) ? 0.017782794100389229f : r;
    r = (i == 8) ? 0.01f : r;
    r = (i == 9) ? 0.0056234132519034910f : r;
    r = (i == 10) ? 0.0031622776601683794f : r;
    r = (i == 11) ? 0.0017782794100389228f : r;
    r = (i == 12) ? 0.001f : r;
    r = (i == 13) ? 0.00056234132519034907f : r;
    r = (i == 14) ? 0.00031622776601683794f : r;
    r = (i == 15) ? 0.00017782794100389227f : r;
    return r;
}
DI void mla_prep_rows(const bf16_t* PC, const int* pos, const float* q_norm, const float* kv_norm, bf16_t* cqn, bf16_t* ckvn, float* tab, bf16_t* KR, int gw, int ngw, int lane) {
    for (int row = gw; row < MT; row += ngw) {
        const bf16_t* pr = PC + (size_t)row * LD_CD;
        {
            float v[8]; float s = 0.f;
            if (lane < 48) { const u32x4 w = *(const u32x4*)(pr + 1536 + 8 * lane);
#pragma unroll
                for (int e = 0; e < 4; ++e) { v[2 * e] = __uint_as_float(w[e] << 16); v[2 * e + 1] = __uint_as_float(w[e] & 0xffff0000u); s += v[2 * e] * v[2 * e] + v[2 * e + 1] * v[2 * e + 1]; } }
            else {
#pragma unroll
                for (int e = 0; e < 8; ++e) v[e] = 0.f; }
            const float rstd = 1.0f / sqrtf(wave_sum(s) * (1.f / 384.f) + EPS);
            if (lane < 48) { const f32x4 g0 = *(const f32x4*)(q_norm + 8 * lane), g1 = *(const f32x4*)(q_norm + 8 * lane + 4);
                u32x4 o; o.x = pk2(v[0] * rstd * g0.x, v[1] * rstd * g0.y); o.y = pk2(v[2] * rstd * g0.z, v[3] * rstd * g0.w); o.z = pk2(v[4] * rstd * g1.x, v[5] * rstd * g1.y); o.w = pk2(v[6] * rstd * g1.z, v[7] * rstd * g1.w);
                *(u32x4*)(cqn + (size_t)row * 384 + 8 * lane) = o; }
        }
        {
            float v[8]; float s = 0.f;
            if (lane < 32) { const u32x4 w = *(const u32x4*)(pr + 1920 + 8 * lane);
#pragma unroll
                for (int e = 0; e < 4; ++e) { v[2 * e] = __uint_as_float(w[e] << 16); v[2 * e + 1] = __uint_as_float(w[e] & 0xffff0000u); s += v[2 * e] * v[2 * e] + v[2 * e + 1] * v[2 * e + 1]; } }
            else {
#pragma unroll
                for (int e = 0; e < 8; ++e) v[e] = 0.f; }
            const float rstd = 1.0f / sqrtf(wave_sum(s) * (1.f / 256.f) + EPS);
            if (lane < 32) { const f32x4 g0 = *(const f32x4*)(kv_norm + 8 * lane), g1 = *(const f32x4*)(kv_norm + 8 * lane + 4);
                u32x4 o; o.x = pk2(v[0] * rstd * g0.x, v[1] * rstd * g0.y); o.y = pk2(v[2] * rstd * g0.z, v[3] * rstd * g0.w); o.z = pk2(v[4] * rstd * g1.x, v[5] * rstd * g1.y); o.w = pk2(v[6] * rstd * g1.z, v[7] * rstd * g1.w);
                *(u32x4*)(ckvn + (size_t)row * 256 + 8 * lane) = o; }
        }
        if (lane < 16) {
            const float cs = tab[(size_t)row * 32 + lane], sn = tab[(size_t)row * 32 + 16 + lane];
            const float x1 = bf2f(pr[2176 + lane]), x2 = bf2f(pr[2176 + 16 + lane]);
            KR[(size_t)row * 32 + lane] = (bf16_t)(pk2(x1 * cs - x2 * sn, 0.f) & 0xffffu);
            KR[(size_t)row * 32 + 16 + lane] = (bf16_t)(pk2(x2 * cs + x1 * sn, 0.f) & 0xffffu);
        }
    }
}

namespace att {
constexpr int KBUF = 13312, VBUF = 9216;
constexpr int OFF_K = 0, OFF_V = 2 * KBUF, OFF_C = OFF_V + 2 * VBUF, OFF_RB = OFF_C + 512, OFF_FLAG = OFF_RB + 1280, ATT_LDS = OFF_FLAG + 64;
DI f32x16 mfma(bf16x8 a, bf16x8 b, f32x16 c) { return __builtin_amdgcn_mfma_f32_32x32x16_bf16(a, b, c, 0, 0, 0); }
DI int crow(int i, int hh) { return (i & 3) + 8 * (i >> 2) + 4 * hh; }
DI bf16x8 packfrag(const f32x16& p, int s) { u32x4 w; w.x = pk2(p[8 * s], p[8 * s + 1]); w.y = pk2(p[8 * s + 2], p[8 * s + 3]); w.z = pk2(p[8 * s + 4], p[8 * s + 5]); w.w = pk2(p[8 * s + 6], p[8 * s + 7]); return __builtin_bit_cast(bf16x8, w); }
typedef short v4i16_t __attribute__((ext_vector_type(4)));
DI s16x4 vtr(const LAS unsigned char* p) { return __builtin_bit_cast(s16x4, __builtin_amdgcn_ds_read_tr16_b64_v4i16((LAS v4i16_t*)p)); }

struct Lane { int tid, lane, wid, r, hh, q4, p4, blk, srow, sch; };
DI Lane mklane() { Lane L; L.tid = threadIdx.x; L.lane = L.tid & 63; L.wid = __builtin_amdgcn_readfirstlane(L.tid >> 6); L.r = L.lane & 31; L.hh = L.lane >> 5;
    const int i16 = L.lane & 15; L.q4 = i16 >> 2; L.p4 = i16 & 3; L.blk = (L.lane >> 4) & 1; L.srow = L.tid >> 3; L.sch = L.tid & 7; return L; }

template <int NDS, int KSTRIDE> DI void qk_tile(f32x16& p0, f32x16& p1, const LAS unsigned char* Kb, const bf16x8* qf, const Lane& L) {
    const LAS unsigned char* ka = Kb + L.r * KSTRIDE + L.hh * 16;
#pragma unroll
    for (int i = 0; i < 16; ++i) { p0[i] = 0.f; p1[i] = 0.f; }
#pragma unroll
    for (int ds = 0; ds < NDS; ++ds) {
        const bf16x8 a0 = *(const LAS bf16x8*)(ka + ds * 32), a1 = *(const LAS bf16x8*)(ka + 32 * KSTRIDE + ds * 32);
        p0 = mfma(a0, qf[ds], p0); p1 = mfma(a1, qf[ds], p1); }
}
DI void pv_tile(f32x16& o0, f32x16& o1, const LAS unsigned char* Vb, const bf16x8 (&pf)[4], const Lane& L) {
    const LAS unsigned char* vb = Vb + (4 * L.hh + L.q4) * 144 + (16 * L.blk + 4 * L.p4) * 2;
#pragma unroll
    for (int f = 0; f < 4; ++f) { const LAS unsigned char* base = vb + (16 * f) * 144;
        { const s16x4 lo = vtr(base), hi = vtr(base + 8 * 144); const bf16x8 vf = __builtin_shufflevector(lo, hi, 0, 1, 2, 3, 4, 5, 6, 7); o0 = mfma(vf, pf[f], o0); }
        { const s16x4 lo = vtr(base + 64), hi = vtr(base + 8 * 144 + 64); const bf16x8 vf = __builtin_shufflevector(lo, hi, 0, 1, 2, 3, 4, 5, 6, 7); o1 = mfma(vf, pf[f], o1); } }
}
DI void online_softmax(f32x16& p0, f32x16& p1, float& m, float& l, f32x16& o0, f32x16& o1, bf16x8 (&pf)[4]) {
    float mt = fmaxf(p0[0], p1[0]);
#pragma unroll
    for (int i = 1; i < 16; ++i) mt = fmaxf(mt, fmaxf(p0[i], p1[i]));
    mt = fmaxf(mt, __shfl_xor(mt, 32));
    if (__any(mt > m)) {
        const float mn = fmaxf(m, mt), alpha = fexp2(m - mn); m = mn; l *= alpha;
#pragma unroll
        for (int i = 0; i < 16; ++i) { o0[i] *= alpha; o1[i] *= alpha; }
    }
    float rs = 0.f;
#pragma unroll
    for (int i = 0; i < 16; ++i) { p0[i] = fexp2(p0[i] - m); p1[i] = fexp2(p1[i] - m); rs += p0[i] + p1[i]; }
    l += rs;
    pf[0] = packfrag(p0, 0); pf[1] = packfrag(p0, 1); pf[2] = packfrag(p1, 0); pf[3] = packfrag(p1, 1);
}
DI void store_o(bf16_t* orow, const f32x16& o0, const f32x16& o1, float inv, int hh) {
#pragma unroll
    for (int g = 0; g < 4; ++g) {
        u32x2 w0, w1; w0.x = pk2(o0[4 * g] * inv, o0[4 * g + 1] * inv); w0.y = pk2(o0[4 * g + 2] * inv, o0[4 * g + 3] * inv);
        w1.x = pk2(o1[4 * g] * inv, o1[4 * g + 1] * inv); w1.y = pk2(o1[4 * g + 2] * inv, o1[4 * g + 3] * inv);
        *(u32x2*)(orow + 8 * g + 4 * hh) = w0; *(u32x2*)(orow + 32 + 8 * g + 4 * hh) = w1; }
}

DI void fox_unit(LAS unsigned char* lds, const bf16_t* PA, const float* cum, const unsigned* kn2, bf16_t* O, int b, int h, int qb) {
    const Lane L = mklane();
    const size_t rowbase = (size_t)b * SEQ;
    const int q0 = qb * 256, q0w = q0 + L.wid * 32, myq = q0w + L.r;
    const bf16_t* Qp = PA + (rowbase + myq) * LD_AB + h * 64;
    const bf16_t* Kp = PA + rowbase * LD_AB + 512 + h * 64;
    const bf16_t* Vp = Kp + 512;
    const float* cumh = cum + (size_t)(b * 8 + h) * SEQ;
    bf16x8 qf[4];
#pragma unroll
    for (int ds = 0; ds < 4; ++ds) qf[ds] = *(const bf16x8*)(Qp + 16 * ds + 8 * L.hh);
    const float c1 = 0.125f * LOG2E;
    float qn2 = 0.f;
#pragma unroll
    for (int ds = 0; ds < 4; ++ds)
#pragma unroll
        for (int j = 0; j < 8; ++j) { const float qv = bf2f((unsigned short)qf[ds][j]); qn2 += qv * qv; }
    qn2 += __shfl_xor(qn2, 32);
    const float kmax2 = __uint_as_float(kn2[(b * 8 + h) * 2]) + __uint_as_float(kn2[(b * 8 + h) * 2 + 1]);
    const float smax = sqrtf(qn2 * kmax2) * c1 * 1.01f + 1e-3f;
    const int NT = (q0 + 256) / 64;
    float m = -INFINITY, l = 0.f; f32x16 o0, o1;
#pragma unroll
    for (int i = 0; i < 16; ++i) { o0[i] = 0.f; o1[i] = 0.f; }
    bool seen = false;
    LAS int* flags = (LAS int*)(lds + OFF_FLAG);
    u32x4 kreg, vreg; float creg = 0.f;
#define FOX_LOAD(t) do { kreg = *(const u32x4*)(Kp + (size_t)((t) * 64 + L.srow) * LD_AB + L.sch * 8); vreg = *(const u32x4*)(Vp + (size_t)((t) * 64 + L.srow) * LD_AB + L.sch * 8); \
        if (L.tid < 64) creg = cumh[(t) * 64 + L.tid] * (-LOG2E); } while (0)
#define FOX_WRITE(bf) do { *(LAS u32x4*)(lds + OFF_K + (bf) * KBUF + L.srow * 144 + L.sch * 16) = kreg; *(LAS u32x4*)(lds + OFF_V + (bf) * VBUF + L.srow * 144 + L.sch * 16) = vreg; \
        if (L.tid < 64) *(LAS float*)(lds + OFF_C + (bf) * 256 + L.tid * 4) = creg; } while (0)
    FOX_LOAD(NT - 1); FOX_WRITE(0); __syncthreads();
    for (int it = 0; it < NT; ++it) {
        const int t = NT - 1 - it, k0 = t * 64, bf = it & 1;
        if (t > 0) FOX_LOAD(t - 1);
        bool done = false;
        if (k0 <= q0w + 31) {
            const LAS unsigned char* Cb = lds + OFF_C + bf * 256;
            const float nck_last = *(const LAS float*)(Cb + 63 * 4);
            done = seen && __all(smax + nck_last - m < -40.0f);
            if (!done) {
                f32x16 p0, p1;
                qk_tile<4, 144>(p0, p1, lds + OFF_K + bf * KBUF, qf, L);
#pragma unroll
                for (int g = 0; g < 4; ++g) { const f32x4 ca = *(const LAS f32x4*)(Cb + (8 * g + 4 * L.hh) * 4), cb = *(const LAS f32x4*)(Cb + (32 + 8 * g + 4 * L.hh) * 4);
#pragma unroll
                    for (int e = 0; e < 4; ++e) { p0[4 * g + e] = fmaf(p0[4 * g + e], c1, ca[e]); p1[4 * g + e] = fmaf(p1[4 * g + e], c1, cb[e]); } }
                if (k0 + 63 > q0w) {
#pragma unroll
                    for (int i = 0; i < 16; ++i) { const int key = k0 + crow(i, L.hh); if (key > myq) p0[i] = -INFINITY; if (key + 32 > myq) p1[i] = -INFINITY; } }
                bf16x8 pf[4];
                online_softmax(p0, p1, m, l, o0, o1, pf);
                pv_tile(o0, o1, lds + OFF_V + bf * VBUF, pf, L);
                seen = true;
            }
        }
        if (L.lane == 0) flags[(it & 1) * 8 + L.wid] = done ? 1 : 0;
        if (t > 0) FOX_WRITE((it + 1) & 1);
        __syncthreads();
        int alld = 1;
#pragma unroll
        for (int w = 0; w < 8; ++w) alld &= flags[(it & 1) * 8 + w];
        if (alld) break;
    }
#undef FOX_LOAD
#undef FOX_WRITE
    const float lt = l + __shfl_xor(l, 32);
    store_o(O + (rowbase + myq) * DM + h * 64, o0, o1, 1.0f / lt, L.hh);
    __syncthreads();
}

DI void chk_unit(LAS unsigned char* lds, const bf16_t* PA, const float* rel_bias, bf16_t* O, int b, int h, int g4) {
    const Lane L = mklane();
    const size_t rowbase = (size_t)b * SEQ;
    const int cw = 4 * g4 + (L.wid >> 1), myq = 64 * cw + 32 * (L.wid & 1) + L.r;
    const bf16_t* Qp = PA + (rowbase + myq) * LD_AB + 1536 + h * 64;
    const bf16_t* Kp = PA + rowbase * LD_AB + 2048 + h * 64;
    const bf16_t* Vp = Kp + 512;
    bf16x8 qf[4];
#pragma unroll
    for (int ds = 0; ds < 4; ++ds) qf[ds] = *(const bf16x8*)(Qp + 16 * ds + 8 * L.hh);
    const float c1 = 0.125f * LOG2E;
    const int c_lo = (4 * g4 - 8) > 0 ? (4 * g4 - 8) : 0, NT = 4 * g4 + 4 - c_lo;
    LAS float* rb = (LAS float*)(lds + OFF_RB);
    if (L.tid < 320) rb[L.tid] = rel_bias[h * 320 + L.tid] * LOG2E;
    float m = -INFINITY, l = 0.f; f32x16 o0, o1;
#pragma unroll
    for (int i = 0; i < 16; ++i) { o0[i] = 0.f; o1[i] = 0.f; }
    u32x4 kreg, vreg;
#define CHK_LOAD(t) do { kreg = *(const u32x4*)(Kp + (size_t)((c_lo + (t)) * 64 + L.srow) * LD_AB + L.sch * 8); vreg = *(const u32x4*)(Vp + (size_t)((c_lo + (t)) * 64 + L.srow) * LD_AB + L.sch * 8); } while (0)
#define CHK_WRITE(bf) do { *(LAS u32x4*)(lds + OFF_K + (bf) * KBUF + L.srow * 144 + L.sch * 16) = kreg; *(LAS u32x4*)(lds + OFF_V + (bf) * VBUF + L.srow * 144 + L.sch * 16) = vreg; } while (0)
    CHK_LOAD(0); CHK_WRITE(0); __syncthreads();
    for (int t = 0; t < NT; ++t) {
        if (t + 1 < NT) CHK_LOAD(t + 1);
        const int kc = c_lo + t, bf = t & 1;
        if (kc >= cw - 8 && kc <= cw) {
            f32x16 p0, p1;
            qk_tile<4, 144>(p0, p1, lds + OFF_K + bf * KBUF, qf, L);
            if (cw - kc >= 5) { const float bb = rb[319];
#pragma unroll
                for (int i = 0; i < 16; ++i) { p0[i] = fmaf(p0[i], c1, bb); p1[i] = fmaf(p1[i], c1, bb); } }
            else {
#pragma unroll
                for (int i = 0; i < 16; ++i) { const int rel = myq - (64 * kc + crow(i, L.hh));
                    const int i0 = (rel < 256 ? rel : 256) + 63, i1 = (rel - 32 < 256 ? rel - 32 : 256) + 63;
                    p0[i] = fmaf(p0[i], c1, rb[i0]); p1[i] = fmaf(p1[i], c1, rb[i1]); } }
            bf16x8 pf[4];
            online_softmax(p0, p1, m, l, o0, o1, pf);
            pv_tile(o0, o1, lds + OFF_V + bf * VBUF, pf, L);
        }
        if (t + 1 < NT) CHK_WRITE((t + 1) & 1);
        __syncthreads();
    }
#undef CHK_LOAD
#undef CHK_WRITE
    const float lt = l + __shfl_xor(l, 32);
    store_o(O + (rowbase + myq) * DM + 512 + h * 64, o0, o1, 1.0f / lt, L.hh);
}

DI void mla_unit(LAS unsigned char* lds, const bf16_t* QF, const bf16_t* KVF, const bf16_t* KR, bf16_t* O, int b, int h, int qb) {
    const Lane L = mklane();
    const size_t rowbase = (size_t)b * SEQ;
    const int cw = 4 * qb + (L.wid >> 1), myq = 64 * cw + 32 * (L.wid & 1) + L.r;
    const bf16_t* Qp = QF + (rowbase + myq) * 768 + h * 96;
    const bf16_t* Kp = KVF + rowbase * 1024 + h * 128;
    const bf16_t* Vp = Kp + 64;
    const bf16_t* Rp = KR + rowbase * 32;
    bf16x8 qf[6];
#pragma unroll
    for (int ds = 0; ds < 6; ++ds) qf[ds] = *(const bf16x8*)(Qp + 16 * ds + 8 * L.hh);
    const float c1 = 0.10206207261596577f * LOG2E;
    const int NT = 4 * qb + 4;
    float m = -INFINITY, l = 0.f; f32x16 o0, o1;
#pragma unroll
    for (int i = 0; i < 16; ++i) { o0[i] = 0.f; o1[i] = 0.f; }
    u32x4 kreg, vreg, rreg;
#define MLA_LOAD(t) do { kreg = *(const u32x4*)(Kp + (size_t)((t) * 64 + L.srow) * 1024 + L.sch * 8); vreg = *(const u32x4*)(Vp + (size_t)((t) * 64 + L.srow) * 1024 + L.sch * 8); \
        if (L.tid < 256) rreg = *(const u32x4*)(Rp + (size_t)((t) * 64 + (L.tid >> 2)) * 32 + (L.tid & 3) * 8); } while (0)
#define MLA_WRITE(bf) do { *(LAS u32x4*)(lds + OFF_K + (bf) * KBUF + L.srow * 208 + L.sch * 16) = kreg; *(LAS u32x4*)(lds + OFF_V + (bf) * VBUF + L.srow * 144 + L.sch * 16) = vreg; \
        if (L.tid < 256) *(LAS u32x4*)(lds + OFF_K + (bf) * KBUF + (L.tid >> 2) * 208 + 128 + (L.tid & 3) * 16) = rreg; } while (0)
    MLA_LOAD(0); MLA_WRITE(0); __syncthreads();
    for (int t = 0; t < NT; ++t) {
        if (t + 1 < NT) MLA_LOAD(t + 1);
        const int bf = t & 1;
        if (t <= cw) {
            f32x16 p0, p1;
            qk_tile<6, 208>(p0, p1, lds + OFF_K + bf * KBUF, qf, L);
#pragma unroll
            for (int i = 0; i < 16; ++i) { p0[i] *= c1; p1[i] *= c1; }
            bf16x8 pf[4];
            online_softmax(p0, p1, m, l, o0, o1, pf);
            pv_tile(o0, o1, lds + OFF_V + bf * VBUF, pf, L);
        }
        if (t + 1 < NT) MLA_WRITE((t + 1) & 1);
        __syncthreads();
    }
#undef MLA_LOAD
#undef MLA_WRITE
    const float lt = l + __shfl_xor(l, 32);
    store_o(O + (rowbase + myq) * DM + 512 + h * 64, o0, o1, 1.0f / lt, L.hh);
}

DI void sb_sub(f32x16& p, float& R, int keybase, int myq, int hh, bool need_mask) {
    float lk[16], lb[16];
#pragma unroll
    for (int i = 0; i < 16; ++i) {
        const float z = p[i] * 0.125f, u = fexp2(-fabsf(z) * LOG2E), sp = fmaxf(z, 0.f) + flog2(1.0f + u) * LN2;
        const bool valid = !need_mask || (keybase + crow(i, hh)) < myq;
        lk[i] = valid ? -sp : 0.f; lb[i] = valid ? (z - sp) : -INFINITY; }
    float G[4], Gp[4];
#pragma unroll
    for (int g = 0; g < 4; ++g) { G[g] = (lk[4 * g] + lk[4 * g + 1]) + (lk[4 * g + 2] + lk[4 * g + 3]); Gp[g] = __shfl_xor(G[g], 32); }
    float acc = R;
#pragma unroll
    for (int g = 3; g >= 0; --g) {
        const float s3 = hh ? acc : acc + Gp[g];
        acc += G[g] + Gp[g];
        const float s2 = s3 + lk[4 * g + 3], s1 = s2 + lk[4 * g + 2], s0 = s1 + lk[4 * g + 1];
        p[4 * g + 3] = fexp2((lb[4 * g + 3] + s3) * LOG2E); p[4 * g + 2] = fexp2((lb[4 * g + 2] + s2) * LOG2E);
        p[4 * g + 1] = fexp2((lb[4 * g + 1] + s1) * LOG2E); p[4 * g] = fexp2((lb[4 * g] + s0) * LOG2E); }
    R = acc;
}
DI void sb_unit(LAS unsigned char* lds, const bf16_t* PC, bf16_t* O, int b, int h, int qb) {
    const Lane L = mklane();
    const size_t rowbase = (size_t)b * SEQ;
    const int q0 = qb * 256, q0w = q0 + L.wid * 32, myq = q0w + L.r;
    const bf16_t* Qp = PC + (rowbase + myq) * LD_CD + h * 64;
    const bf16_t* Kp = PC + rowbase * LD_CD + 512 + h * 64;
    const bf16_t* Vp = Kp + 512;
    bf16x8 qf[4];
#pragma unroll
    for (int ds = 0; ds < 4; ++ds) qf[ds] = *(const bf16x8*)(Qp + 16 * ds + 8 * L.hh);
    const int NT = (q0 + 256) / 64;
    float R = 0.f; f32x16 o0, o1;
#pragma unroll
    for (int i = 0; i < 16; ++i) { o0[i] = 0.f; o1[i] = 0.f; }
    bool seen = false;
    LAS int* flags = (LAS int*)(lds + OFF_FLAG);
    u32x4 kreg, vreg;
#define SB_LOAD(t) do { kreg = *(const u32x4*)(Kp + (size_t)((t) * 64 + L.srow) * LD_CD + L.sch * 8); vreg = *(const u32x4*)(Vp + (size_t)((t) * 64 + L.srow) * LD_CD + L.sch * 8); } while (0)
#define SB_WRITE(bf) do { *(LAS u32x4*)(lds + OFF_K + (bf) * KBUF + L.srow * 144 + L.sch * 16) = kreg; *(LAS u32x4*)(lds + OFF_V + (bf) * VBUF + L.srow * 144 + L.sch * 16) = vreg; } while (0)
    SB_LOAD(NT - 1); SB_WRITE(0); __syncthreads();
    for (int it = 0; it < NT; ++it) {
        const int t = NT - 1 - it, k0 = t * 64, bf = it & 1;
        if (t > 0) SB_LOAD(t - 1);
        bool done = false;
        if (k0 <= q0w + 31) {
            done = seen && __all(R < -110.0f);
            if (!done) {
                f32x16 p0, p1;
                qk_tile<4, 144>(p0, p1, lds + OFF_K + bf * KBUF, qf, L);
                const bool nm = (k0 + 63 >= q0w);
                sb_sub(p1, R, k0 + 32, myq, L.hh, nm);
                sb_sub(p0, R, k0, myq, L.hh, nm);
                bf16x8 pf[4];
                pf[0] = packfrag(p0, 0); pf[1] = packfrag(p0, 1); pf[2] = packfrag(p1, 0); pf[3] = packfrag(p1, 1);
                pv_tile(o0, o1, lds + OFF_V + bf * VBUF, pf, L);
                seen = true;
                done = __all(R < -110.0f);
            }
        }
        if (L.lane == 0) flags[(it & 1) * 8 + L.wid] = done ? 1 : 0;
        if (t > 0) SB_WRITE((it + 1) & 1);
        __syncthreads();
        int alld = 1;
#pragma unroll
        for (int w = 0; w < 8; ++w) alld &= flags[(it & 1) * 8 + w];
        if (alld) break;
    }
#undef SB_LOAD
#undef SB_WRITE
    store_o(O + (rowbase + myq) * DM + h * 64, o0, o1, 1.0f, L.hh);
    __syncthreads();
}
}

#define XB_TMO      128
#define XB_XCNT(j)  (256  + 64 * (j))
#define XB_XSUB(j)  (1280 + 64 * (j))
#define XB_XGEN(j)  (2304 + 64 * (j))
#define XB_TOP      3328
#define XB_TOPGEN   3392
#define XCD_BAR_WORDS 3456
#define XB_SPIN_CAP (1u << 18)

__device__ __forceinline__ unsigned xb_ld(unsigned* p)              { return __hip_atomic_load(p, __ATOMIC_RELAXED, __HIP_MEMORY_SCOPE_AGENT); }
__device__ __forceinline__ unsigned xb_add(unsigned* p, unsigned v) { return __hip_atomic_fetch_add(p, v, __ATOMIC_RELAXED, __HIP_MEMORY_SCOPE_AGENT); }
__device__ __forceinline__ unsigned xb_xcc_id() { return (unsigned)__builtin_amdgcn_s_getreg((3 << 11) | 20) & 0xFu; }
#define XB_SPIN(cond, bar) do { unsigned _sp = 0; while (cond) { __builtin_amdgcn_s_sleep(1); \
    if ((++_sp & 255u) == 0u) { if (xb_ld(&(bar)[XB_TMO])) break; if (_sp > XB_SPIN_CAP) { atomicAdd(&(bar)[XB_TMO], 1u); break; } } } } while (0)

struct XcdBarrier {
    unsigned* bar; unsigned x;
    volatile LAS unsigned* st;
};

__device__ __forceinline__ XcdBarrier xcd_barrier_post(unsigned* bar, volatile LAS unsigned* st) {
    XcdBarrier b; b.bar = bar; b.x = xb_xcc_id(); b.st = st;
    if (threadIdx.x == 0) (void)xb_add(&bar[XB_XCNT(b.x)], 1u);
    return b;
}
__device__ __forceinline__ void xcd_barrier_complete(unsigned* bar, unsigned x, unsigned& nloc, unsigned& nx) {
    const unsigned G = gridDim.x * gridDim.y * gridDim.z;
    unsigned sum, cnt, mine, sp = 0u;
    for (;;) {
        sum = 0u; cnt = 0u; mine = 0u;
#pragma unroll
        for (unsigned j = 0; j < 16; ++j) { const unsigned c = xb_ld(&bar[XB_XCNT(j)]); sum += c; cnt += (c > 0u) ? 1u : 0u; mine = (j == x) ? c : mine; }
        if (sum == G) break;
        __builtin_amdgcn_s_sleep(1);
        if ((++sp & 255u) == 0u) { if (xb_ld(&bar[XB_TMO])) break; if (sp > XB_SPIN_CAP) { atomicAdd(&bar[XB_TMO], 1u); break; } }
    }
    nloc = mine > 0u ? mine : 1u; nx = cnt > 0u ? cnt : 1u;
}

__device__ __forceinline__ void xcd_barrier(const XcdBarrier& b) {
    asm volatile("s_waitcnt vmcnt(0)" ::: "memory");
    __syncthreads();
    if (threadIdx.x == 0) {
        unsigned* bar = b.bar;
        __builtin_amdgcn_s_waitcnt(0);
        unsigned nloc = b.st[0], nx = b.st[1];
        if (nloc == 0u) { xcd_barrier_complete(bar, b.x, nloc, nx); b.st[0] = nloc; b.st[1] = nx; }
        const unsigned old = xb_add(&bar[XB_XSUB(b.x)], 1u);
        const unsigned gen = old / nloc;
        if (old + 1u == (gen + 1u) * nloc) {
            __builtin_amdgcn_fence(__ATOMIC_RELEASE, "agent");
            asm volatile("s_waitcnt vmcnt(0)" ::: "memory");
            const unsigned og = xb_add(&bar[XB_TOP], 1u);
            const unsigned tg = og / nx;
            if (og + 1u == (tg + 1u) * nx) xb_add(&bar[XB_TOPGEN], 1u);
            else XB_SPIN(xb_ld(&bar[XB_TOPGEN]) == tg, bar);
            __builtin_amdgcn_fence(__ATOMIC_ACQUIRE, "agent");
            xb_add(&bar[XB_XGEN(b.x)], 1u);
            asm volatile("s_waitcnt vmcnt(0)" ::: "memory");
        } else {
            XB_SPIN(xb_ld(&bar[XB_XGEN(b.x)]) == gen, bar);
            __builtin_amdgcn_fence(__ATOMIC_ACQUIRE, "agent");
            asm volatile("s_waitcnt vmcnt(0)" ::: "memory");
        }
    }
    __syncthreads();
}


constexpr int RSTD_OFF = 131072 + 1024;
DI void rstd_prepass(LAS unsigned char* lds, const pg8::StaticOrder& S, const float* ssq, int tid) {
    LAS float* tab = (LAS float*)(lds + RSTD_OFF);
    pg8::Unit u;
#pragma unroll 1
    for (int i = 0; i < 4 && S.next(i, u); ++i) {
        const int r = tid >> 1, hf = tid & 1;
        const f32x4* sp = (const f32x4*)(ssq + (size_t)(u.pm * 256 + r) * 16 + hf * 8);
        const f32x4 a = sp[0], b = sp[1];
        float t = ((a[0] + a[1]) + (a[2] + a[3])) + ((b[0] + b[1]) + (b[2] + b[3]));
        t += __shfl_xor(t, 1);
        if (hf == 0) tab[i * 256 + r] = 1.0f / sqrtf(t * (1.0f / 1024.0f) + EPS);
    }
    __syncthreads();
}
struct Params {
    const float* x; const int* pos; const float* norm_mix; const float* norm_mlp; const float* norm_final;
    const float* w_in_ab; const float* b_forget; const float* rel_bias; const float* w_out_ab;
    const float* w_in_cd; const float* q_norm; const float* kv_norm; const float* w_uq; const float* w_ukv; const float* w_out_cd;
    const float* w_up; const float* w_down;
    float* out; unsigned char* ws; int ph_lo, ph_hi, coop, pad;
};
constexpr int N_PHASES = 17;

__global__ void __launch_bounds__(NTHREADS) fwd_kernel(Params P) {
    extern __shared__ __attribute__((aligned(16))) unsigned char lds_raw[];
    LAS unsigned char* lds = (LAS unsigned char*)lds_raw;
    const int tid = threadIdx.x, lane = tid & 63, wave = __builtin_amdgcn_readfirstlane(tid >> 6);
    const int G = gridDim.x, bx = blockIdx.x;
    const int vcu = (G % 8 == 0) ? (bx % 8) * (G / 8) + bx / 8 : bx;
    const int gw = vcu * NWAVES + wave, ngw = G * NWAVES;
    unsigned char* ws = P.ws;
    bf16_t* WinAB = (bf16_t*)(ws + WS_WINAB); bf16_t* WoutAB = (bf16_t*)(ws + WS_WOUTAB); bf16_t* WinCD = (bf16_t*)(ws + WS_WINCD);
    bf16_t* Wuq = (bf16_t*)(ws + WS_WUQ); bf16_t* Wukv = (bf16_t*)(ws + WS_WUKV); bf16_t* WoutCD = (bf16_t*)(ws + WS_WOUTCD);
    bf16_t* Wup0 = (bf16_t*)(ws + WS_WUP0); bf16_t* Wup1 = (bf16_t*)(ws + WS_WUP1); bf16_t* Wdn0 = (bf16_t*)(ws + WS_WDN0); bf16_t* Wdn1 = (bf16_t*)(ws + WS_WDN1);
    float* LOGF = (float*)(ws + WS_LOGF); float* CUM = (float*)(ws + WS_CUM); float* TAB = (float*)(ws + WS_TAB); bf16_t* KR = (bf16_t*)(ws + WS_KR); float* SSQ = (float*)(ws + WS_SSQ); unsigned* KN2 = (unsigned*)(ws + WS_CTL + CTL_KN2);
    bf16_t* XN = (bf16_t*)(ws + WS_XN); bf16_t* CQN = (bf16_t*)(ws + WS_CQN); bf16_t* CKVN = (bf16_t*)(ws + WS_CKVN); bf16_t* OB = (bf16_t*)(ws + WS_O);
    bf16_t* BIG = (bf16_t*)(ws + WS_BIG); bf16_t* QF = (bf16_t*)(ws + WS_QF); bf16_t* KVF = (bf16_t*)(ws + WS_KVF);
    cg::grid_group grid = cg::this_grid();
    volatile LAS unsigned* MISC = (volatile LAS unsigned*)(lds + MISC_OFF);
    if (tid < 32) MISC[tid] = 0u;
    __syncthreads();
    XcdBarrier bar; bar.bar = (unsigned*)(ws + WS_CTL); bar.x = 0; bar.st = nullptr;
    if (P.coop) bar = xcd_barrier_post((unsigned*)(ws + WS_CTL), MISC + 8);
    const int lo = P.ph_lo, hi = P.ph_hi;
#ifndef PHMASK
#define PHMASK 0x1ffff
#endif
#define IN(k) (((PHMASK >> (k)) & 1) && lo <= (k) && (k) < hi)
#ifndef REPMASK
#define REPMASK 0
#endif
#define REP(k) ((REPMASK >> (k)) & 1)
#define SEAM(k) do { if (P.coop && (k) + 1 < hi) { if (P.coop == 2) grid.sync(); else xcd_barrier(bar); } } while (0)

    if (IN(0)) {
        LAS float* scr = (LAS float*)(lds + wave * 8704);
        for (int it = gw; ; it += ngw) {
            int r = it; bool hit = false;
#define TR(W, K, LDN, C0, NC, WT, R0, GN) if (!hit) { const int n_it = ((K) / 64) * ((NC) / 32); if (r < n_it) { transpose_item((W), (K), (LDN), (C0), (WT), (R0), (NC) / 32, scr, r, lane, (GN)); hit = true; } else r -= n_it; }
            TR(P.w_in_ab, 1024, NSRC_AB, 0, 1536, WinAB, 0, nullptr)
            TR(P.w_in_ab, 1024, NSRC_AB, 1544, 1536, WinAB, 1536, nullptr)
            TR(P.w_out_ab, 1024, 1024, 0, 1024, WoutAB, 0, nullptr)
            TR(P.w_in_cd, 1024, NSRC_CD, 0, NSRC_CD, WinCD, 0, P.norm_mix + DM)
            TR(P.w_uq, 384, 768, 0, 768, Wuq, 0, nullptr)
            TR(P.w_ukv, 256, 1024, 0, 1024, Wukv, 0, nullptr)
            TR(P.w_out_cd, 1024, 1024, 0, 1024, WoutCD, 0, nullptr)
            TR(P.w_up, 1024, 4096, 0, 4096, Wup0, 0, P.norm_mlp)
            TR(P.w_up + (size_t)1024 * 4096, 1024, 4096, 0, 4096, Wup1, 0, P.norm_mlp + DM)
            TR(P.w_down, 4096, 1024, 0, 1024, Wdn0, 0, nullptr)
            TR(P.w_down + (size_t)4096 * 1024, 4096, 1024, 0, 1024, Wdn1, 0, nullptr)
#undef TR
            if (!hit) break;
        }
        for (int i = (vcu * NTHREADS + tid); i < 96 * 1024 / 8; i += G * NTHREADS) ((u32x4*)(WinCD + (size_t)2208 * 1024))[i] = (u32x4){0u, 0u, 0u, 0u};
        __syncthreads();
        LAS float* wfaT = (LAS float*)lds;
        for (int i = tid; i < 8192; i += NTHREADS) { const int k = i >> 3, j = i & 7; wfaT[j * 1024 + k] = P.w_in_ab[(size_t)k * NSRC_AB + 1536 + j]; }
        __syncthreads();
        norm_rows_bf16<true>(P.x, P.norm_mix, XN, gw, ngw, lane, wfaT, P.b_forget, LOGF, P.pos, TAB);
        __syncthreads();
        SEAM(0);
    }
    if (IN(1)) {
        if (vcu < 32) {
            const int b = vcu >> 3, h = vcu & 7; LAS float* sc = (LAS float*)lds;
            float v[8]; float run = 0.f;
#pragma unroll
            for (int e = 0; e < 8; ++e) { run += LOGF[((size_t)b * SEQ + tid * 8 + e) * 8 + h]; v[e] = run; }
            sc[tid] = run; __syncthreads();
            for (int off = 1; off < NTHREADS; off <<= 1) { const float add = (tid >= off) ? sc[tid - off] : 0.f; __syncthreads(); sc[tid] += add; __syncthreads(); }
            const float base = sc[tid] - run;
#pragma unroll
            for (int e = 0; e < 8; ++e) CUM[(size_t)(b * 8 + h) * SEQ + tid * 8 + e] = base + v[e];
            __syncthreads();
        }
        pg8::Gemm g{XN, WinAB, MT, LD_AB, DM}; pg8::StaticOrder S; S.init(MT, LD_AB, G, bx);
        pg8::EpiStoreAB E{BIG, LD_AB, KN2};
        pg8::gemm_phase<pg8::EpiStoreAB, pg8::StaticOrder, true, true>(lds, g, S, E);
        SEAM(1);
    }
    if (IN(2)) {
        const int bh = vcu >> 3, s = vcu & 7, b = bh >> 3, h = bh & 7;
        {
            att::fox_unit(lds, BIG, CUM, KN2, OB, b, h, 15 - s);
            att::fox_unit(lds, BIG, CUM, KN2, OB, b, h, s);
            att::chk_unit(lds, BIG, P.rel_bias, OB, b, h, 2 * s);
            att::chk_unit(lds, BIG, P.rel_bias, OB, b, h, 2 * s + 1);
        }
        SEAM(2);
    }
    if (IN(3)) {
        pg8::Gemm g{OB, WoutAB, MT, DM, DM}; pg8::StaticOrder S; S.init(MT, DM, G, bx);
        pg8::EpiResidN E{P.x, P.out, XN, SSQ, DM};
        pg8::gemm_phase<pg8::EpiResidN, pg8::StaticOrder, true, true>(lds, g, S, E);
        SEAM(3);
    }
    if (IN(5)) {
        pg8::Gemm g{XN, Wup0, MT, DFF, DM}; pg8::StaticOrder S; S.init(MT, DFF, G, bx);
        rstd_prepass(lds, S, SSQ, tid);
        pg8::EpiStore<1, 1> E{BIG, DFF, (const LAS float*)(lds + RSTD_OFF), 0};
        pg8::gemm_phase<pg8::EpiStore<1, 1>, pg8::StaticOrder, true, true>(lds, g, S, E);
        SEAM(5);
    }
    if (IN(6)) {
        pg8::Gemm g{BIG, Wdn0, MT, DM, DFF}; pg8::StaticOrder S; S.init(MT, DM, G, bx);
        pg8::EpiResidN E{P.out, P.out, XN, SSQ, DM};
        pg8::gemm_phase<pg8::EpiResidN, pg8::StaticOrder, true, true>(lds, g, S, E);
        SEAM(6);
    }
    if (IN(8)) {
        pg8::Gemm g{XN, WinCD, MT, LD_CD, DM}; pg8::StaticOrder S; S.init(MT, LD_CD, G, bx);
        rstd_prepass(lds, S, SSQ, tid);
        pg8::EpiStore<0, 1> E{BIG, LD_CD, (const LAS float*)(lds + RSTD_OFF), 0};
        pg8::gemm_phase<pg8::EpiStore<0, 1>, pg8::StaticOrder, true, true>(lds, g, S, E);
        SEAM(8);
    }
    if (IN(9)) { mla_prep_rows(BIG, P.pos, P.q_norm, P.kv_norm, CQN, CKVN, TAB, KR, gw, ngw, lane); SEAM(9); }
    if (IN(10)) {
#ifndef P10SEL
#define P10SEL 3
#endif
        if (P10SEL & 1) { pg8::Gemm g{CQN, Wuq, MT, 768, 384 + P.pad};     pg8::StaticOrder S; S.init(MT, 768, G, bx);
          pg8::EpiQRope E{QF, 768, TAB};
          pg8::gemm_phase<pg8::EpiQRope, pg8::StaticOrder, true, true>(lds, g, S, E); }
        if (P10SEL & 2) { pg8::Gemm g{CKVN, Wukv, MT, 1024, 256 + P.pad}; pg8::StaticOrder S; S.init(MT, 1024, G, bx);
          pg8::EpiStore<0> E{KVF, 1024, nullptr, 0};
          pg8::gemm_phase<pg8::EpiStore<0>, pg8::StaticOrder, true, true>(lds, g, S, E); }
        SEAM(10);
    }
    if (IN(11)) {
        const int bh = vcu >> 3, s = vcu & 7, b = bh >> 3, h = bh & 7;
        {
            att::mla_unit(lds, QF, KVF, KR, OB, b, h, 15 - s);
            att::mla_unit(lds, QF, KVF, KR, OB, b, h, s);
            att::sb_unit(lds, BIG, OB, b, h, 15 - s);
            att::sb_unit(lds, BIG, OB, b, h, s);
        }
        SEAM(11);
    }
    if (IN(12)) {
        pg8::Gemm g{OB, WoutCD, MT, DM, DM}; pg8::StaticOrder S; S.init(MT, DM, G, bx);
        pg8::EpiResidN E{P.out, P.out, XN, SSQ, DM};
        pg8::gemm_phase<pg8::EpiResidN, pg8::StaticOrder, true, true>(lds, g, S, E);
        SEAM(12);
    }
    if (IN(14)) {
        pg8::Gemm g{XN, Wup1, MT, DFF, DM}; pg8::StaticOrder S; S.init(MT, DFF, G, bx);
        rstd_prepass(lds, S, SSQ, tid);
        pg8::EpiStore<1, 1> E{BIG, DFF, (const LAS float*)(lds + RSTD_OFF), 0};
        pg8::gemm_phase<pg8::EpiStore<1, 1>, pg8::StaticOrder, true, true>(lds, g, S, E);
        SEAM(14);
    }
    if (IN(15)) {
        pg8::Gemm g{BIG, Wdn1, MT, DM, DFF}; pg8::StaticOrder S; S.init(MT, DM, G, bx);
        pg8::EpiResid E{P.out, P.out, DM};
        pg8::gemm_phase<pg8::EpiResid, pg8::StaticOrder, true, true>(lds, g, S, E);
        SEAM(15);
    }
    if (IN(16)) { norm_rows_f32(P.out, P.norm_final, gw, ngw, lane); }
#undef IN
#undef SEAM
}

#ifndef MK_MULTI_LAUNCH
#define MK_MULTI_LAUNCH 0
#endif
extern "C" void kernel_launch(void* const* d_in, const int* in_sizes, int n_in, void* d_out, int out_size, void* d_ws, size_t ws_size, hipStream_t stream) {
    static int grid = 0;
    if (grid == 0) {
        if (n_in != 17 || out_size != MT * DM || ws_size < WS_END) { fprintf(stderr, "kernel_launch: unexpected problem (n_in %d out %d ws %zu)\n", n_in, out_size, ws_size); grid = -1; return; }
        int dev = 0, cus = 0, per_cu = 0;
        hipGetDevice(&dev); hipDeviceGetAttribute(&cus, hipDeviceAttributeMultiprocessorCount, dev);
        if (hipFuncSetAttribute((const void*)fwd_kernel, hipFuncAttributeMaxDynamicSharedMemorySize, LDS_BYTES) != hipSuccess) { fprintf(stderr, "kernel_launch: hipFuncSetAttribute failed\n"); grid = -1; return; }
        if (hipOccupancyMaxActiveBlocksPerMultiprocessor(&per_cu, (const void*)fwd_kernel, NTHREADS, LDS_BYTES) != hipSuccess || per_cu < 1) { fprintf(stderr, "kernel_launch: occupancy query says %d\n", per_cu); per_cu = 1; }
        (void)hipGetLastError();
        grid = cus;
        if (grid != 256) fprintf(stderr, "kernel_launch: note: %d CUs\n", grid);
    }
    if (grid < 0) return;
    Params p{};
    p.x = (const float*)d_in[0]; p.pos = (const int*)d_in[1]; p.norm_mix = (const float*)d_in[2]; p.norm_mlp = (const float*)d_in[3]; p.norm_final = (const float*)d_in[4];
    p.w_in_ab = (const float*)d_in[5]; p.b_forget = (const float*)d_in[6]; p.rel_bias = (const float*)d_in[7]; p.w_out_ab = (const float*)d_in[8];
    p.w_in_cd = (const float*)d_in[9]; p.q_norm = (const float*)d_in[10]; p.kv_norm = (const float*)d_in[11]; p.w_uq = (const float*)d_in[12]; p.w_ukv = (const float*)d_in[13]; p.w_out_cd = (const float*)d_in[14];
    p.w_up = (const float*)d_in[15]; p.w_down = (const float*)d_in[16];
    p.out = (float*)d_out; p.ws = (unsigned char*)d_ws;
    if (hipMemsetAsync((char*)d_ws + WS_CTL, 0, CTL_BYTES, stream) != hipSuccess) { fprintf(stderr, "kernel_launch: hipMemsetAsync failed\n"); return; }
#if MK_MULTI_LAUNCH
    for (int ph = 0; ph < N_PHASES; ++ph) {
        p.ph_lo = ph; p.ph_hi = ph + 1; p.coop = 0;
        hipLaunchKernelGGL(fwd_kernel, dim3(grid), dim3(NTHREADS), LDS_BYTES, stream, p);
        if (REP(ph)) hipLaunchKernelGGL(fwd_kernel, dim3(grid), dim3(NTHREADS), LDS_BYTES, stream, p);
    }
#else
    p.ph_lo = 0; p.ph_hi = N_PHASES; p.coop = 1;
    void* args[] = {&p};
    hipError_t e = hipLaunchCooperativeKernel((const void*)fwd_kernel, dim3(grid), dim3(NTHREADS), args, LDS_BYTES, stream);
    if (e != hipSuccess) fprintf(stderr, "cooperative launch failed: %s (grid %d)\n", hipGetErrorString(e), grid);
#endif
}
```

```cpp
#include <hip/hip_runtime.h>
#include <hip/hip_cooperative_groups.h>
#include <cstdio>
#include <cstdint>
#include <cmath>
namespace cg = cooperative_groups;
namespace pg8 {
#define PG8_LAS __attribute__((address_space(3)))
typedef unsigned short bf16_t;
typedef short bf16x8 __attribute__((ext_vector_type(8)));
typedef float f32x4 __attribute__((ext_vector_type(4)));
typedef unsigned u32x4 __attribute__((ext_vector_type(4)));
constexpr int BM = 256, BK = 64, HALF = 128, HTB = HALF * BK * 2  , STAGE_BYTES = 8 * HTB, NXCD = 8, WGM = 8;

__host__ __device__ __forceinline__ int lds_byte(int r, int c) { const int st = (r >> 4) * 2 + (c >> 5), rr = r & 15, cc = c & 31, ob = rr * 64 + cc * 2; return st * 1024 + (ob ^ (((ob >> 9) & 1) << 5)); }
__host__ __device__ __forceinline__ void stage_rc(int b, int& R, int& C) { const int st = b / 1024, sb = b % 1024, swz = sb ^ (((sb >> 9) & 1) << 5); R = (st >> 1) * 16 + swz / 64; C = (st & 1) * 32 + (swz % 64) / 2; }
__host__ __device__ __forceinline__ int perm32(int rho) { const int n = rho >> 4, i = rho & 15; return 8 * (i >> 2) + 4 * n + (i & 3); }

struct Unit { int pm, pn; };
struct Gemm { const bf16_t* A; const bf16_t* Bt; int M, N, K; };

struct StaticOrder {
    int nM, nN, nwg, G, c;
    __host__ __device__ void init(int M, int N, int G_, int c_) { nM = M / BM; nN = N / BM; nwg = nM * nN; G = G_; c = c_; }
    __host__ __device__ bool next(int i, Unit& u) const {
        const long L = (long)i * G + c; if (L >= nwg) return false;
        int wgid = (int)L; { const int q = nwg / NXCD, r = nwg % NXCD, xcd = wgid % NXCD, off = wgid / NXCD; wgid = (xcd < r ? xcd * (q + 1) : r * (q + 1) + (xcd - r) * q) + off; }
        const int nig = WGM * nN, gid = wgid / nig, fm = gid * WGM, gsz = (nM - fm) < WGM ? (nM - fm) : WGM;
        u.pm = fm + ((wgid % nig) % gsz); u.pn = (wgid % nig) / gsz; return true;
    }
    __device__ __forceinline__ void a_ready(const Unit&) const {}
    __device__ __forceinline__ void done(const Unit&) const {}
};

__device__ __forceinline__ unsigned cvt_pk_bf16(float lo, float hi) { unsigned r; asm volatile("v_cvt_pk_bf16_f32 %0, %1, %2" : "=v"(r) : "v"(lo), "v"(hi)); return r; }
template <class Epi, class Sched, bool ALIGN_EPI = false, bool SP2 = false>
__device__ __forceinline__ void gemm_phase(PG8_LAS unsigned char* lds, const Gemm g, const Sched& S, const Epi& E) {
    const int tid = threadIdx.x, wid = __builtin_amdgcn_readfirstlane(tid >> 6), lane = tid & 63, wr = wid >> 2, wc = wid & 3, fr = lane & 15, fq = lane >> 4;
    const int K = g.K, nt = K / BK;
    unsigned voffA[2], voffB[2];
#pragma unroll
    for (int i = 0; i < 2; ++i) { int R, C; stage_rc(tid * 16 + i * 8192, R, C); const int Rb = Epi::PERM ? ((R & ~31) + perm32(R & 31)) : R;
        voffA[i] = (unsigned)(R * K + C) * 2u; voffB[i] = (unsigned)(Rb * K + C) * 2u; }
    const size_t kstep = (size_t)(BK * 2);
    const size_t hstep = (size_t)HALF * K * 2;
    const size_t tstep = 2 * hstep;
    const unsigned ldsw = (unsigned)wid * 1024u;
    const int aoff = lds_byte(wr * 64 + fr, fq * 8), boff = lds_byte(wc * 32 + fr, fq * 8);
#define PG8_SA(b, h) (((b) * 2 + (h)) * HTB)
#define PG8_SB(b, h) ((4 + (b) * 2 + (h)) * HTB)
#define PG8_STAGE(bufoff, gbase, voff) do { _Pragma("unroll") for (int _i = 0; _i < 2; ++_i) \
        __builtin_amdgcn_global_load_lds((const unsigned*)((const char*)(gbase) + (voff)[_i]), (PG8_LAS unsigned*)(lds + (bufoff) + ldsw + _i * 8192), 16, 0, 0); } while (0)
#define PG8_LDA(dst, b, h) do { _Pragma("unroll") for (int m = 0; m < 4; ++m) _Pragma("unroll") for (int k = 0; k < 2; ++k) dst[m][k] = *(const PG8_LAS bf16x8*)(lds + PG8_SA(b, h) + aoff + m * 2048 + k * 1024); } while (0)
#define PG8_LDB(dst, b, h) do { _Pragma("unroll") for (int n = 0; n < 2; ++n) _Pragma("unroll") for (int k = 0; k < 2; ++k) dst[n][k] = *(const PG8_LAS bf16x8*)(lds + PG8_SB(b, h) + boff + n * 2048 + k * 1024); } while (0)
#define PG8_MMA(ai, bj, At, Bt) do { __builtin_amdgcn_s_setprio(1); _Pragma("unroll") for (int m = 0; m < 4; ++m) _Pragma("unroll") for (int n = 0; n < 2; ++n) _Pragma("unroll") for (int k = 0; k < 2; ++k) \
        acc[ai][bj][m][n] = __builtin_amdgcn_mfma_f32_16x16x32_bf16(Bt[n][k], At[m][k], acc[ai][bj][m][n], 0, 0, 0); __builtin_amdgcn_s_setprio(0); } while (0)
#define PG8_WAIT_V(n) asm volatile("s_waitcnt vmcnt(" #n ")" ::: "memory")
#define PG8_WAIT_L(n) asm volatile("s_waitcnt lgkmcnt(" #n ")" ::: "memory")
#define PG8_BAR __builtin_amdgcn_s_barrier()
#define PG8_SCHED __builtin_amdgcn_sched_barrier(0)
    Unit cur, nxt; int ui = 0;
    if (!S.next(0, cur)) return;
    f32x4 acc[2][2][4][2];
#pragma unroll
    for (int a = 0; a < 2; ++a)
#pragma unroll
        for (int b = 0; b < 2; ++b)
#pragma unroll
            for (int m = 0; m < 4; ++m)
#pragma unroll
                for (int n = 0; n < 2; ++n) acc[a][b][m][n] = (f32x4){0.f, 0.f, 0.f, 0.f};
    bf16x8 At[4][2], B0[2][2], B1[2][2];
    const char* cA = (const char*)g.A + (size_t)cur.pm * tstep; const char* cB = (const char*)g.Bt + (size_t)cur.pn * tstep;
    S.a_ready(cur);
    if constexpr (SP2) {
        PG8_STAGE(PG8_SB(0, 0), cB, voffB); PG8_STAGE(PG8_SB(0, 1), cB + hstep, voffB); PG8_STAGE(PG8_SA(0, 0), cA, voffA); PG8_STAGE(PG8_SA(0, 1), cA + hstep, voffA);
        if (wr == 1) PG8_BAR;
        PG8_WAIT_V(2); PG8_BAR;
        PG8_STAGE(PG8_SB(1, 0), cB + kstep, voffB); PG8_STAGE(PG8_SA(1, 0), cA + kstep, voffA); PG8_STAGE(PG8_SB(1, 1), cB + hstep + kstep, voffB);
        PG8_WAIT_V(6); PG8_BAR;
    } else {
        PG8_STAGE(PG8_SB(0, 0), cB, voffB); PG8_STAGE(PG8_SA(0, 0), cA, voffA); PG8_STAGE(PG8_SB(0, 1), cB + hstep, voffB); PG8_STAGE(PG8_SA(0, 1), cA + hstep, voffA);
        if (wr == 1) PG8_BAR;
        PG8_WAIT_V(4); PG8_BAR;
        PG8_STAGE(PG8_SB(1, 0), cB + kstep, voffB); PG8_STAGE(PG8_SA(1, 0), cA + kstep, voffA); PG8_STAGE(PG8_SB(1, 1), cB + hstep + kstep, voffB);
        PG8_WAIT_V(6); PG8_BAR;
    }
    for (;;) {
        const bool has_next = S.next(ui + 1, nxt);
        const char* nA = has_next ? (const char*)g.A + (size_t)nxt.pm * tstep : cA; const char* nB = has_next ? (const char*)g.Bt + (size_t)nxt.pn * tstep : cB;
        for (int t = 0; t < nt; t += 2) {
            const bool last = (t == nt - 2);
            const char* a1 = cA + (size_t)(t + 1) * kstep;
            const char* a2 = last ? nA : cA + (size_t)(t + 2) * kstep; const char* b2 = last ? nB : cB + (size_t)(t + 2) * kstep;
            const char* a3 = a2 + kstep; const char* b3 = b2 + kstep;
            if (last && has_next) S.a_ready(nxt);
            if constexpr (SP2) {
            PG8_LDB(B0, 0, 0); PG8_LDB(B1, 0, 1); PG8_SCHED; PG8_LDA(At, 0, 0); PG8_STAGE(PG8_SA(1, 1), a1 + hstep, voffA);
            PG8_WAIT_V(8); PG8_WAIT_L(0); PG8_BAR; PG8_MMA(0, 0, At, B0); PG8_MMA(0, 1, At, B1); PG8_BAR; PG8_SCHED;
            PG8_LDA(At, 0, 1); PG8_STAGE(PG8_SB(0, 0), b2, voffB); PG8_STAGE(PG8_SB(0, 1), b2 + hstep, voffB); PG8_STAGE(PG8_SA(0, 0), a2, voffA);
            PG8_WAIT_V(8); PG8_WAIT_L(0); PG8_BAR; PG8_MMA(1, 0, At, B0); PG8_MMA(1, 1, At, B1); PG8_BAR; PG8_SCHED;
            PG8_LDB(B0, 1, 0); PG8_LDB(B1, 1, 1); PG8_SCHED; PG8_LDA(At, 1, 0); PG8_STAGE(PG8_SA(0, 1), a2 + hstep, voffA);
            PG8_WAIT_V(8); PG8_WAIT_L(0); PG8_BAR; PG8_MMA(0, 0, At, B0); PG8_MMA(0, 1, At, B1); PG8_BAR; PG8_SCHED;
            PG8_LDA(At, 1, 1); PG8_STAGE(PG8_SB(1, 0), b3, voffB); PG8_STAGE(PG8_SB(1, 1), b3 + hstep, voffB); PG8_STAGE(PG8_SA(1, 0), a3, voffA);
            PG8_WAIT_V(8); PG8_WAIT_L(0); PG8_BAR; PG8_MMA(1, 0, At, B0); PG8_MMA(1, 1, At, B1); PG8_BAR; PG8_SCHED;
            } else {
            PG8_LDB(B0, 0, 0); PG8_SCHED; PG8_LDA(At, 0, 0); PG8_STAGE(PG8_SA(1, 1), a1 + hstep, voffA);
            PG8_WAIT_L(8); PG8_BAR; PG8_WAIT_L(0); PG8_MMA(0, 0, At, B0); PG8_BAR; PG8_SCHED;
            PG8_LDB(B1, 0, 1); PG8_STAGE(PG8_SB(0, 0), b2, voffB);
            PG8_BAR; PG8_WAIT_L(0); PG8_MMA(0, 1, At, B1); PG8_BAR;
            PG8_LDA(At, 0, 1); PG8_STAGE(PG8_SA(0, 0), a2, voffA);
            PG8_BAR; PG8_WAIT_L(0); PG8_MMA(1, 0, At, B0); PG8_BAR; PG8_SCHED;
            PG8_STAGE(PG8_SB(0, 1), b2 + hstep, voffB);
            PG8_WAIT_V(6); PG8_BAR; PG8_MMA(1, 1, At, B1); PG8_BAR;
            PG8_LDB(B0, 1, 0); PG8_SCHED; PG8_LDA(At, 1, 0); PG8_STAGE(PG8_SA(0, 1), a2 + hstep, voffA);
            PG8_WAIT_L(8); PG8_BAR; PG8_WAIT_L(0); PG8_MMA(0, 0, At, B0); PG8_BAR; PG8_SCHED;
            PG8_LDB(B1, 1, 1); PG8_STAGE(PG8_SB(1, 0), b3, voffB);
            PG8_BAR; PG8_WAIT_L(0); PG8_MMA(0, 1, At, B1); PG8_BAR;
            PG8_LDA(At, 1, 1); PG8_STAGE(PG8_SA(1, 0), a3, voffA);
            PG8_BAR; PG8_WAIT_L(0); PG8_MMA(1, 0, At, B0); PG8_BAR; PG8_SCHED;
            PG8_STAGE(PG8_SB(1, 1), b3 + hstep, voffB);
            PG8_WAIT_V(6); PG8_BAR; PG8_MMA(1, 1, At, B1); PG8_BAR;
            }
        }
        if constexpr (ALIGN_EPI) { if (wr == 0) PG8_BAR; }
        if constexpr (!Epi::AFTER_DRAIN) { E(acc, cur, wr, wc, fr, fq); S.done(cur); }
        if (!has_next) break;
#pragma unroll
        for (int a = 0; a < 2; ++a)
#pragma unroll
            for (int b = 0; b < 2; ++b)
#pragma unroll
                for (int m = 0; m < 4; ++m)
#pragma unroll
                    for (int n = 0; n < 2; ++n) acc[a][b][m][n] = (f32x4){0.f, 0.f, 0.f, 0.f};
        cur = nxt; cA = nA; cB = nB; ++ui;
        if constexpr (ALIGN_EPI) { if (wr == 1) PG8_BAR; }
    }
    PG8_WAIT_V(0);
    if constexpr (!ALIGN_EPI) { if (wr == 0) PG8_BAR; }
    PG8_BAR;
    if constexpr (Epi::AFTER_DRAIN) { E.fused(acc, cur, wr, wc, fr, fq, lds, wid, lane); S.done(cur); }
#undef PG8_SA
#undef PG8_SB
#undef PG8_STAGE
#undef PG8_LDA
#undef PG8_LDB
#undef PG8_MMA
#undef PG8_WAIT_V
#undef PG8_WAIT_L
#undef PG8_BAR
#undef PG8_SCHED
}
}

namespace pg8 {
template <int RELU2, int SCALE = 0> struct EpiStore {
    static constexpr bool PERM = true, AFTER_DRAIN = false;
    bf16_t* O; int ldc; const PG8_LAS float* rstd; mutable int cnt;
    __device__ __forceinline__ void operator()(const f32x4 (&acc)[2][2][4][2], const Unit& u, int wr, int wc, int fr, int fq) const {
        const int row0 = u.pm * BM + wr * 64 + fr, col0 = u.pn * BM + wc * 32 + 8 * fq;
#pragma unroll
        for (int ai = 0; ai < 2; ++ai)
#pragma unroll
            for (int m = 0; m < 4; ++m) { const int row = row0 + ai * HALF + m * 16; bf16_t* rowp = O + (size_t)row * ldc + col0;
                float rs = 1.f;
                if (SCALE) rs = rstd[cnt * 256 + wr * 64 + fr + ai * HALF + m * 16];
#pragma unroll
                for (int bj = 0; bj < 2; ++bj) { f32x4 v0 = acc[ai][bj][m][0] * rs, v1 = acc[ai][bj][m][1] * rs;
                    if (RELU2) {
#pragma unroll
                        for (int e = 0; e < 4; ++e) { const float a = fmaxf(v0[e], 0.f), b = fmaxf(v1[e], 0.f); v0[e] = a * a; v1[e] = b * b; } }
                    u32x4 w; w.x = cvt_pk_bf16(v0[0], v0[1]); w.y = cvt_pk_bf16(v0[2], v0[3]); w.z = cvt_pk_bf16(v1[0], v1[1]); w.w = cvt_pk_bf16(v1[2], v1[3]);
                    *(u32x4*)(rowp + bj * HALF) = w; } }
        if (SCALE) ++cnt;
    }
};

struct EpiStoreAB {
    static constexpr bool PERM = true, AFTER_DRAIN = false;
    bf16_t* O; int ldc; unsigned* kn2;
    __device__ __forceinline__ void operator()(const f32x4 (&acc)[2][2][4][2], const Unit& u, int wr, int wc, int fr, int fq) const {
        const int row0 = u.pm * BM + wr * 64 + fr, col0 = u.pn * BM + wc * 32 + 8 * fq;
#pragma unroll
        for (int ai = 0; ai < 2; ++ai)
#pragma unroll
            for (int m = 0; m < 4; ++m) { bf16_t* rowp = O + (size_t)(row0 + ai * HALF + m * 16) * ldc + col0;
#pragma unroll
                for (int bj = 0; bj < 2; ++bj) { const f32x4 v0 = acc[ai][bj][m][0], v1 = acc[ai][bj][m][1];
                    u32x4 w; w.x = cvt_pk_bf16(v0[0], v0[1]); w.y = cvt_pk_bf16(v0[2], v0[3]); w.z = cvt_pk_bf16(v1[0], v1[1]); w.w = cvt_pk_bf16(v1[2], v1[3]);
                    *(u32x4*)(rowp + bj * HALF) = w; } }
        if (u.pn == 2 || u.pn == 3) {
#pragma unroll
            for (int bj = 0; bj < 2; ++bj) { float mx = 0.f;
#pragma unroll
                for (int ai = 0; ai < 2; ++ai)
#pragma unroll
                    for (int m = 0; m < 4; ++m) { const f32x4 v0 = acc[ai][bj][m][0], v1 = acc[ai][bj][m][1];
                        float s = ((v0[0] * v0[0] + v0[1] * v0[1]) + (v0[2] * v0[2] + v0[3] * v0[3])) + ((v1[0] * v1[0] + v1[1] * v1[1]) + (v1[2] * v1[2] + v1[3] * v1[3]));
                        s += __shfl_xor(s, 16); s += __shfl_xor(s, 32); mx = fmaxf(mx, s); }
                mx = fmaxf(mx, __shfl_xor(mx, 1)); mx = fmaxf(mx, __shfl_xor(mx, 2)); mx = fmaxf(mx, __shfl_xor(mx, 4)); mx = fmaxf(mx, __shfl_xor(mx, 8));
                const int colb = u.pn * BM + bj * HALF + wc * 32 - 512, head = colb >> 6, half = (colb >> 5) & 1, b = u.pm >> 4;
                if (fr == 0 && fq == 0) atomicMax(kn2 + ((b * 8 + head) * 2 + half), __float_as_uint(mx * 1.02f)); }
        }
    }
};
struct EpiResid {
    static constexpr bool PERM = false, AFTER_DRAIN = false;
    const float* base; float* out; int ldc;
    __device__ __forceinline__ void operator()(const f32x4 (&acc)[2][2][4][2], const Unit& u, int wr, int wc, int fr, int fq) const {
        const int row0 = u.pm * BM + wr * 64 + fr, col0 = u.pn * BM + wc * 32 + 4 * fq;
#pragma unroll
        for (int ai = 0; ai < 2; ++ai)
#pragma unroll
            for (int m = 0; m < 4; ++m) { const size_t off = (size_t)(row0 + ai * HALF + m * 16) * ldc + col0;
#pragma unroll
                for (int bj = 0; bj < 2; ++bj)
#pragma unroll
                    for (int n = 0; n < 2; ++n) { const size_t o = off + bj * HALF + n * 16; const f32x4 bs = *(const f32x4*)(base + o); *(f32x4*)(out + o) = bs + acc[ai][bj][m][n]; } }
    }
};

struct EpiResidN {
    static constexpr bool PERM = false, AFTER_DRAIN = false;
    const float* base; float* out; bf16_t* xn; float* ssq; int ldc;
    __device__ __forceinline__ void operator()(const f32x4 (&acc)[2][2][4][2], const Unit& u, int wr, int wc, int fr, int fq) const {
        typedef unsigned u32x2 __attribute__((ext_vector_type(2)));
        const int row0 = u.pm * BM + wr * 64 + fr, col0 = u.pn * BM + wc * 32 + 4 * fq;
#pragma unroll
        for (int ai = 0; ai < 2; ++ai)
#pragma unroll
            for (int m = 0; m < 4; ++m) { const int row = row0 + ai * HALF + m * 16; const size_t off = (size_t)row * ldc + col0; float s = 0.f;
#pragma unroll
                for (int bj = 0; bj < 2; ++bj)
#pragma unroll
                    for (int n = 0; n < 2; ++n) { const size_t o = off + bj * HALF + n * 16; const f32x4 v = *(const f32x4*)(base + o) + acc[ai][bj][m][n]; *(f32x4*)(out + o) = v;
                        u32x2 w; w.x = cvt_pk_bf16(v[0], v[1]); w.y = cvt_pk_bf16(v[2], v[3]); *(u32x2*)(xn + o) = w;
                        s += (v[0] * v[0] + v[1] * v[1]) + (v[2] * v[2] + v[3] * v[3]); }
                s += __shfl_xor(s, 16); s += __shfl_xor(s, 32);
                if (fq == 0) ssq[(size_t)row * 16 + u.pn * 4 + wc] = s; }
    }
};
struct EpiQRope {
    static constexpr bool PERM = false, AFTER_DRAIN = false;
    bf16_t* O; int ldc; const float* tab;
    __device__ __forceinline__ void operator()(const f32x4 (&acc)[2][2][4][2], const Unit& u, int wr, int wc, int fr, int fq) const {
        typedef unsigned u32x2 __attribute__((ext_vector_type(2)));
        const int row0 = u.pm * BM + wr * 64 + fr;
#pragma unroll
        for (int ai = 0; ai < 2; ++ai)
#pragma unroll
            for (int m = 0; m < 4; ++m) { const int row = row0 + ai * HALF + m * 16;
                const f32x4 cs = *(const f32x4*)(tab + (size_t)row * 32 + 4 * fq), sn = *(const f32x4*)(tab + (size_t)row * 32 + 16 + 4 * fq);
#pragma unroll
                for (int bj = 0; bj < 2; ++bj) { const int cgp = u.pn * BM + bj * HALF + wc * 32;
                    f32x4 x1 = acc[ai][bj][m][0], x2 = acc[ai][bj][m][1];
                    if ((cgp % 96) == 64) { const f32x4 o1 = x1 * cs - x2 * sn, o2 = x2 * cs + x1 * sn; x1 = o1; x2 = o2; }
                    bf16_t* op = O + (size_t)row * ldc + cgp + 4 * fq;
                    u32x2 w1, w2; w1.x = cvt_pk_bf16(x1[0], x1[1]); w1.y = cvt_pk_bf16(x1[2], x1[3]); w2.x = cvt_pk_bf16(x2[0], x2[1]); w2.y = cvt_pk_bf16(x2[2], x2[3]);
                    *(u32x2*)op = w1; *(u32x2*)(op + 16) = w2; }
                asm volatile("" ::: "memory"); }
    }
};
}

#define DI __device__ __forceinline__
#define LAS __attribute__((address_space(3)))
typedef unsigned short bf16_t;
typedef short bf16x8 __attribute__((ext_vector_type(8)));
typedef short s16x4 __attribute__((ext_vector_type(4)));
typedef float f32x4 __attribute__((ext_vector_type(4)));
typedef float f32x16 __attribute__((ext_vector_type(16)));
typedef unsigned u32x4 __attribute__((ext_vector_type(4)));
typedef unsigned u32x2 __attribute__((ext_vector_type(2)));

constexpr int BATCH = 4, SEQ = 4096, DM = 1024, MT = BATCH * SEQ, DFF = 4096;
constexpr int LD_AB = 3072, LD_CD = 2304, NSRC_AB = 3080, NSRC_CD = 2208;
constexpr int NWAVES = 8, NTHREADS = 512;
constexpr float LOG2E = 1.4426950408889634f, LN2 = 0.6931471805599453f, EPS = 1e-6f;
constexpr size_t MiB = 1u << 20;
constexpr size_t WS_WINAB = 0, WS_WOUTAB = 6 * MiB, WS_WINCD = 8 * MiB, WS_WUQ = 13 * MiB, WS_WUKV = 14 * MiB, WS_WOUTCD = 15 * MiB;
constexpr size_t WS_WUP0 = 17 * MiB, WS_WUP1 = 25 * MiB, WS_WDN0 = 33 * MiB, WS_WDN1 = 41 * MiB;
constexpr size_t WS_LOGF = 49 * MiB, WS_CUM = 49 * MiB + 512 * 1024, WS_TAB = 50 * MiB, WS_KR = 52 * MiB, WS_SSQ = 53 * MiB;
constexpr size_t WS_XN = 54 * MiB, WS_CQN = 54 * MiB, WS_CKVN = 66 * MiB, WS_O = 86 * MiB;
constexpr size_t WS_BIG = 118 * MiB, WS_QF = 190 * MiB, WS_KVF = 214 * MiB, WS_CTL = 246 * MiB, CTL_BYTES = 65536, CTL_KN2 = 32768, WS_END = 247 * MiB;
constexpr int LDS_BYTES = 147456, MISC_OFF = 131072 + 320;

DI float bf2f(unsigned short v) { return __uint_as_float((unsigned)v << 16); }
DI unsigned pk2(float lo, float hi) { typedef float f2 __attribute__((ext_vector_type(2))); typedef __bf16 b2 __attribute__((ext_vector_type(2))); f2 v = {lo, hi}; b2 b = __builtin_convertvector(v, b2); return __builtin_bit_cast(unsigned, b); }
DI float wave_sum(float v) {
#pragma unroll
    for (int o = 1; o < 64; o <<= 1) v += __shfl_xor(v, o);
    return v;
}
DI float fexp2(float x) { return __builtin_amdgcn_exp2f(x); }
DI float flog2(float x) { return __builtin_amdgcn_logf(x); }

DI void transpose_item(const float* W, int K, int ldn, int src_col0, bf16_t* WT, int dst_row0, int nblk, LAS float* scr, int item, int lane, const float* gain) {
    const int kb = item / nblk, nb = item % nblk, k0 = 64 * kb, n0 = 32 * nb;
    float wv[32];
#pragma unroll
    for (int i = 0; i < 32; ++i) { const int kk = 2 * i + (lane >> 5); wv[i] = W[(size_t)(k0 + kk) * ldn + src_col0 + n0 + (lane & 31)]; }
    if (gain) {
#pragma unroll
        for (int i = 0; i < 32; ++i) wv[i] *= gain[k0 + 2 * i + (lane >> 5)]; }
#pragma unroll
    for (int i = 0; i < 32; ++i) { const int kk = 2 * i + (lane >> 5); scr[kk * 33 + (lane & 31)] = wv[i]; }
    asm volatile("s_waitcnt lgkmcnt(0)" ::: "memory");
    const int c = lane & 7;
#pragma unroll
    for (int j = 0; j < 4; ++j) { const int n = (lane >> 3) + 8 * j; const LAS float* s = scr + (8 * c) * 33 + n;
        u32x4 o; o.x = pk2(s[0 * 33], s[1 * 33]); o.y = pk2(s[2 * 33], s[3 * 33]); o.z = pk2(s[4 * 33], s[5 * 33]); o.w = pk2(s[6 * 33], s[7 * 33]);
        *(u32x4*)(WT + (size_t)(dst_row0 + n0 + n) * K + k0 + 8 * c) = o; }
    asm volatile("s_waitcnt lgkmcnt(0)" ::: "memory");
}

DI void sincos_d(double a, float& sn, float& cs);
DI float inv_freq_f(int i);
template <bool FA> DI void norm_rows_bf16(const float* src, const float* gain, bf16_t* dst, int gw, int ngw, int lane, const LAS float* wfaT, const float* b_forget, float* logf_out, const int* pos, float* tab) {
    f32x4 g[4];
#pragma unroll
    for (int j = 0; j < 4; ++j) g[j] = ((const f32x4*)gain)[64 * j + lane];
    f32x4 nx[4];
    if (gw < MT) {
#pragma unroll
        for (int j = 0; j < 4; ++j) nx[j] = ((const f32x4*)(src + (size_t)gw * DM) + lane)[64 * j]; }
    for (int row = gw; row < MT; row += ngw) {
        f32x4 v[4]; float s = 0.f;
#pragma unroll
        for (int j = 0; j < 4; ++j) v[j] = nx[j];
        if (row + ngw < MT) {
#pragma unroll
            for (int j = 0; j < 4; ++j) nx[j] = ((const f32x4*)(src + (size_t)(row + ngw) * DM) + lane)[64 * j]; }
#pragma unroll
        for (int j = 0; j < 4; ++j) { s += (v[j].x * v[j].x + v[j].y * v[j].y) + (v[j].z * v[j].z + v[j].w * v[j].w); v[j] = v[j] * g[j]; }
        float a8[8];
        if (FA) {
#pragma unroll
            for (int jj = 0; jj < 8; ++jj) { float a = 0.f;
#pragma unroll
                for (int j = 0; j < 4; ++j) { const f32x4 w = *(const LAS f32x4*)(wfaT + jj * 1024 + 256 * j + 4 * lane); a += (v[j].x * w.x + v[j].y * w.y) + (v[j].z * w.z + v[j].w * w.w); }
                a8[jj] = a; }
        }
        const float rstd = 1.0f / sqrtf(wave_sum(s) * (1.f / DM) + EPS);
        unsigned long long* o8 = (unsigned long long*)(dst + (size_t)row * DM) + lane;
#pragma unroll
        for (int j = 0; j < 4; ++j) { const f32x4 y = v[j] * rstd; o8[64 * j] = (unsigned long long)pk2(y.x, y.y) | ((unsigned long long)pk2(y.z, y.w) << 32); }
        if (FA) {
            float b4[4], c2[2], d;
            { const bool up = (lane & 32) != 0;
#pragma unroll
              for (int i = 0; i < 4; ++i) { const float keep = up ? a8[i + 4] : a8[i], send = up ? a8[i] : a8[i + 4]; b4[i] = keep + __shfl_xor(send, 32); } }
            { const bool up = (lane & 16) != 0;
#pragma unroll
              for (int i = 0; i < 2; ++i) { const float keep = up ? b4[i + 2] : b4[i], send = up ? b4[i] : b4[i + 2]; c2[i] = keep + __shfl_xor(send, 16); } }
            { const bool up = (lane & 8) != 0; const float keep = up ? c2[1] : c2[0], send = up ? c2[0] : c2[1]; d = keep + __shfl_xor(send, 8); }
            d += __shfl_xor(d, 4); d += __shfl_xor(d, 2); d += __shfl_xor(d, 1);
            if ((lane & 7) == 0) { const int j = lane >> 3; const float t = d * rstd + b_forget[j]; const float ls = fminf(t, 0.f) - log1pf(expf(-fabsf(t))); logf_out[(size_t)row * 8 + j] = ls; }
            if (lane < 16) { const float ang = (float)pos[row] * inv_freq_f(lane); float sn, cs; sincos_d((double)ang, sn, cs); tab[(size_t)row * 32 + lane] = cs; tab[(size_t)row * 32 + 16 + lane] = sn; }
        }
    }
}
DI void norm_rows_f32(float* buf, const float* gain, int gw, int ngw, int lane) {
    f32x4 g[4];
#pragma unroll
    for (int j = 0; j < 4; ++j) g[j] = ((const f32x4*)gain)[64 * j + lane];
    for (int row = gw; row < MT; row += ngw) {
        f32x4* xr = (f32x4*)(buf + (size_t)row * DM) + lane;
        f32x4 v[4]; float s = 0.f;
#pragma unroll
        for (int j = 0; j < 4; ++j) { v[j] = xr[64 * j]; s += (v[j].x * v[j].x + v[j].y * v[j].y) + (v[j].z * v[j].z + v[j].w * v[j].w); }
        const float rstd = 1.0f / sqrtf(wave_sum(s) * (1.f / DM) + EPS);
#pragma unroll
        for (int j = 0; j < 4; ++j) xr[64 * j] = v[j] * rstd * g[j];
    }
}

DI void sincos_d(double a, float& sn, float& cs) {
    const double n = rint(a * 0.63661977236758134308);
    const double r = fma(-n, 1.5707963267948966192, a) - n * 6.123233995736766e-17;
    const double r2 = r * r;
    double sp = -2.5052108385441718775e-8; sp = sp * r2 + 2.7557319223985890653e-6; sp = sp * r2 - 1.9841269841269841270e-4; sp = sp * r2 + 8.3333333333333333333e-3; sp = sp * r2 - 1.6666666666666666667e-1; sp = r + r * r2 * sp;
    double cp = 2.0876756987868098979e-9; cp = cp * r2 - 2.7557319223985890653e-7; cp = cp * r2 + 2.4801587301587301587e-5; cp = cp * r2 - 1.3888888888888888889e-3; cp = cp * r2 + 4.1666666666666666667e-2; cp = cp * r2 - 0.5; cp = 1.0 + r2 * cp;
    const int q = (int)((long long)n & 3);
    const double s_ = (q == 0) ? sp : (q == 1) ? cp : (q == 2) ? -sp : -cp;
    const double c_ = (q == 0) ? cp : (q == 1) ? -sp : (q == 2) ? -cp : sp;
    sn = (float)s_; cs = (float)c_;
}
DI float inv_freq_f(int i) {
    float r = 1.0f;
    r = (i == 1) ? 0.56234132519034908f : r;
    r = (i == 2) ? 0.31622776601683794f : r;
    r = (i == 3) ? 0.17782794100389228f : r;
    r = (i == 4) ? 0.1f : r;
    r = (i == 5) ? 0.056234132519034911f : r;
    r = (i == 6) ? 0.031622776601683791f : r;
    r = (i == 7) ? 0.017782794100389229f : r;
    r = (i == 8) ? 0.01f : r;
    r = (i == 9) ? 0.0056234132519034910f : r;
    r = (i == 10) ? 0.0031622776601683794f : r;
    r = (i == 11) ? 0.0017782794100389228f : r;
    r = (i == 12) ? 0.001f : r;
    r = (i == 13) ? 0.00056234132519034907f : r;
    r = (i == 14) ? 0.00031622776601683794f : r;
    r = (i == 15) ? 0.00017782794100389227f : r;
    return r;
}
DI void mla_prep_rows(const bf16_t* PC, const int* pos, const float* q_norm, const float* kv_norm, bf16_t* cqn, bf16_t* ckvn, float* tab, bf16_t* KR, int gw, int ngw, int lane) {
    for (int row = gw; row < MT; row += ngw) {
        const bf16_t* pr = PC + (size_t)row * LD_CD;
        {
            float v[8]; float s = 0.f;
            if (lane < 48) { const u32x4 w = *(const u32x4*)(pr + 1536 + 8 * lane);
#pragma unroll
                for (int e = 0; e < 4; ++e) { v[2 * e] = __uint_as_float(w[e] << 16); v[2 * e + 1] = __uint_as_float(w[e] & 0xffff0000u); s += v[2 * e] * v[2 * e] + v[2 * e + 1] * v[2 * e + 1]; } }
            else {
#pragma unroll
                for (int e = 0; e < 8; ++e) v[e] = 0.f; }
            const float rstd = 1.0f / sqrtf(wave_sum(s) * (1.f / 384.f) + EPS);
            if (lane < 48) { const f32x4 g0 = *(const f32x4*)(q_norm + 8 * lane), g1 = *(const f32x4*)(q_norm + 8 * lane + 4);
                u32x4 o; o.x = pk2(v[0] * rstd * g0.x, v[1] * rstd * g0.y); o.y = pk2(v[2] * rstd * g0.z, v[3] * rstd * g0.w); o.z = pk2(v[4] * rstd * g1.x, v[5] * rstd * g1.y); o.w = pk2(v[6] * rstd * g1.z, v[7] * rstd * g1.w);
                *(u32x4*)(cqn + (size_t)row * 384 + 8 * lane) = o; }
        }
        {
            float v[8]; float s = 0.f;
            if (lane < 32) { const u32x4 w = *(const u32x4*)(pr + 1920 + 8 * lane);
#pragma unroll
                for (int e = 0; e < 4; ++e) { v[2 * e] = __uint_as_float(w[e] << 16); v[2 * e + 1] = __uint_as_float(w[e] & 0xffff0000u); s += v[2 * e] * v[2 * e] + v[2 * e + 1] * v[2 * e + 1]; } }
            else {
#pragma unroll
                for (int e = 0; e < 8; ++e) v[e] = 0.f; }
            const float rstd = 1.0f / sqrtf(wave_sum(s) * (1.f / 256.f) + EPS);
            if (lane < 32) { const f32x4 g0 = *(const f32x4*)(kv_norm + 8 * lane), g1 = *(const f32x4*)(kv_norm + 8 * lane + 4);
                u32x4 o; o.x = pk2(v[0] * rstd * g0.x, v[1] * rstd * g0.y); o.y = pk2(v[2] * rstd * g0.z, v[3] * rstd * g0.w); o.z = pk2(v[4] * rstd * g1.x, v[5] * rstd * g1.y); o.w = pk2(v[6] * rstd * g1.z, v[7] * rstd * g1.w);
                *(u32x4*)(ckvn + (size_t)row * 256 + 8 * lane) = o; }
        }
        if (lane < 16) {
            const float cs = tab[(size_t)row * 32 + lane], sn = tab[(size_t)row * 32 + 16 + lane];
            const float x1 = bf2f(pr[2176 + lane]), x2 = bf2f(pr[2176 + 16 + lane]);
            KR[(size_t)row * 32 + lane] = (bf16_t)(pk2(x1 * cs - x2 * sn, 0.f) & 0xffffu);
            KR[(size_t)row * 32 + 16 + lane] = (bf16_t)(pk2(x2 * cs + x1 * sn, 0.f) & 0xffffu);
        }
    }
}

namespace att {
constexpr int KBUF = 13312, VBUF = 9216;
constexpr int OFF_K = 0, OFF_V = 2 * KBUF, OFF_C = OFF_V + 2 * VBUF, OFF_RB = OFF_C + 512, OFF_FLAG = OFF_RB + 1280, ATT_LDS = OFF_FLAG + 64;
DI f32x16 mfma(bf16x8 a, bf16x8 b, f32x16 c) { return __builtin_amdgcn_mfma_f32_32x32x16_bf16(a, b, c, 0, 0, 0); }
DI int crow(int i, int hh) { return (i & 3) + 8 * (i >> 2) + 4 * hh; }
DI bf16x8 packfrag(const f32x16& p, int s) { u32x4 w; w.x = pk2(p[8 * s], p[8 * s + 1]); w.y = pk2(p[8 * s + 2], p[8 * s + 3]); w.z = pk2(p[8 * s + 4], p[8 * s + 5]); w.w = pk2(p[8 * s + 6], p[8 * s + 7]); return __builtin_bit_cast(bf16x8, w); }
typedef short v4i16_t __attribute__((ext_vector_type(4)));
DI s16x4 vtr(const LAS unsigned char* p) { return __builtin_bit_cast(s16x4, __builtin_amdgcn_ds_read_tr16_b64_v4i16((LAS v4i16_t*)p)); }

struct Lane { int tid, lane, wid, r, hh, q4, p4, blk, srow, sch; };
DI Lane mklane() { Lane L; L.tid = threadIdx.x; L.lane = L.tid & 63; L.wid = __builtin_amdgcn_readfirstlane(L.tid >> 6); L.r = L.lane & 31; L.hh = L.lane >> 5;
    const int i16 = L.lane & 15; L.q4 = i16 >> 2; L.p4 = i16 & 3; L.blk = (L.lane >> 4) & 1; L.srow = L.tid >> 3; L.sch = L.tid & 7; return L; }

template <int NDS, int KSTRIDE> DI void qk_tile(f32x16& p0, f32x16& p1, const LAS unsigned char* Kb, const bf16x8* qf, const Lane& L) {
    const LAS unsigned char* ka = Kb + L.r * KSTRIDE + L.hh * 16;
#pragma unroll
    for (int i = 0; i < 16; ++i) { p0[i] = 0.f; p1[i] = 0.f; }
#pragma unroll
    for (int ds = 0; ds < NDS; ++ds) {
        const bf16x8 a0 = *(const LAS bf16x8*)(ka + ds * 32), a1 = *(const LAS bf16x8*)(ka + 32 * KSTRIDE + ds * 32);
        p0 = mfma(a0, qf[ds], p0); p1 = mfma(a1, qf[ds], p1); }
}
DI void pv_tile(f32x16& o0, f32x16& o1, const LAS unsigned char* Vb, const bf16x8 (&pf)[4], const Lane& L) {
    const LAS unsigned char* vb = Vb + (4 * L.hh + L.q4) * 144 + (16 * L.blk + 4 * L.p4) * 2;
#pragma unroll
    for (int f = 0; f < 4; ++f) { const LAS unsigned char* base = vb + (16 * f) * 144;
        { const s16x4 lo = vtr(base), hi = vtr(base + 8 * 144); const bf16x8 vf = __builtin_shufflevector(lo, hi, 0, 1, 2, 3, 4, 5, 6, 7); o0 = mfma(vf, pf[f], o0); }
        { const s16x4 lo = vtr(base + 64), hi = vtr(base + 8 * 144 + 64); const bf16x8 vf = __builtin_shufflevector(lo, hi, 0, 1, 2, 3, 4, 5, 6, 7); o1 = mfma(vf, pf[f], o1); } }
}
DI void online_softmax(f32x16& p0, f32x16& p1, float& m, float& l, f32x16& o0, f32x16& o1, bf16x8 (&pf)[4]) {
    float mt = fmaxf(p0[0], p1[0]);
#pragma unroll
    for (int i = 1; i < 16; ++i) mt = fmaxf(mt, fmaxf(p0[i], p1[i]));
    mt = fmaxf(mt, __shfl_xor(mt, 32));
    if (__any(mt > m)) {
        const float mn = fmaxf(m, mt), alpha = fexp2(m - mn); m = mn; l *= alpha;
#pragma unroll
        for (int i = 0; i < 16; ++i) { o0[i] *= alpha; o1[i] *= alpha; }
    }
    float rs = 0.f;
#pragma unroll
    for (int i = 0; i < 16; ++i) { p0[i] = fexp2(p0[i] - m); p1[i] = fexp2(p1[i] - m); rs += p0[i] + p1[i]; }
    l += rs;
    pf[0] = packfrag(p0, 0); pf[1] = packfrag(p0, 1); pf[2] = packfrag(p1, 0); pf[3] = packfrag(p1, 1);
}
DI void store_o(bf16_t* orow, const f32x16& o0, const f32x16& o1, float inv, int hh) {
#pragma unroll
    for (int g = 0; g < 4; ++g) {
        u32x2 w0, w1; w0.x = pk2(o0[4 * g] * inv, o0[4 * g + 1] * inv); w0.y = pk2(o0[4 * g + 2] * inv, o0[4 * g + 3] * inv);
        w1.x = pk2(o1[4 * g] * inv, o1[4 * g + 1] * inv); w1.y = pk2(o1[4 * g + 2] * inv, o1[4 * g + 3] * inv);
        *(u32x2*)(orow + 8 * g + 4 * hh) = w0; *(u32x2*)(orow + 32 + 8 * g + 4 * hh) = w1; }
}

DI void fox_unit(LAS unsigned char* lds, const bf16_t* PA, const float* cum, const unsigned* kn2, bf16_t* O, int b, int h, int qb) {
    const Lane L = mklane();
    const size_t rowbase = (size_t)b * SEQ;
    const int q0 = qb * 256, q0w = q0 + L.wid * 32, myq = q0w + L.r;
    const bf16_t* Qp = PA + (rowbase + myq) * LD_AB + h * 64;
    const bf16_t* Kp = PA + rowbase * LD_AB + 512 + h * 64;
    const bf16_t* Vp = Kp + 512;
    const float* cumh = cum + (size_t)(b * 8 + h) * SEQ;
    bf16x8 qf[4];
#pragma unroll
    for (int ds = 0; ds < 4; ++ds) qf[ds] = *(const bf16x8*)(Qp + 16 * ds + 8 * L.hh);
    const float c1 = 0.125f * LOG2E;
    float qn2 = 0.f;
#pragma unroll
    for (int ds = 0; ds < 4; ++ds)
#pragma unroll
        for (int j = 0; j < 8; ++j) { const float qv = bf2f((unsigned short)qf[ds][j]); qn2 += qv * qv; }
    qn2 += __shfl_xor(qn2, 32);
    const float kmax2 = __uint_as_float(kn2[(b * 8 + h) * 2]) + __uint_as_float(kn2[(b * 8 + h) * 2 + 1]);
    const float smax = sqrtf(qn2 * kmax2) * c1 * 1.01f + 1e-3f;
    const int NT = (q0 + 256) / 64;
    float m = -INFINITY, l = 0.f; f32x16 o0, o1;
#pragma unroll
    for (int i = 0; i < 16; ++i) { o0[i] = 0.f; o1[i] = 0.f; }
    bool seen = false;
    LAS int* flags = (LAS int*)(lds + OFF_FLAG);
    u32x4 kreg, vreg; float creg = 0.f;
#define FOX_LOAD(t) do { kreg = *(const u32x4*)(Kp + (size_t)((t) * 64 + L.srow) * LD_AB + L.sch * 8); vreg = *(const u32x4*)(Vp + (size_t)((t) * 64 + L.srow) * LD_AB + L.sch * 8); \
        if (L.tid < 64) creg = cumh[(t) * 64 + L.tid] * (-LOG2E); } while (0)
#define FOX_WRITE(bf) do { *(LAS u32x4*)(lds + OFF_K + (bf) * KBUF + L.srow * 144 + L.sch * 16) = kreg; *(LAS u32x4*)(lds + OFF_V + (bf) * VBUF + L.srow * 144 + L.sch * 16) = vreg; \
        if (L.tid < 64) *(LAS float*)(lds + OFF_C + (bf) * 256 + L.tid * 4) = creg; } while (0)
    FOX_LOAD(NT - 1); FOX_WRITE(0); __syncthreads();
    for (int it = 0; it < NT; ++it) {
        const int t = NT - 1 - it, k0 = t * 64, bf = it & 1;
        if (t > 0) FOX_LOAD(t - 1);
        bool done = false;
        if (k0 <= q0w + 31) {
            const LAS unsigned char* Cb = lds + OFF_C + bf * 256;
            const float nck_last = *(const LAS float*)(Cb + 63 * 4);
            done = seen && __all(smax + nck_last - m < -40.0f);
            if (!done) {
                f32x16 p0, p1;
                qk_tile<4, 144>(p0, p1, lds + OFF_K + bf * KBUF, qf, L);
#pragma unroll
                for (int g = 0; g < 4; ++g) { const f32x4 ca = *(const LAS f32x4*)(Cb + (8 * g + 4 * L.hh) * 4), cb = *(const LAS f32x4*)(Cb + (32 + 8 * g + 4 * L.hh) * 4);
#pragma unroll
                    for (int e = 0; e < 4; ++e) { p0[4 * g + e] = fmaf(p0[4 * g + e], c1, ca[e]); p1[4 * g + e] = fmaf(p1[4 * g + e], c1, cb[e]); } }
                if (k0 + 63 > q0w) {
#pragma unroll
                    for (int i = 0; i < 16; ++i) { const int key = k0 + crow(i, L.hh); if (key > myq) p0[i] = -INFINITY; if (key + 32 > myq) p1[i] = -INFINITY; } }
                bf16x8 pf[4];
                online_softmax(p0, p1, m, l, o0, o1, pf);
                pv_tile(o0, o1, lds + OFF_V + bf * VBUF, pf, L);
                seen = true;
            }
        }
        if (L.lane == 0) flags[(it & 1) * 8 + L.wid] = done ? 1 : 0;
        if (t > 0) FOX_WRITE((it + 1) & 1);
        __syncthreads();
        int alld = 1;
#pragma unroll
        for (int w = 0; w < 8; ++w) alld &= flags[(it & 1) * 8 + w];
        if (alld) break;
    }
#undef FOX_LOAD
#undef FOX_WRITE
    const float lt = l + __shfl_xor(l, 32);
    store_o(O + (rowbase + myq) * DM + h * 64, o0, o1, 1.0f / lt, L.hh);
    __syncthreads();
}

DI void chk_unit(LAS unsigned char* lds, const bf16_t* PA, const float* rel_bias, bf16_t* O, int b, int h, int g4) {
    const Lane L = mklane();
    const size_t rowbase = (size_t)b * SEQ;
    const int cw = 4 * g4 + (L.wid >> 1), myq = 64 * cw + 32 * (L.wid & 1) + L.r;
    const bf16_t* Qp = PA + (rowbase + myq) * LD_AB + 1536 + h * 64;
    const bf16_t* Kp = PA + rowbase * LD_AB + 2048 + h * 64;
    const bf16_t* Vp = Kp + 512;
    bf16x8 qf[4];
#pragma unroll
    for (int ds = 0; ds < 4; ++ds) qf[ds] = *(const bf16x8*)(Qp + 16 * ds + 8 * L.hh);
    const float c1 = 0.125f * LOG2E;
    const int c_lo = (4 * g4 - 8) > 0 ? (4 * g4 - 8) : 0, NT = 4 * g4 + 4 - c_lo;
    LAS float* rb = (LAS float*)(lds + OFF_RB);
    if (L.tid < 320) rb[L.tid] = rel_bias[h * 320 + L.tid] * LOG2E;
    float m = -INFINITY, l = 0.f; f32x16 o0, o1;
#pragma unroll
    for (int i = 0; i < 16; ++i) { o0[i] = 0.f; o1[i] = 0.f; }
    u32x4 kreg, vreg;
#define CHK_LOAD(t) do { kreg = *(const u32x4*)(Kp + (size_t)((c_lo + (t)) * 64 + L.srow) * LD_AB + L.sch * 8); vreg = *(const u32x4*)(Vp + (size_t)((c_lo + (t)) * 64 + L.srow) * LD_AB + L.sch * 8); } while (0)
#define CHK_WRITE(bf) do { *(LAS u32x4*)(lds + OFF_K + (bf) * KBUF + L.srow * 144 + L.sch * 16) = kreg; *(LAS u32x4*)(lds + OFF_V + (bf) * VBUF + L.srow * 144 + L.sch * 16) = vreg; } while (0)
    CHK_LOAD(0); CHK_WRITE(0); __syncthreads();
    for (int t = 0; t < NT; ++t) {
        if (t + 1 < NT) CHK_LOAD(t + 1);
        const int kc = c_lo + t, bf = t & 1;
        if (kc >= cw - 8 && kc <= cw) {
            f32x16 p0, p1;
            qk_tile<4, 144>(p0, p1, lds + OFF_K + bf * KBUF, qf, L);
            if (cw - kc >= 5) { const float bb = rb[319];
#pragma unroll
                for (int i = 0; i < 16; ++i) { p0[i] = fmaf(p0[i], c1, bb); p1[i] = fmaf(p1[i], c1, bb); } }
            else {
#pragma unroll
                for (int i = 0; i < 16; ++i) { const int rel = myq - (64 * kc + crow(i, L.hh));
                    const int i0 = (rel < 256 ? rel : 256) + 63, i1 = (rel - 32 < 256 ? rel - 32 : 256) + 63;
                    p0[i] = fmaf(p0[i], c1, rb[i0]); p1[i] = fmaf(p1[i], c1, rb[i1]); } }
            bf16x8 pf[4];
            online_softmax(p0, p1, m, l, o0, o1, pf);
            pv_tile(o0, o1, lds + OFF_V + bf * VBUF, pf, L);
        }
        if (t + 1 < NT) CHK_WRITE((t + 1) & 1);
        __syncthreads();
    }
#undef CHK_LOAD
#undef CHK_WRITE
    const float lt = l + __shfl_xor(l, 32);
    store_o(O + (rowbase + myq) * DM + 512 + h * 64, o0, o1, 1.0f / lt, L.hh);
}

DI void mla_unit(LAS unsigned char* lds, const bf16_t* QF, const bf16_t* KVF, const bf16_t* KR, bf16_t* O, int b, int h, int qb) {
    const Lane L = mklane();
    const size_t rowbase = (size_t)b * SEQ;
    const int cw = 4 * qb + (L.wid >> 1), myq = 64 * cw + 32 * (L.wid & 1) + L.r;
    const bf16_t* Qp = QF + (rowbase + myq) * 768 + h * 96;
    const bf16_t* Kp = KVF + rowbase * 1024 + h * 128;
    const bf16_t* Vp = Kp + 64;
    const bf16_t* Rp = KR + rowbase * 32;
    bf16x8 qf[6];
#pragma unroll
    for (int ds = 0; ds < 6; ++ds) qf[ds] = *(const bf16x8*)(Qp + 16 * ds + 8 * L.hh);
    const float c1 = 0.10206207261596577f * LOG2E;
    const int NT = 4 * qb + 4;
    float m = -INFINITY, l = 0.f; f32x16 o0, o1;
#pragma unroll
    for (int i = 0; i < 16; ++i) { o0[i] = 0.f; o1[i] = 0.f; }
    u32x4 kreg, vreg, rreg;
#define MLA_LOAD(t) do { kreg = *(const u32x4*)(Kp + (size_t)((t) * 64 + L.srow) * 1024 + L.sch * 8); vreg = *(const u32x4*)(Vp + (size_t)((t) * 64 + L.srow) * 1024 + L.sch * 8); \
        if (L.tid < 256) rreg = *(const u32x4*)(Rp + (size_t)((t) * 64 + (L.tid >> 2)) * 32 + (L.tid & 3) * 8); } while (0)
#define MLA_WRITE(bf) do { *(LAS u32x4*)(lds + OFF_K + (bf) * KBUF + L.srow * 208 + L.sch * 16) = kreg; *(LAS u32x4*)(lds + OFF_V + (bf) * VBUF + L.srow * 144 + L.sch * 16) = vreg; \
        if (L.tid < 256) *(LAS u32x4*)(lds + OFF_K + (bf) * KBUF + (L.tid >> 2) * 208 + 128 + (L.tid & 3) * 16) = rreg; } while (0)
    MLA_LOAD(0); MLA_WRITE(0); __syncthreads();
    for (int t = 0; t < NT; ++t) {
        if (t + 1 < NT) MLA_LOAD(t + 1);
        const int bf = t & 1;
        if (t <= cw) {
            f32x16 p0, p1;
            qk_tile<6, 208>(p0, p1, lds + OFF_K + bf * KBUF, qf, L);
#pragma unroll
            for (int i = 0; i < 16; ++i) { p0[i] *= c1; p1[i] *= c1; }
            bf16x8 pf[4];
            online_softmax(p0, p1, m, l, o0, o1, pf);
            pv_tile(o0, o1, lds + OFF_V + bf * VBUF, pf, L);
        }
        if (t + 1 < NT) MLA_WRITE((t + 1) & 1);
        __syncthreads();
    }
#undef MLA_LOAD
#undef MLA_WRITE
    const float lt = l + __shfl_xor(l, 32);
    store_o(O + (rowbase + myq) * DM + 512 + h * 64, o0, o1, 1.0f / lt, L.hh);
}

DI void sb_sub(f32x16& p, float& R, int keybase, int myq, int hh, bool need_mask) {
    float lk[16], lb[16];
#pragma unroll
    for (int i = 0; i < 16; ++i) {
        const float z = p[i] * 0.125f, u = fexp2(-fabsf(z) * LOG2E), sp = fmaxf(z, 0.f) + flog2(1.0f + u) * LN2;
        const bool valid = !need_mask || (keybase + crow(i, hh)) < myq;
        lk[i] = valid ? -sp : 0.f; lb[i] = valid ? (z - sp) : -INFINITY; }
    float G[4], Gp[4];
#pragma unroll
    for (int g = 0; g < 4; ++g) { G[g] = (lk[4 * g] + lk[4 * g + 1]) + (lk[4 * g + 2] + lk[4 * g + 3]); Gp[g] = __shfl_xor(G[g], 32); }
    float acc = R;
#pragma unroll
    for (int g = 3; g >= 0; --g) {
        const float s3 = hh ? acc : acc + Gp[g];
        acc += G[g] + Gp[g];
        const float s2 = s3 + lk[4 * g + 3], s1 = s2 + lk[4 * g + 2], s0 = s1 + lk[4 * g + 1];
        p[4 * g + 3] = fexp2((lb[4 * g + 3] + s3) * LOG2E); p[4 * g + 2] = fexp2((lb[4 * g + 2] + s2) * LOG2E);
        p[4 * g + 1] = fexp2((lb[4 * g + 1] + s1) * LOG2E); p[4 * g] = fexp2((lb[4 * g] + s0) * LOG2E); }
    R = acc;
}
DI void sb_unit(LAS unsigned char* lds, const bf16_t* PC, bf16_t* O, int b, int h, int qb) {
    const Lane L = mklane();
    const size_t rowbase = (size_t)b * SEQ;
    const int q0 = qb * 256, q0w = q0 + L.wid * 32, myq = q0w + L.r;
    const bf16_t* Qp = PC + (rowbase + myq) * LD_CD + h * 64;
    const bf16_t* Kp = PC + rowbase * LD_CD + 512 + h * 64;
    const bf16_t* Vp = Kp + 512;
    bf16x8 qf[4];
#pragma unroll
    for (int ds = 0; ds < 4; ++ds) qf[ds] = *(const bf16x8*)(Qp + 16 * ds + 8 * L.hh);
    const int NT = (q0 + 256) / 64;
    float R = 0.f; f32x16 o0, o1;
#pragma unroll
    for (int i = 0; i < 16; ++i) { o0[i] = 0.f; o1[i] = 0.f; }
    bool seen = false;
    LAS int* flags = (LAS int*)(lds + OFF_FLAG);
    u32x4 kreg, vreg;
#define SB_LOAD(t) do { kreg = *(const u32x4*)(Kp + (size_t)((t) * 64 + L.srow) * LD_CD + L.sch * 8); vreg = *(const u32x4*)(Vp + (size_t)((t) * 64 + L.srow) * LD_CD + L.sch * 8); } while (0)
#define SB_WRITE(bf) do { *(LAS u32x4*)(lds + OFF_K + (bf) * KBUF + L.srow * 144 + L.sch * 16) = kreg; *(LAS u32x4*)(lds + OFF_V + (bf) * VBUF + L.srow * 144 + L.sch * 16) = vreg; } while (0)
    SB_LOAD(NT - 1); SB_WRITE(0); __syncthreads();
    for (int it = 0; it < NT; ++it) {
        const int t = NT - 1 - it, k0 = t * 64, bf = it & 1;
        if (t > 0) SB_LOAD(t - 1);
        bool done = false;
        if (k0 <= q0w + 31) {
            done = seen && __all(R < -110.0f);
            if (!done) {
                f32x16 p0, p1;
                qk_tile<4, 144>(p0, p1, lds + OFF_K + bf * KBUF, qf, L);
                const bool nm = (k0 + 63 >= q0w);
                sb_sub(p1, R, k0 + 32, myq, L.hh, nm);
                sb_sub(p0, R, k0, myq, L.hh, nm);
                bf16x8 pf[4];
                pf[0] = packfrag(p0, 0); pf[1] = packfrag(p0, 1); pf[2] = packfrag(p1, 0); pf[3] = packfrag(p1, 1);
                pv_tile(o0, o1, lds + OFF_V + bf * VBUF, pf, L);
                seen = true;
                done = __all(R < -110.0f);
            }
        }
        if (L.lane == 0) flags[(it & 1) * 8 + L.wid] = done ? 1 : 0;
        if (t > 0) SB_WRITE((it + 1) & 1);
        __syncthreads();
        int alld = 1;
#pragma unroll
        for (int w = 0; w < 8; ++w) alld &= flags[(it & 1) * 8 + w];
        if (alld) break;
    }
#undef SB_LOAD
#undef SB_WRITE
    store_o(O + (rowbase + myq) * DM + h * 64, o0, o1, 1.0f, L.hh);
    __syncthreads();
}
}

#define XB_TMO      128
#define XB_XCNT(j)  (256  + 64 * (j))
#define XB_XSUB(j)  (1280 + 64 * (j))
#define XB_XGEN(j)  (2304 + 64 * (j))
#define XB_TOP      3328
#define XB_TOPGEN   3392
#define XCD_BAR_WORDS 3456
#define XB_SPIN_CAP (1u << 18)

__device__ __forceinline__ unsigned xb_ld(unsigned* p)              { return __hip_atomic_load(p, __ATOMIC_RELAXED, __HIP_MEMORY_SCOPE_AGENT); }
__device__ __forceinline__ unsigned xb_add(unsigned* p, unsigned v) { return __hip_atomic_fetch_add(p, v, __ATOMIC_RELAXED, __HIP_MEMORY_SCOPE_AGENT); }
__device__ __forceinline__ unsigned xb_xcc_id() { return (unsigned)__builtin_amdgcn_s_getreg((3 << 11) | 20) & 0xFu; }
#define XB_SPIN(cond, bar) do { unsigned _sp = 0; while (cond) { __builtin_amdgcn_s_sleep(1); \
    if ((++_sp & 255u) == 0u) { if (xb_ld(&(bar)[XB_TMO])) break; if (_sp > XB_SPIN_CAP) { atomicAdd(&(bar)[XB_TMO], 1u); break; } } } } while (0)

struct XcdBarrier {
    unsigned* bar; unsigned x;
    volatile LAS unsigned* st;
};

__device__ __forceinline__ XcdBarrier xcd_barrier_post(unsigned* bar, volatile LAS unsigned* st) {
    XcdBarrier b; b.bar = bar; b.x = xb_xcc_id(); b.st = st;
    if (threadIdx.x == 0) (void)xb_add(&bar[XB_XCNT(b.x)], 1u);
    return b;
}
__device__ __forceinline__ void xcd_barrier_complete(unsigned* bar, unsigned x, unsigned& nloc, unsigned& nx) {
    const unsigned G = gridDim.x * gridDim.y * gridDim.z;
    unsigned sum, cnt, mine, sp = 0u;
    for (;;) {
        sum = 0u; cnt = 0u; mine = 0u;
#pragma unroll
        for (unsigned j = 0; j < 16; ++j) { const unsigned c = xb_ld(&bar[XB_XCNT(j)]); sum += c; cnt += (c > 0u) ? 1u : 0u; mine = (j == x) ? c : mine; }
        if (sum == G) break;
        __builtin_amdgcn_s_sleep(1);
        if ((++sp & 255u) == 0u) { if (xb_ld(&bar[XB_TMO])) break; if (sp > XB_SPIN_CAP) { atomicAdd(&bar[XB_TMO], 1u); break; } }
    }
    nloc = mine > 0u ? mine : 1u; nx = cnt > 0u ? cnt : 1u;
}

__device__ __forceinline__ void xcd_barrier(const XcdBarrier& b) {
    asm volatile("s_waitcnt vmcnt(0)" ::: "memory");
    __syncthreads();
    if (threadIdx.x == 0) {
        unsigned* bar = b.bar;
        __builtin_amdgcn_s_waitcnt(0);
        unsigned nloc = b.st[0], nx = b.st[1];
        if (nloc == 0u) { xcd_barrier_complete(bar, b.x, nloc, nx); b.st[0] = nloc; b.st[1] = nx; }
        const unsigned old = xb_add(&bar[XB_XSUB(b.x)], 1u);
        const unsigned gen = old / nloc;
        if (old + 1u == (gen + 1u) * nloc) {
            __builtin_amdgcn_fence(__ATOMIC_RELEASE, "agent");
            asm volatile("s_waitcnt vmcnt(0)" ::: "memory");
            const unsigned og = xb_add(&bar[XB_TOP], 1u);
            const unsigned tg = og / nx;
            if (og + 1u == (tg + 1u) * nx) xb_add(&bar[XB_TOPGEN], 1u);
            else XB_SPIN(xb_ld(&bar[XB_TOPGEN]) == tg, bar);
            __builtin_amdgcn_fence(__ATOMIC_ACQUIRE, "agent");
            xb_add(&bar[XB_XGEN(b.x)], 1u);
            asm volatile("s_waitcnt vmcnt(0)" ::: "memory");
        } else {
            XB_SPIN(xb_ld(&bar[XB_XGEN(b.x)]) == gen, bar);
            __builtin_amdgcn_fence(__ATOMIC_ACQUIRE, "agent");
            asm volatile("s_waitcnt vmcnt(0)" ::: "memory");
        }
    }
    __syncthreads();
}


constexpr int RSTD_OFF = 131072 + 1024;
DI void rstd_prepass(LAS unsigned char* lds, const pg8::StaticOrder& S, const float* ssq, int tid) {
    LAS float* tab = (LAS float*)(lds + RSTD_OFF);
    pg8::Unit u;
#pragma unroll 1
    for (int i = 0; i < 4 && S.next(i, u); ++i) {
        const int r = tid >> 1, hf = tid & 1;
        const f32x4* sp = (const f32x4*)(ssq + (size_t)(u.pm * 256 + r) * 16 + hf * 8);
        const f32x4 a = sp[0], b = sp[1];
        float t = ((a[0] + a[1]) + (a[2] + a[3])) + ((b[0] + b[1]) + (b[2] + b[3]));
        t += __shfl_xor(t, 1);
        if (hf == 0) tab[i * 256 + r] = 1.0f / sqrtf(t * (1.0f / 1024.0f) + EPS);
    }
    __syncthreads();
}
struct Params {
    const float* x; const int* pos; const float* norm_mix; const float* norm_mlp; const float* norm_final;
    const float* w_in_ab; const float* b_forget; const float* rel_bias; const float* w_out_ab;
    const float* w_in_cd; const float* q_norm; const float* kv_norm; const float* w_uq; const float* w_ukv; const float* w_out_cd;
    const float* w_up; const float* w_down;
    float* out; unsigned char* ws; int ph_lo, ph_hi, coop, pad;
};
constexpr int N_PHASES = 17;

__global__ void __launch_bounds__(NTHREADS) fwd_kernel(Params P) {
    extern __shared__ __attribute__((aligned(16))) unsigned char lds_raw[];
    LAS unsigned char* lds = (LAS unsigned char*)lds_raw;
    const int tid = threadIdx.x, lane = tid & 63, wave = __builtin_amdgcn_readfirstlane(tid >> 6);
    const int G = gridDim.x, bx = blockIdx.x;
    const int vcu = (G % 8 == 0) ? (bx % 8) * (G / 8) + bx / 8 : bx;
    const int gw = vcu * NWAVES + wave, ngw = G * NWAVES;
    unsigned char* ws = P.ws;
    bf16_t* WinAB = (bf16_t*)(ws + WS_WINAB); bf16_t* WoutAB = (bf16_t*)(ws + WS_WOUTAB); bf16_t* WinCD = (bf16_t*)(ws + WS_WINCD);
    bf16_t* Wuq = (bf16_t*)(ws + WS_WUQ); bf16_t* Wukv = (bf16_t*)(ws + WS_WUKV); bf16_t* WoutCD = (bf16_t*)(ws + WS_WOUTCD);
    bf16_t* Wup0 = (bf16_t*)(ws + WS_WUP0); bf16_t* Wup1 = (bf16_t*)(ws + WS_WUP1); bf16_t* Wdn0 = (bf16_t*)(ws + WS_WDN0); bf16_t* Wdn1 = (bf16_t*)(ws + WS_WDN1);
    float* LOGF = (float*)(ws + WS_LOGF); float* CUM = (float*)(ws + WS_CUM); float* TAB = (float*)(ws + WS_TAB); bf16_t* KR = (bf16_t*)(ws + WS_KR); float* SSQ = (float*)(ws + WS_SSQ); unsigned* KN2 = (unsigned*)(ws + WS_CTL + CTL_KN2);
    bf16_t* XN = (bf16_t*)(ws + WS_XN); bf16_t* CQN = (bf16_t*)(ws + WS_CQN); bf16_t* CKVN = (bf16_t*)(ws + WS_CKVN); bf16_t* OB = (bf16_t*)(ws + WS_O);
    bf16_t* BIG = (bf16_t*)(ws + WS_BIG); bf16_t* QF = (bf16_t*)(ws + WS_QF); bf16_t* KVF = (bf16_t*)(ws + WS_KVF);
    cg::grid_group grid = cg::this_grid();
    volatile LAS unsigned* MISC = (volatile LAS unsigned*)(lds + MISC_OFF);
    if (tid < 32) MISC[tid] = 0u;
    __syncthreads();
    XcdBarrier bar; bar.bar = (unsigned*)(ws + WS_CTL); bar.x = 0; bar.st = nullptr;
    if (P.coop) bar = xcd_barrier_post((unsigned*)(ws + WS_CTL), MISC + 8);
    const int lo = P.ph_lo, hi = P.ph_hi;
#ifndef PHMASK
#define PHMASK 0x1ffff
#endif
#define IN(k) (((PHMASK >> (k)) & 1) && lo <= (k) && (k) < hi)
#ifndef REPMASK
#define REPMASK 0
#endif
#define REP(k) ((REPMASK >> (k)) & 1)
#ifndef REPKMASK
#define REPKMASK 0
#endif
#define REPK(k) ((REPKMASK >> (k)) & 1)
#define SEAM(k) do { if (P.coop && (k) + 1 < hi) { if (P.coop == 2) grid.sync(); else xcd_barrier(bar); } } while (0)

    if (IN(0)) {
        LAS float* scr = (LAS float*)(lds + wave * 8704);
        for (int it = gw; ; it += ngw) {
            int r = it; bool hit = false;
#define TR(W, K, LDN, C0, NC, WT, R0, GN) if (!hit) { const int n_it = ((K) / 64) * ((NC) / 32); if (r < n_it) { transpose_item((W), (K), (LDN), (C0), (WT), (R0), (NC) / 32, scr, r, lane, (GN)); hit = true; } else r -= n_it; }
            TR(P.w_in_ab, 1024, NSRC_AB, 0, 1536, WinAB, 0, nullptr)
            TR(P.w_in_ab, 1024, NSRC_AB, 1544, 1536, WinAB, 1536, nullptr)
            TR(P.w_out_ab, 1024, 1024, 0, 1024, WoutAB, 0, nullptr)
            TR(P.w_in_cd, 1024, NSRC_CD, 0, NSRC_CD, WinCD, 0, P.norm_mix + DM)
            TR(P.w_up, 1024, 4096, 0, 4096, Wup0, 0, P.norm_mlp)
            TR(P.w_down, 4096, 1024, 0, 1024, Wdn0, 0, nullptr)
#undef TR
            if (!hit) break;
        }
        for (int i = (vcu * NTHREADS + tid); i < 96 * 1024 / 8; i += G * NTHREADS) ((u32x4*)(WinCD + (size_t)2208 * 1024))[i] = (u32x4){0u, 0u, 0u, 0u};
        __syncthreads();
        LAS float* wfaT = (LAS float*)lds;
        for (int i = tid; i < 8192; i += NTHREADS) { const int k = i >> 3, j = i & 7; wfaT[j * 1024 + k] = P.w_in_ab[(size_t)k * NSRC_AB + 1536 + j]; }
        __syncthreads();
        norm_rows_bf16<true>(P.x, P.norm_mix, XN, gw, ngw, lane, wfaT, P.b_forget, LOGF, P.pos, TAB);
        __syncthreads();
        SEAM(0);
    }
    if (IN(1)) {
        if (vcu < 32) {
            const int b = vcu >> 3, h = vcu & 7; LAS float* sc = (LAS float*)lds;
            float v[8]; float run = 0.f;
#pragma unroll
            for (int e = 0; e < 8; ++e) { run += LOGF[((size_t)b * SEQ + tid * 8 + e) * 8 + h]; v[e] = run; }
            sc[tid] = run; __syncthreads();
            for (int off = 1; off < NTHREADS; off <<= 1) { const float add = (tid >= off) ? sc[tid - off] : 0.f; __syncthreads(); sc[tid] += add; __syncthreads(); }
            const float base = sc[tid] - run;
#pragma unroll
            for (int e = 0; e < 8; ++e) CUM[(size_t)(b * 8 + h) * SEQ + tid * 8 + e] = base + v[e];
            __syncthreads();
        }
        pg8::Gemm g{XN, WinAB, MT, LD_AB, DM}; pg8::StaticOrder S; S.init(MT, LD_AB, G, bx);
        pg8::EpiStoreAB E{BIG, LD_AB, KN2};
        pg8::gemm_phase<pg8::EpiStoreAB, pg8::StaticOrder, true, true>(lds, g, S, E);
        SEAM(1);
    }
    if (IN(2)) {
        const int bh = vcu >> 3, s = vcu & 7, b = bh >> 3, h = bh & 7;
        for (int rep = 0; rep <= REPK(2); ++rep) {
            att::fox_unit(lds, BIG, CUM, KN2, OB, b, h, 15 - s);
            att::fox_unit(lds, BIG, CUM, KN2, OB, b, h, s);
            att::chk_unit(lds, BIG, P.rel_bias, OB, b, h, 2 * s);
            att::chk_unit(lds, BIG, P.rel_bias, OB, b, h, 2 * s + 1);
        }
        SEAM(2);
    }
    if (IN(3)) {
        pg8::Gemm g{OB, WoutAB, MT, DM, DM}; pg8::StaticOrder S; S.init(MT, DM, G, bx);
        pg8::EpiResidN E{P.x, P.out, XN, SSQ, DM};
        pg8::gemm_phase<pg8::EpiResidN, pg8::StaticOrder, true, true>(lds, g, S, E);
        SEAM(3);
    }
    if (IN(5)) {
        pg8::Gemm g{XN, Wup0, MT, DFF, DM}; pg8::StaticOrder S; S.init(MT, DFF, G, bx);
        rstd_prepass(lds, S, SSQ, tid);
        pg8::EpiStore<1, 1> E{BIG, DFF, (const LAS float*)(lds + RSTD_OFF), 0};
        pg8::gemm_phase<pg8::EpiStore<1, 1>, pg8::StaticOrder, true, true>(lds, g, S, E);
        SEAM(5);
    }
    if (IN(6)) {
        pg8::Gemm g{BIG, Wdn0, MT, DM, DFF}; pg8::StaticOrder S; S.init(MT, DM, G, bx);
        pg8::EpiResidN E{P.out, P.out, XN, SSQ, DM};
        pg8::gemm_phase<pg8::EpiResidN, pg8::StaticOrder, true, true>(lds, g, S, E);
        SEAM(6);
    }
    if (IN(8)) {
        pg8::Gemm g{XN, WinCD, MT, LD_CD, DM}; pg8::StaticOrder S; S.init(MT, LD_CD, G, bx);
        rstd_prepass(lds, S, SSQ, tid);
        pg8::EpiStore<0, 1> E{BIG, LD_CD, (const LAS float*)(lds + RSTD_OFF), 0};
        pg8::gemm_phase<pg8::EpiStore<0, 1>, pg8::StaticOrder, true, true>(lds, g, S, E);
        if (G == 256 ? bx >= 64 : true) {
            const int nidle = (G == 256) ? 192 : G, iw = ((G == 256) ? bx - 64 : bx) * NWAVES + wave;
            LAS float* scr = (LAS float*)(lds + wave * 8704);
            for (int it = iw; ; it += nidle * NWAVES) {
                int r = it; bool hit = false;
#define TR(W, K, LDN, C0, NC, WT, R0, GN) if (!hit) { const int n_it = ((K) / 64) * ((NC) / 32); if (r < n_it) { transpose_item((W), (K), (LDN), (C0), (WT), (R0), (NC) / 32, scr, r, lane, (GN)); hit = true; } else r -= n_it; }
                TR(P.w_uq, 384, 768, 0, 768, Wuq, 0, nullptr)
                TR(P.w_ukv, 256, 1024, 0, 1024, Wukv, 0, nullptr)
                TR(P.w_out_cd, 1024, 1024, 0, 1024, WoutCD, 0, nullptr)
                TR(P.w_up + (size_t)1024 * 4096, 1024, 4096, 0, 4096, Wup1, 0, P.norm_mlp + DM)
                TR(P.w_down + (size_t)4096 * 1024, 4096, 1024, 0, 1024, Wdn1, 0, nullptr)
#undef TR
                if (!hit) break;
            }
        }
        SEAM(8);
    }
    if (IN(9)) { mla_prep_rows(BIG, P.pos, P.q_norm, P.kv_norm, CQN, CKVN, TAB, KR, gw, ngw, lane); SEAM(9); }
    if (IN(10)) {
#ifndef P10SEL
#define P10SEL 3
#endif
        if (P10SEL & 1) { pg8::Gemm g{CQN, Wuq, MT, 768, 384 + P.pad};     pg8::StaticOrder S; S.init(MT, 768, G, bx);
          pg8::EpiQRope E{QF, 768, TAB};
          pg8::gemm_phase<pg8::EpiQRope, pg8::StaticOrder, true, true>(lds, g, S, E); }
        if (P10SEL & 2) { pg8::Gemm g{CKVN, Wukv, MT, 1024, 256 + P.pad}; pg8::StaticOrder S; S.init(MT, 1024, G, bx);
          pg8::EpiStore<0> E{KVF, 1024, nullptr, 0};
          pg8::gemm_phase<pg8::EpiStore<0>, pg8::StaticOrder, true, true>(lds, g, S, E); }
        SEAM(10);
    }
    if (IN(11)) {
        const int bh = vcu >> 3, s = vcu & 7, b = bh >> 3, h = bh & 7;
        for (int rep = 0; rep <= REPK(11); ++rep) {
            att::mla_unit(lds, QF, KVF, KR, OB, b, h, 15 - s);
            att::mla_unit(lds, QF, KVF, KR, OB, b, h, s);
            att::sb_unit(lds, BIG, OB, b, h, 15 - s);
            att::sb_unit(lds, BIG, OB, b, h, s);
        }
        SEAM(11);
    }
    if (IN(12)) {
        pg8::Gemm g{OB, WoutCD, MT, DM, DM}; pg8::StaticOrder S; S.init(MT, DM, G, bx);
        pg8::EpiResidN E{P.out, P.out, XN, SSQ, DM};
        pg8::gemm_phase<pg8::EpiResidN, pg8::StaticOrder, true, true>(lds, g, S, E);
        SEAM(12);
    }
    if (IN(14)) {
        pg8::Gemm g{XN, Wup1, MT, DFF, DM}; pg8::StaticOrder S; S.init(MT, DFF, G, bx);
        rstd_prepass(lds, S, SSQ, tid);
        pg8::EpiStore<1, 1> E{BIG, DFF, (const LAS float*)(lds + RSTD_OFF), 0};
        pg8::gemm_phase<pg8::EpiStore<1, 1>, pg8::StaticOrder, true, true>(lds, g, S, E);
        SEAM(14);
    }
    if (IN(15)) {
        pg8::Gemm g{BIG, Wdn1, MT, DM, DFF}; pg8::StaticOrder S; S.init(MT, DM, G, bx);
        pg8::EpiResid E{P.out, P.out, DM};
        pg8::gemm_phase<pg8::EpiResid, pg8::StaticOrder, true, true>(lds, g, S, E);
        SEAM(15);
    }
    if (IN(16)) { norm_rows_f32(P.out, P.norm_final, gw, ngw, lane); }
#undef IN
#undef SEAM
}

#ifndef MK_MULTI_LAUNCH
#define MK_MULTI_LAUNCH 0
#endif
extern "C" void kernel_launch(void* const* d_in, const int* in_sizes, int n_in, void* d_out, int out_size, void* d_ws, size_t ws_size, hipStream_t stream) {
    static int grid = 0;
    if (grid == 0) {
        if (n_in != 17 || out_size != MT * DM || ws_size < WS_END) { fprintf(stderr, "kernel_launch: unexpected problem (n_in %d out %d ws %zu)\n", n_in, out_size, ws_size); grid = -1; return; }
        int dev = 0, cus = 0, per_cu = 0;
        hipGetDevice(&dev); hipDeviceGetAttribute(&cus, hipDeviceAttributeMultiprocessorCount, dev);
        if (hipFuncSetAttribute((const void*)fwd_kernel, hipFuncAttributeMaxDynamicSharedMemorySize, LDS_BYTES) != hipSuccess) { fprintf(stderr, "kernel_launch: hipFuncSetAttribute failed\n"); grid = -1; return; }
        if (hipOccupancyMaxActiveBlocksPerMultiprocessor(&per_cu, (const void*)fwd_kernel, NTHREADS, LDS_BYTES) != hipSuccess || per_cu < 1) { fprintf(stderr, "kernel_launch: occupancy query says %d\n", per_cu); per_cu = 1; }
        (void)hipGetLastError();
        grid = cus;
        if (grid != 256) fprintf(stderr, "kernel_launch: note: %d CUs\n", grid);
    }
    if (grid < 0) return;
    Params p{};
    p.x = (const float*)d_in[0]; p.pos = (const int*)d_in[1]; p.norm_mix = (const float*)d_in[2]; p.norm_mlp = (const float*)d_in[3]; p.norm_final = (const float*)d_in[4];
    p.w_in_ab = (const float*)d_in[5]; p.b_forget = (const float*)d_in[6]; p.rel_bias = (const float*)d_in[7]; p.w_out_ab = (const float*)d_in[8];
    p.w_in_cd = (const float*)d_in[9]; p.q_norm = (const float*)d_in[10]; p.kv_norm = (const float*)d_in[11]; p.w_uq = (const float*)d_in[12]; p.w_ukv = (const float*)d_in[13]; p.w_out_cd = (const float*)d_in[14];
    p.w_up = (const float*)d_in[15]; p.w_down = (const float*)d_in[16];
    p.out = (float*)d_out; p.ws = (unsigned char*)d_ws;
    if (hipMemsetAsync((char*)d_ws + WS_CTL, 0, CTL_BYTES, stream) != hipSuccess) { fprintf(stderr, "kernel_launch: hipMemsetAsync failed\n"); return; }
#if MK_MULTI_LAUNCH
    for (int ph = 0; ph < N_PHASES; ++ph) {
        p.ph_lo = ph; p.ph_hi = ph + 1; p.coop = 0;
        hipLaunchKernelGGL(fwd_kernel, dim3(grid), dim3(NTHREADS), LDS_BYTES, stream, p);
        if (REP(ph)) hipLaunchKernelGGL(fwd_kernel, dim3(grid), dim3(NTHREADS), LDS_BYTES, stream, p);
    }
#else
    p.ph_lo = 0; p.ph_hi = N_PHASES; p.coop = 1;
    void* args[] = {&p};
    hipError_t e = hipLaunchCooperativeKernel((const void*)fwd_kernel, dim3(grid), dim3(NTHREADS), args, LDS_BYTES, stream);
    if (e != hipSuccess) fprintf(stderr, "cooperative launch failed: %s (grid %d)\n", hipGetErrorString(e), grid);
#endif
}
```

```cpp
#include <hip/hip_runtime.h>
#include <hip/hip_cooperative_groups.h>
#include <cstdio>
#include <cstdint>
#include <cmath>
namespace cg = cooperative_groups;
namespace pg8 {
#define PG8_LAS __attribute__((address_space(3)))
typedef unsigned short bf16_t;
typedef short bf16x8 __attribute__((ext_vector_type(8)));
typedef float f32x4 __attribute__((ext_vector_type(4)));
typedef unsigned u32x4 __attribute__((ext_vector_type(4)));
constexpr int BM = 256, BK = 64, HALF = 128, HTB = HALF * BK * 2  , STAGE_BYTES = 8 * HTB, NXCD = 8, WGM = 8;

__host__ __device__ __forceinline__ int lds_byte(int r, int c) { const int st = (r >> 4) * 2 + (c >> 5), rr = r & 15, cc = c & 31, ob = rr * 64 + cc * 2; return st * 1024 + (ob ^ (((ob >> 9) & 1) << 5)); }
__host__ __device__ __forceinline__ void stage_rc(int b, int& R, int& C) { const int st = b / 1024, sb = b % 1024, swz = sb ^ (((sb >> 9) & 1) << 5); R = (st >> 1) * 16 + swz / 64; C = (st & 1) * 32 + (swz % 64) / 2; }
__host__ __device__ __forceinline__ int perm32(int rho) { const int n = rho >> 4, i = rho & 15; return 8 * (i >> 2) + 4 * n + (i & 3); }

struct Unit { int pm, pn; };
struct Gemm { const bf16_t* A; const bf16_t* Bt; int M, N, K; int lda; };

struct StaticOrder {
    int nM, nN, nwg, G, c;
    __host__ __device__ void init(int M, int N, int G_, int c_) { nM = M / BM; nN = N / BM; nwg = nM * nN; G = G_; c = c_; }
    __host__ __device__ bool next(int i, Unit& u) const {
        const long L = (long)i * G + c; if (L >= nwg) return false;
        int wgid = (int)L; { const int q = nwg / NXCD, r = nwg % NXCD, xcd = wgid % NXCD, off = wgid / NXCD; wgid = (xcd < r ? xcd * (q + 1) : r * (q + 1) + (xcd - r) * q) + off; }
        const int nig = WGM * nN, gid = wgid / nig, fm = gid * WGM, gsz = (nM - fm) < WGM ? (nM - fm) : WGM;
        u.pm = fm + ((wgid % nig) % gsz); u.pn = (wgid % nig) / gsz; return true;
    }
    __device__ __forceinline__ void a_ready(const Unit&) const {}
    __device__ __forceinline__ void done(const Unit&) const {}
};

__device__ __forceinline__ unsigned cvt_pk_bf16(float lo, float hi) { unsigned r; asm volatile("v_cvt_pk_bf16_f32 %0, %1, %2" : "=v"(r) : "v"(lo), "v"(hi)); return r; }
template <class Epi, class Sched, bool ALIGN_EPI = false, bool SP2 = false>
__device__ __forceinline__ void gemm_phase(PG8_LAS unsigned char* lds, const Gemm g, const Sched& S, const Epi& E) {
    const int tid = threadIdx.x, wid = __builtin_amdgcn_readfirstlane(tid >> 6), lane = tid & 63, wr = wid >> 2, wc = wid & 3, fr = lane & 15, fq = lane >> 4;
    const int K = g.K, nt = K / BK, LDA = g.lda ? g.lda : g.K;
    unsigned voffA[2], voffB[2];
#pragma unroll
    for (int i = 0; i < 2; ++i) { int R, C; stage_rc(tid * 16 + i * 8192, R, C); const int Rb = Epi::PERM ? ((R & ~31) + perm32(R & 31)) : R;
        voffA[i] = (unsigned)(R * LDA + C) * 2u; voffB[i] = (unsigned)(Rb * K + C) * 2u; }
    const size_t kstep = (size_t)(BK * 2);
    const size_t hstepB = (size_t)HALF * K * 2, hstepA = (size_t)HALF * LDA * 2;
    const size_t tstepB = 2 * hstepB, tstepA = 2 * hstepA;
    const unsigned ldsw = (unsigned)wid * 1024u;
    const int aoff = lds_byte(wr * 64 + fr, fq * 8), boff = lds_byte(wc * 32 + fr, fq * 8);
#define PG8_SA(b, h) (((b) * 2 + (h)) * HTB)
#define PG8_SB(b, h) ((4 + (b) * 2 + (h)) * HTB)
#define PG8_STAGE(bufoff, gbase, voff) do { _Pragma("unroll") for (int _i = 0; _i < 2; ++_i) \
        __builtin_amdgcn_global_load_lds((const unsigned*)((const char*)(gbase) + (voff)[_i]), (PG8_LAS unsigned*)(lds + (bufoff) + ldsw + _i * 8192), 16, 0, 0); } while (0)
#define PG8_LDA(dst, b, h) do { _Pragma("unroll") for (int m = 0; m < 4; ++m) _Pragma("unroll") for (int k = 0; k < 2; ++k) dst[m][k] = *(const PG8_LAS bf16x8*)(lds + PG8_SA(b, h) + aoff + m * 2048 + k * 1024); } while (0)
#define PG8_LDB(dst, b, h) do { _Pragma("unroll") for (int n = 0; n < 2; ++n) _Pragma("unroll") for (int k = 0; k < 2; ++k) dst[n][k] = *(const PG8_LAS bf16x8*)(lds + PG8_SB(b, h) + boff + n * 2048 + k * 1024); } while (0)
#define PG8_MMA(ai, bj, At, Bt) do { __builtin_amdgcn_s_setprio(1); _Pragma("unroll") for (int m = 0; m < 4; ++m) _Pragma("unroll") for (int n = 0; n < 2; ++n) _Pragma("unroll") for (int k = 0; k < 2; ++k) \
        acc[ai][bj][m][n] = __builtin_amdgcn_mfma_f32_16x16x32_bf16(Bt[n][k], At[m][k], acc[ai][bj][m][n], 0, 0, 0); __builtin_amdgcn_s_setprio(0); } while (0)
#define PG8_WAIT_V(n) asm volatile("s_waitcnt vmcnt(" #n ")" ::: "memory")
#define PG8_WAIT_L(n) asm volatile("s_waitcnt lgkmcnt(" #n ")" ::: "memory")
#define PG8_BAR __builtin_amdgcn_s_barrier()
#define PG8_SCHED __builtin_amdgcn_sched_barrier(0)
    Unit cur, nxt; int ui = 0;
    if (!S.next(0, cur)) return;
    f32x4 acc[2][2][4][2];
#pragma unroll
    for (int a = 0; a < 2; ++a)
#pragma unroll
        for (int b = 0; b < 2; ++b)
#pragma unroll
            for (int m = 0; m < 4; ++m)
#pragma unroll
                for (int n = 0; n < 2; ++n) acc[a][b][m][n] = (f32x4){0.f, 0.f, 0.f, 0.f};
    bf16x8 At[4][2], B0[2][2], B1[2][2];
    const char* cA = (const char*)g.A + (size_t)cur.pm * tstepA; const char* cB = (const char*)g.Bt + (size_t)cur.pn * tstepB;
    S.a_ready(cur);
    if constexpr (SP2) {
        PG8_STAGE(PG8_SB(0, 0), cB, voffB); PG8_STAGE(PG8_SB(0, 1), cB + hstepB, voffB); PG8_STAGE(PG8_SA(0, 0), cA, voffA); PG8_STAGE(PG8_SA(0, 1), cA + hstepA, voffA);
        if (wr == 1) PG8_BAR;
        PG8_WAIT_V(2); PG8_BAR;
        PG8_STAGE(PG8_SB(1, 0), cB + kstep, voffB); PG8_STAGE(PG8_SA(1, 0), cA + kstep, voffA); PG8_STAGE(PG8_SB(1, 1), cB + hstepB + kstep, voffB);
        PG8_WAIT_V(6); PG8_BAR;
    } else {
        PG8_STAGE(PG8_SB(0, 0), cB, voffB); PG8_STAGE(PG8_SA(0, 0), cA, voffA); PG8_STAGE(PG8_SB(0, 1), cB + hstepB, voffB); PG8_STAGE(PG8_SA(0, 1), cA + hstepA, voffA);
        if (wr == 1) PG8_BAR;
        PG8_WAIT_V(4); PG8_BAR;
        PG8_STAGE(PG8_SB(1, 0), cB + kstep, voffB); PG8_STAGE(PG8_SA(1, 0), cA + kstep, voffA); PG8_STAGE(PG8_SB(1, 1), cB + hstepB + kstep, voffB);
        PG8_WAIT_V(6); PG8_BAR;
    }
    for (;;) {
        const bool has_next = S.next(ui + 1, nxt);
        const char* nA = has_next ? (const char*)g.A + (size_t)nxt.pm * tstepA : cA; const char* nB = has_next ? (const char*)g.Bt + (size_t)nxt.pn * tstepB : cB;
        for (int t = 0; t < nt; t += 2) {
            const bool last = (t == nt - 2);
            const char* a1 = cA + (size_t)(t + 1) * kstep;
            const char* a2 = last ? nA : cA + (size_t)(t + 2) * kstep; const char* b2 = last ? nB : cB + (size_t)(t + 2) * kstep;
            const char* a3 = a2 + kstep; const char* b3 = b2 + kstep;
            if (last && has_next) S.a_ready(nxt);
            if constexpr (SP2) {
            PG8_LDB(B0, 0, 0); PG8_LDB(B1, 0, 1); PG8_SCHED; PG8_LDA(At, 0, 0); PG8_STAGE(PG8_SA(1, 1), a1 + hstepA, voffA);
            PG8_WAIT_V(8); PG8_WAIT_L(0); PG8_BAR; PG8_MMA(0, 0, At, B0); PG8_MMA(0, 1, At, B1); PG8_BAR; PG8_SCHED;
            PG8_LDA(At, 0, 1); PG8_STAGE(PG8_SB(0, 0), b2, voffB); PG8_STAGE(PG8_SB(0, 1), b2 + hstepB, voffB); PG8_STAGE(PG8_SA(0, 0), a2, voffA);
            PG8_WAIT_V(8); PG8_WAIT_L(0); PG8_BAR; PG8_MMA(1, 0, At, B0); PG8_MMA(1, 1, At, B1); PG8_BAR; PG8_SCHED;
            PG8_LDB(B0, 1, 0); PG8_LDB(B1, 1, 1); PG8_SCHED; PG8_LDA(At, 1, 0); PG8_STAGE(PG8_SA(0, 1), a2 + hstepA, voffA);
            PG8_WAIT_V(8); PG8_WAIT_L(0); PG8_BAR; PG8_MMA(0, 0, At, B0); PG8_MMA(0, 1, At, B1); PG8_BAR; PG8_SCHED;
            PG8_LDA(At, 1, 1); PG8_STAGE(PG8_SB(1, 0), b3, voffB); PG8_STAGE(PG8_SB(1, 1), b3 + hstepB, voffB); PG8_STAGE(PG8_SA(1, 0), a3, voffA);
            PG8_WAIT_V(8); PG8_WAIT_L(0); PG8_BAR; PG8_MMA(1, 0, At, B0); PG8_MMA(1, 1, At, B1); PG8_BAR; PG8_SCHED;
            } else {
            PG8_LDB(B0, 0, 0); PG8_SCHED; PG8_LDA(At, 0, 0); PG8_STAGE(PG8_SA(1, 1), a1 + hstepA, voffA);
            PG8_WAIT_L(8); PG8_BAR; PG8_WAIT_L(0); PG8_MMA(0, 0, At, B0); PG8_BAR; PG8_SCHED;
            PG8_LDB(B1, 0, 1); PG8_STAGE(PG8_SB(0, 0), b2, voffB);
            PG8_BAR; PG8_WAIT_L(0); PG8_MMA(0, 1, At, B1); PG8_BAR;
            PG8_LDA(At, 0, 1); PG8_STAGE(PG8_SA(0, 0), a2, voffA);
            PG8_BAR; PG8_WAIT_L(0); PG8_MMA(1, 0, At, B0); PG8_BAR; PG8_SCHED;
            PG8_STAGE(PG8_SB(0, 1), b2 + hstepB, voffB);
            PG8_WAIT_V(6); PG8_BAR; PG8_MMA(1, 1, At, B1); PG8_BAR;
            PG8_LDB(B0, 1, 0); PG8_SCHED; PG8_LDA(At, 1, 0); PG8_STAGE(PG8_SA(0, 1), a2 + hstepA, voffA);
            PG8_WAIT_L(8); PG8_BAR; PG8_WAIT_L(0); PG8_MMA(0, 0, At, B0); PG8_BAR; PG8_SCHED;
            PG8_LDB(B1, 1, 1); PG8_STAGE(PG8_SB(1, 0), b3, voffB);
            PG8_BAR; PG8_WAIT_L(0); PG8_MMA(0, 1, At, B1); PG8_BAR;
            PG8_LDA(At, 1, 1); PG8_STAGE(PG8_SA(1, 0), a3, voffA);
            PG8_BAR; PG8_WAIT_L(0); PG8_MMA(1, 0, At, B0); PG8_BAR; PG8_SCHED;
            PG8_STAGE(PG8_SB(1, 1), b3 + hstepB, voffB);
            PG8_WAIT_V(6); PG8_BAR; PG8_MMA(1, 1, At, B1); PG8_BAR;
            }
        }
        if constexpr (ALIGN_EPI) { if (wr == 0) PG8_BAR; }
        if constexpr (!Epi::AFTER_DRAIN) { E(acc, cur, wr, wc, fr, fq); S.done(cur); }
        if (!has_next) break;
#pragma unroll
        for (int a = 0; a < 2; ++a)
#pragma unroll
            for (int b = 0; b < 2; ++b)
#pragma unroll
                for (int m = 0; m < 4; ++m)
#pragma unroll
                    for (int n = 0; n < 2; ++n) acc[a][b][m][n] = (f32x4){0.f, 0.f, 0.f, 0.f};
        cur = nxt; cA = nA; cB = nB; ++ui;
        if constexpr (ALIGN_EPI) { if (wr == 1) PG8_BAR; }
    }
    PG8_WAIT_V(0);
    if constexpr (!ALIGN_EPI) { if (wr == 0) PG8_BAR; }
    PG8_BAR;
    if constexpr (Epi::AFTER_DRAIN) { E.fused(acc, cur, wr, wc, fr, fq, lds, wid, lane); S.done(cur); }
#undef PG8_SA
#undef PG8_SB
#undef PG8_STAGE
#undef PG8_LDA
#undef PG8_LDB
#undef PG8_MMA
#undef PG8_WAIT_V
#undef PG8_WAIT_L
#undef PG8_BAR
#undef PG8_SCHED
}
}

namespace pg8 {
template <int RELU2, int SCALE = 0> struct EpiStore {
    static constexpr bool PERM = true, AFTER_DRAIN = false;
    bf16_t* O; int ldc; const PG8_LAS float* rstd; mutable int cnt;
    __device__ __forceinline__ void operator()(const f32x4 (&acc)[2][2][4][2], const Unit& u, int wr, int wc, int fr, int fq) const {
        const int row0 = u.pm * BM + wr * 64 + fr, col0 = u.pn * BM + wc * 32 + 8 * fq;
#pragma unroll
        for (int ai = 0; ai < 2; ++ai)
#pragma unroll
            for (int m = 0; m < 4; ++m) { const int row = row0 + ai * HALF + m * 16; bf16_t* rowp = O + (size_t)row * ldc + col0;
                float rs = 1.f;
                if (SCALE) rs = rstd[cnt * 256 + wr * 64 + fr + ai * HALF + m * 16];
#pragma unroll
                for (int bj = 0; bj < 2; ++bj) { f32x4 v0 = acc[ai][bj][m][0] * rs, v1 = acc[ai][bj][m][1] * rs;
                    if (RELU2) {
#pragma unroll
                        for (int e = 0; e < 4; ++e) { const float a = fmaxf(v0[e], 0.f), b = fmaxf(v1[e], 0.f); v0[e] = a * a; v1[e] = b * b; } }
                    u32x4 w; w.x = cvt_pk_bf16(v0[0], v0[1]); w.y = cvt_pk_bf16(v0[2], v0[3]); w.z = cvt_pk_bf16(v1[0], v1[1]); w.w = cvt_pk_bf16(v1[2], v1[3]);
                    *(u32x4*)(rowp + bj * HALF) = w; } }
        if (SCALE) ++cnt;
    }
};

struct EpiStoreAB {
    static constexpr bool PERM = true, AFTER_DRAIN = false;
    bf16_t* O; int ldc; unsigned* kn2;
    __device__ __forceinline__ void operator()(const f32x4 (&acc)[2][2][4][2], const Unit& u, int wr, int wc, int fr, int fq) const {
        const int row0 = u.pm * BM + wr * 64 + fr, col0 = u.pn * BM + wc * 32 + 8 * fq;
#pragma unroll
        for (int ai = 0; ai < 2; ++ai)
#pragma unroll
            for (int m = 0; m < 4; ++m) { bf16_t* rowp = O + (size_t)(row0 + ai * HALF + m * 16) * ldc + col0;
#pragma unroll
                for (int bj = 0; bj < 2; ++bj) { const f32x4 v0 = acc[ai][bj][m][0], v1 = acc[ai][bj][m][1];
                    u32x4 w; w.x = cvt_pk_bf16(v0[0], v0[1]); w.y = cvt_pk_bf16(v0[2], v0[3]); w.z = cvt_pk_bf16(v1[0], v1[1]); w.w = cvt_pk_bf16(v1[2], v1[3]);
                    *(u32x4*)(rowp + bj * HALF) = w; } }
        if (u.pn == 2 || u.pn == 3) {
#pragma unroll
            for (int bj = 0; bj < 2; ++bj) { float mx = 0.f;
#pragma unroll
                for (int ai = 0; ai < 2; ++ai)
#pragma unroll
                    for (int m = 0; m < 4; ++m) { const f32x4 v0 = acc[ai][bj][m][0], v1 = acc[ai][bj][m][1];
                        float s = ((v0[0] * v0[0] + v0[1] * v0[1]) + (v0[2] * v0[2] + v0[3] * v0[3])) + ((v1[0] * v1[0] + v1[1] * v1[1]) + (v1[2] * v1[2] + v1[3] * v1[3]));
                        s += __shfl_xor(s, 16); s += __shfl_xor(s, 32); mx = fmaxf(mx, s); }
                mx = fmaxf(mx, __shfl_xor(mx, 1)); mx = fmaxf(mx, __shfl_xor(mx, 2)); mx = fmaxf(mx, __shfl_xor(mx, 4)); mx = fmaxf(mx, __shfl_xor(mx, 8));
                const int colb = u.pn * BM + bj * HALF + wc * 32 - 512, head = colb >> 6, half = (colb >> 5) & 1, b = u.pm >> 4;
                if (fr == 0 && fq == 0) atomicMax(kn2 + ((b * 8 + head) * 2 + half), __float_as_uint(mx * 1.02f)); }
        }
    }
};

struct EpiStoreCD {
    static constexpr bool PERM = true, AFTER_DRAIN = false;
    bf16_t* O; int ldc; const PG8_LAS float* rstd; float* ssq2; bf16_t* kr; const float* tab; mutable int cnt;
    __device__ __forceinline__ void operator()(const f32x4 (&acc)[2][2][4][2], const Unit& u, int wr, int wc, int fr, int fq) const {
        const int row0 = u.pm * BM + wr * 64 + fr, col0 = u.pn * BM + wc * 32 + 8 * fq;
#pragma unroll
        for (int ai = 0; ai < 2; ++ai)
#pragma unroll
            for (int m = 0; m < 4; ++m) { const int row = row0 + ai * HALF + m * 16; bf16_t* rowp = O + (size_t)row * ldc + col0;
                const float rs = rstd[cnt * 256 + wr * 64 + fr + ai * HALF + m * 16];
#pragma unroll
                for (int bj = 0; bj < 2; ++bj) { const f32x4 v0 = acc[ai][bj][m][0] * rs, v1 = acc[ai][bj][m][1] * rs;
                    u32x4 w; w.x = cvt_pk_bf16(v0[0], v0[1]); w.y = cvt_pk_bf16(v0[2], v0[3]); w.z = cvt_pk_bf16(v1[0], v1[1]); w.w = cvt_pk_bf16(v1[2], v1[3]);
                    *(u32x4*)(rowp + bj * HALF) = w;
                    const int cgp = u.pn * BM + bj * HALF + wc * 32;
                    if (cgp >= 1536 && cgp < 2176) {
                        float s = ((v0[0] * v0[0] + v0[1] * v0[1]) + (v0[2] * v0[2] + v0[3] * v0[3])) + ((v1[0] * v1[0] + v1[1] * v1[1]) + (v1[2] * v1[2] + v1[3] * v1[3]));
                        s += __shfl_xor(s, 16); s += __shfl_xor(s, 32);
                        if (fq == 0) ssq2[(size_t)row * 32 + ((cgp - 1536) >> 5)] = s;
                    } else if (cgp == 2176) {
                        const int i0 = 8 * (fq & 1);
                        const f32x4 c0 = *(const f32x4*)(tab + (size_t)row * 32 + i0), c1 = *(const f32x4*)(tab + (size_t)row * 32 + i0 + 4);
                        const f32x4 s0 = *(const f32x4*)(tab + (size_t)row * 32 + 16 + i0), s1 = *(const f32x4*)(tab + (size_t)row * 32 + 16 + i0 + 4);
                        f32x4 p0, p1;
#pragma unroll
                        for (int e = 0; e < 4; ++e) { p0[e] = __shfl_xor(v0[e], 32); p1[e] = __shfl_xor(v1[e], 32); }
                        f32x4 o0, o1;
                        if (fq < 2) { o0 = v0 * c0 - p0 * s0; o1 = v1 * c1 - p1 * s1; }
                        else        { o0 = v0 * c0 + p0 * s0; o1 = v1 * c1 + p1 * s1; }
                        u32x4 k; k.x = cvt_pk_bf16(o0[0], o0[1]); k.y = cvt_pk_bf16(o0[2], o0[3]); k.z = cvt_pk_bf16(o1[0], o1[1]); k.w = cvt_pk_bf16(o1[2], o1[3]);
                        *(u32x4*)(kr + (size_t)row * 32 + 8 * fq) = k;
                    } } }
        ++cnt;
    }
};
struct EpiResid {
    static constexpr bool PERM = false, AFTER_DRAIN = false;
    const float* base; float* out; int ldc;
    __device__ __forceinline__ void operator()(const f32x4 (&acc)[2][2][4][2], const Unit& u, int wr, int wc, int fr, int fq) const {
        const int row0 = u.pm * BM + wr * 64 + fr, col0 = u.pn * BM + wc * 32 + 4 * fq;
#pragma unroll
        for (int ai = 0; ai < 2; ++ai)
#pragma unroll
            for (int m = 0; m < 4; ++m) { const size_t off = (size_t)(row0 + ai * HALF + m * 16) * ldc + col0;
#pragma unroll
                for (int bj = 0; bj < 2; ++bj)
#pragma unroll
                    for (int n = 0; n < 2; ++n) { const size_t o = off + bj * HALF + n * 16; const f32x4 bs = *(const f32x4*)(base + o); *(f32x4*)(out + o) = bs + acc[ai][bj][m][n]; } }
    }
};

struct EpiResidN {
    static constexpr bool PERM = false, AFTER_DRAIN = false;
    const float* base; float* out; bf16_t* xn; float* ssq; int ldc;
    __device__ __forceinline__ void operator()(const f32x4 (&acc)[2][2][4][2], const Unit& u, int wr, int wc, int fr, int fq) const {
        typedef unsigned u32x2 __attribute__((ext_vector_type(2)));
        const int row0 = u.pm * BM + wr * 64 + fr, col0 = u.pn * BM + wc * 32 + 4 * fq;
#pragma unroll
        for (int ai = 0; ai < 2; ++ai)
#pragma unroll
            for (int m = 0; m < 4; ++m) { const int row = row0 + ai * HALF + m * 16; const size_t off = (size_t)row * ldc + col0; float s = 0.f;
#pragma unroll
                for (int bj = 0; bj < 2; ++bj)
#pragma unroll
                    for (int n = 0; n < 2; ++n) { const size_t o = off + bj * HALF + n * 16; const f32x4 v = *(const f32x4*)(base + o) + acc[ai][bj][m][n]; *(f32x4*)(out + o) = v;
                        u32x2 w; w.x = cvt_pk_bf16(v[0], v[1]); w.y = cvt_pk_bf16(v[2], v[3]); *(u32x2*)(xn + o) = w;
                        s += (v[0] * v[0] + v[1] * v[1]) + (v[2] * v[2] + v[3] * v[3]); }
                s += __shfl_xor(s, 16); s += __shfl_xor(s, 32);
                if (fq == 0) ssq[(size_t)row * 16 + u.pn * 4 + wc] = s; }
    }
};
struct EpiQRope {
    static constexpr bool PERM = false, AFTER_DRAIN = false;
    bf16_t* O; int ldc; const float* tab; const PG8_LAS float* rstd;
    __device__ __forceinline__ void operator()(const f32x4 (&acc)[2][2][4][2], const Unit& u, int wr, int wc, int fr, int fq) const {
        typedef unsigned u32x2 __attribute__((ext_vector_type(2)));
        const int row0 = u.pm * BM + wr * 64 + fr;
#pragma unroll
        for (int ai = 0; ai < 2; ++ai)
#pragma unroll
            for (int m = 0; m < 4; ++m) { const int row = row0 + ai * HALF + m * 16;
                const f32x4 cs = *(const f32x4*)(tab + (size_t)row * 32 + 4 * fq), sn = *(const f32x4*)(tab + (size_t)row * 32 + 16 + 4 * fq);
                const float rs = rstd[wr * 64 + fr + ai * HALF + m * 16];
#pragma unroll
                for (int bj = 0; bj < 2; ++bj) { const int cgp = u.pn * BM + bj * HALF + wc * 32;
                    f32x4 x1 = acc[ai][bj][m][0] * rs, x2 = acc[ai][bj][m][1] * rs;
                    if ((cgp % 96) == 64) { const f32x4 o1 = x1 * cs - x2 * sn, o2 = x2 * cs + x1 * sn; x1 = o1; x2 = o2; }
                    bf16_t* op = O + (size_t)row * ldc + cgp + 4 * fq;
                    u32x2 w1, w2; w1.x = cvt_pk_bf16(x1[0], x1[1]); w1.y = cvt_pk_bf16(x1[2], x1[3]); w2.x = cvt_pk_bf16(x2[0], x2[1]); w2.y = cvt_pk_bf16(x2[2], x2[3]);
                    *(u32x2*)op = w1; *(u32x2*)(op + 16) = w2; }
                asm volatile("" ::: "memory"); }
    }
};
}

#define DI __device__ __forceinline__
#define LAS __attribute__((address_space(3)))
typedef unsigned short bf16_t;
typedef short bf16x8 __attribute__((ext_vector_type(8)));
typedef short s16x4 __attribute__((ext_vector_type(4)));
typedef float f32x4 __attribute__((ext_vector_type(4)));
typedef float f32x16 __attribute__((ext_vector_type(16)));
typedef unsigned u32x4 __attribute__((ext_vector_type(4)));
typedef unsigned u32x2 __attribute__((ext_vector_type(2)));

constexpr int BATCH = 4, SEQ = 4096, DM = 1024, MT = BATCH * SEQ, DFF = 4096;
constexpr int LD_AB = 3072, LD_CD = 2304, NSRC_AB = 3080, NSRC_CD = 2208;
constexpr int NWAVES = 8, NTHREADS = 512;
constexpr float LOG2E = 1.4426950408889634f, LN2 = 0.6931471805599453f, EPS = 1e-6f;
constexpr size_t MiB = 1u << 20;
constexpr size_t WS_WINAB = 0, WS_WOUTAB = 6 * MiB, WS_WINCD = 8 * MiB, WS_WUQ = 13 * MiB, WS_WUKV = 14 * MiB, WS_WOUTCD = 15 * MiB;
constexpr size_t WS_WUP0 = 17 * MiB, WS_WUP1 = 25 * MiB, WS_WDN0 = 33 * MiB, WS_WDN1 = 41 * MiB;
constexpr size_t WS_LOGF = 49 * MiB, WS_CUM = 49 * MiB + 512 * 1024, WS_TAB = 50 * MiB, WS_KR = 52 * MiB, WS_SSQ = 53 * MiB, WS_SSQ2 = 86 * MiB;
constexpr size_t WS_XN = 54 * MiB, WS_CQN = 54 * MiB, WS_CKVN = 66 * MiB, WS_O = 86 * MiB;
constexpr size_t WS_BIG = 118 * MiB, WS_QF = 190 * MiB, WS_KVF = 214 * MiB, WS_CTL = 246 * MiB, CTL_BYTES = 65536, CTL_KN2 = 32768, WS_END = 247 * MiB;
constexpr int LDS_BYTES = 147456, MISC_OFF = 131072 + 320;

DI float bf2f(unsigned short v) { return __uint_as_float((unsigned)v << 16); }
DI unsigned pk2(float lo, float hi) { typedef float f2 __attribute__((ext_vector_type(2))); typedef __bf16 b2 __attribute__((ext_vector_type(2))); f2 v = {lo, hi}; b2 b = __builtin_convertvector(v, b2); return __builtin_bit_cast(unsigned, b); }
DI float wave_sum(float v) {
#pragma unroll
    for (int o = 1; o < 64; o <<= 1) v += __shfl_xor(v, o);
    return v;
}
DI float fexp2(float x) { return __builtin_amdgcn_exp2f(x); }
DI float flog2(float x) { return __builtin_amdgcn_logf(x); }

DI void transpose_item(const float* W, int K, int ldn, int src_col0, bf16_t* WT, int dst_row0, int nblk, LAS float* scr, int item, int lane, const float* gain) {
    const int kb = item / nblk, nb = item % nblk, k0 = 64 * kb, n0 = 32 * nb;
    float wv[32];
#pragma unroll
    for (int i = 0; i < 32; ++i) { const int kk = 2 * i + (lane >> 5); wv[i] = W[(size_t)(k0 + kk) * ldn + src_col0 + n0 + (lane & 31)]; }
    if (gain) {
#pragma unroll
        for (int i = 0; i < 32; ++i) wv[i] *= gain[k0 + 2 * i + (lane >> 5)]; }
#pragma unroll
    for (int i = 0; i < 32; ++i) { const int kk = 2 * i + (lane >> 5); scr[kk * 33 + (lane & 31)] = wv[i]; }
    asm volatile("s_waitcnt lgkmcnt(0)" ::: "memory");
    const int c = lane & 7;
#pragma unroll
    for (int j = 0; j < 4; ++j) { const int n = (lane >> 3) + 8 * j; const LAS float* s = scr + (8 * c) * 33 + n;
        u32x4 o; o.x = pk2(s[0 * 33], s[1 * 33]); o.y = pk2(s[2 * 33], s[3 * 33]); o.z = pk2(s[4 * 33], s[5 * 33]); o.w = pk2(s[6 * 33], s[7 * 33]);
        *(u32x4*)(WT + (size_t)(dst_row0 + n0 + n) * K + k0 + 8 * c) = o; }
    asm volatile("s_waitcnt lgkmcnt(0)" ::: "memory");
}

DI void sincos_d(double a, float& sn, float& cs);
DI float inv_freq_f(int i);
template <bool FA> DI void norm_rows_bf16(const float* src, const float* gain, bf16_t* dst, int gw, int ngw, int lane, const LAS float* wfaT, const float* b_forget, float* logf_out, const int* pos, float* tab) {
    f32x4 g[4];
#pragma unroll
    for (int j = 0; j < 4; ++j) g[j] = ((const f32x4*)gain)[64 * j + lane];
    f32x4 nx[4];
    if (gw < MT) {
#pragma unroll
        for (int j = 0; j < 4; ++j) nx[j] = ((const f32x4*)(src + (size_t)gw * DM) + lane)[64 * j]; }
    for (int row = gw; row < MT; row += ngw) {
        f32x4 v[4]; float s = 0.f;
#pragma unroll
        for (int j = 0; j < 4; ++j) v[j] = nx[j];
        if (row + ngw < MT) {
#pragma unroll
            for (int j = 0; j < 4; ++j) nx[j] = ((const f32x4*)(src + (size_t)(row + ngw) * DM) + lane)[64 * j]; }
#pragma unroll
        for (int j = 0; j < 4; ++j) { s += (v[j].x * v[j].x + v[j].y * v[j].y) + (v[j].z * v[j].z + v[j].w * v[j].w); v[j] = v[j] * g[j]; }
        float a8[8];
        if (FA) {
#pragma unroll
            for (int jj = 0; jj < 8; ++jj) { float a = 0.f;
#pragma unroll
                for (int j = 0; j < 4; ++j) { const f32x4 w = *(const LAS f32x4*)(wfaT + jj * 1024 + 256 * j + 4 * lane); a += (v[j].x * w.x + v[j].y * w.y) + (v[j].z * w.z + v[j].w * w.w); }
                a8[jj] = a; }
        }
        const float rstd = 1.0f / sqrtf(wave_sum(s) * (1.f / DM) + EPS);
        unsigned long long* o8 = (unsigned long long*)(dst + (size_t)row * DM) + lane;
#pragma unroll
        for (int j = 0; j < 4; ++j) { const f32x4 y = v[j] * rstd; o8[64 * j] = (unsigned long long)pk2(y.x, y.y) | ((unsigned long long)pk2(y.z, y.w) << 32); }
        if (FA) {
            float b4[4], c2[2], d;
            { const bool up = (lane & 32) != 0;
#pragma unroll
              for (int i = 0; i < 4; ++i) { const float keep = up ? a8[i + 4] : a8[i], send = up ? a8[i] : a8[i + 4]; b4[i] = keep + __shfl_xor(send, 32); } }
            { const bool up = (lane & 16) != 0;
#pragma unroll
              for (int i = 0; i < 2; ++i) { const float keep = up ? b4[i + 2] : b4[i], send = up ? b4[i] : b4[i + 2]; c2[i] = keep + __shfl_xor(send, 16); } }
            { const bool up = (lane & 8) != 0; const float keep = up ? c2[1] : c2[0], send = up ? c2[0] : c2[1]; d = keep + __shfl_xor(send, 8); }
            d += __shfl_xor(d, 4); d += __shfl_xor(d, 2); d += __shfl_xor(d, 1);
            if ((lane & 7) == 0) { const int j = lane >> 3; const float t = d * rstd + b_forget[j]; const float ls = fminf(t, 0.f) - log1pf(expf(-fabsf(t))); logf_out[(size_t)row * 8 + j] = ls; }
            if (lane < 16) { const float ang = (float)pos[row] * inv_freq_f(lane); float sn, cs; sincos_d((double)ang, sn, cs); tab[(size_t)row * 32 + lane] = cs; tab[(size_t)row * 32 + 16 + lane] = sn; }
        }
    }
}
DI void norm_rows_f32(float* buf, const float* gain, int gw, int ngw, int lane) {
    f32x4 g[4];
#pragma unroll
    for (int j = 0; j < 4; ++j) g[j] = ((const f32x4*)gain)[64 * j + lane];
    for (int row = gw; row < MT; row += ngw) {
        f32x4* xr = (f32x4*)(buf + (size_t)row * DM) + lane;
        f32x4 v[4]; float s = 0.f;
#pragma unroll
        for (int j = 0; j < 4; ++j) { v[j] = xr[64 * j]; s += (v[j].x * v[j].x + v[j].y * v[j].y) + (v[j].z * v[j].z + v[j].w * v[j].w); }
        const float rstd = 1.0f / sqrtf(wave_sum(s) * (1.f / DM) + EPS);
#pragma unroll
        for (int j = 0; j < 4; ++j) xr[64 * j] = v[j] * rstd * g[j];
    }
}

DI void sincos_d(double a, float& sn, float& cs) {
    const double n = rint(a * 0.63661977236758134308);
    const double r = fma(-n, 1.5707963267948966192, a) - n * 6.123233995736766e-17;
    const double r2 = r * r;
    double sp = -2.5052108385441718775e-8; sp = sp * r2 + 2.7557319223985890653e-6; sp = sp * r2 - 1.9841269841269841270e-4; sp = sp * r2 + 8.3333333333333333333e-3; sp = sp * r2 - 1.6666666666666666667e-1; sp = r + r * r2 * sp;
    double cp = 2.0876756987868098979e-9; cp = cp * r2 - 2.7557319223985890653e-7; cp = cp * r2 + 2.4801587301587301587e-5; cp = cp * r2 - 1.3888888888888888889e-3; cp = cp * r2 + 4.1666666666666666667e-2; cp = cp * r2 - 0.5; cp = 1.0 + r2 * cp;
    const int q = (int)((long long)n & 3);
    const double s_ = (q == 0) ? sp : (q == 1) ? cp : (q == 2) ? -sp : -cp;
    const double c_ = (q == 0) ? cp : (q == 1) ? -sp : (q == 2) ? -cp : sp;
    sn = (float)s_; cs = (float)c_;
}
DI float inv_freq_f(int i) {
    float r = 1.0f;
    r = (i == 1) ? 0.56234132519034908f : r;
    r = (i == 2) ? 0.31622776601683794f : r;
    r = (i == 3) ? 0.17782794100389228f : r;
    r = (i == 4) ? 0.1f : r;
    r = (i == 5) ? 0.056234132519034911f : r;
    r = (i == 6) ? 0.031622776601683791f : r;
    r = (i == 7) ? 0.017782794100389229f : r;
    r = (i == 8) ? 0.01f : r;
    r = (i == 9) ? 0.0056234132519034910f : r;
    r = (i == 10) ? 0.0031622776601683794f : r;
    r = (i == 11) ? 0.0017782794100389228f : r;
    r = (i == 12) ? 0.001f : r;
    r = (i == 13) ? 0.00056234132519034907f : r;
    r = (i == 14) ? 0.00031622776601683794f : r;
    r = (i == 15) ? 0.00017782794100389227f : r;
    return r;
}
DI void mla_prep_rows(const bf16_t* PC, const int* pos, const float* q_norm, const float* kv_norm, bf16_t* cqn, bf16_t* ckvn, float* tab, bf16_t* KR, int gw, int ngw, int lane) {
    for (int row = gw; row < MT; row += ngw) {
        const bf16_t* pr = PC + (size_t)row * LD_CD;
        {
            float v[8]; float s = 0.f;
            if (lane < 48) { const u32x4 w = *(const u32x4*)(pr + 1536 + 8 * lane);
#pragma unroll
                for (int e = 0; e < 4; ++e) { v[2 * e] = __uint_as_float(w[e] << 16); v[2 * e + 1] = __uint_as_float(w[e] & 0xffff0000u); s += v[2 * e] * v[2 * e] + v[2 * e + 1] * v[2 * e + 1]; } }
            else {
#pragma unroll
                for (int e = 0; e < 8; ++e) v[e] = 0.f; }
            const float rstd = 1.0f / sqrtf(wave_sum(s) * (1.f / 384.f) + EPS);
            if (lane < 48) { const f32x4 g0 = *(const f32x4*)(q_norm + 8 * lane), g1 = *(const f32x4*)(q_norm + 8 * lane + 4);
                u32x4 o; o.x = pk2(v[0] * rstd * g0.x, v[1] * rstd * g0.y); o.y = pk2(v[2] * rstd * g0.z, v[3] * rstd * g0.w); o.z = pk2(v[4] * rstd * g1.x, v[5] * rstd * g1.y); o.w = pk2(v[6] * rstd * g1.z, v[7] * rstd * g1.w);
                *(u32x4*)(cqn + (size_t)row * 384 + 8 * lane) = o; }
        }
        {
            float v[8]; float s = 0.f;
            if (lane < 32) { const u32x4 w = *(const u32x4*)(pr + 1920 + 8 * lane);
#pragma unroll
                for (int e = 0; e < 4; ++e) { v[2 * e] = __uint_as_float(w[e] << 16); v[2 * e + 1] = __uint_as_float(w[e] & 0xffff0000u); s += v[2 * e] * v[2 * e] + v[2 * e + 1] * v[2 * e + 1]; } }
            else {
#pragma unroll
                for (int e = 0; e < 8; ++e) v[e] = 0.f; }
            const float rstd = 1.0f / sqrtf(wave_sum(s) * (1.f / 256.f) + EPS);
            if (lane < 32) { const f32x4 g0 = *(const f32x4*)(kv_norm + 8 * lane), g1 = *(const f32x4*)(kv_norm + 8 * lane + 4);
                u32x4 o; o.x = pk2(v[0] * rstd * g0.x, v[1] * rstd * g0.y); o.y = pk2(v[2] * rstd * g0.z, v[3] * rstd * g0.w); o.z = pk2(v[4] * rstd * g1.x, v[5] * rstd * g1.y); o.w = pk2(v[6] * rstd * g1.z, v[7] * rstd * g1.w);
                *(u32x4*)(ckvn + (size_t)row * 256 + 8 * lane) = o; }
        }
        if (lane < 16) {
            const float cs = tab[(size_t)row * 32 + lane], sn = tab[(size_t)row * 32 + 16 + lane];
            const float x1 = bf2f(pr[2176 + lane]), x2 = bf2f(pr[2176 + 16 + lane]);
            KR[(size_t)row * 32 + lane] = (bf16_t)(pk2(x1 * cs - x2 * sn, 0.f) & 0xffffu);
            KR[(size_t)row * 32 + 16 + lane] = (bf16_t)(pk2(x2 * cs + x1 * sn, 0.f) & 0xffffu);
        }
    }
}

namespace att {
constexpr int KBUF = 13312, VBUF = 9216;
constexpr int OFF_K = 0, OFF_V = 2 * KBUF, OFF_C = OFF_V + 2 * VBUF, OFF_RB = OFF_C + 512, OFF_FLAG = OFF_RB + 1280, ATT_LDS = OFF_FLAG + 64;
DI f32x16 mfma(bf16x8 a, bf16x8 b, f32x16 c) { return __builtin_amdgcn_mfma_f32_32x32x16_bf16(a, b, c, 0, 0, 0); }
DI int crow(int i, int hh) { return (i & 3) + 8 * (i >> 2) + 4 * hh; }
DI bf16x8 packfrag(const f32x16& p, int s) { u32x4 w; w.x = pk2(p[8 * s], p[8 * s + 1]); w.y = pk2(p[8 * s + 2], p[8 * s + 3]); w.z = pk2(p[8 * s + 4], p[8 * s + 5]); w.w = pk2(p[8 * s + 6], p[8 * s + 7]); return __builtin_bit_cast(bf16x8, w); }
typedef short v4i16_t __attribute__((ext_vector_type(4)));
DI s16x4 vtr(const LAS unsigned char* p) { return __builtin_bit_cast(s16x4, __builtin_amdgcn_ds_read_tr16_b64_v4i16((LAS v4i16_t*)p)); }

struct Lane { int tid, lane, wid, r, hh, q4, p4, blk, srow, sch; };
DI Lane mklane() { Lane L; L.tid = threadIdx.x; L.lane = L.tid & 63; L.wid = __builtin_amdgcn_readfirstlane(L.tid >> 6); L.r = L.lane & 31; L.hh = L.lane >> 5;
    const int i16 = L.lane & 15; L.q4 = i16 >> 2; L.p4 = i16 & 3; L.blk = (L.lane >> 4) & 1; L.srow = L.tid >> 3; L.sch = L.tid & 7; return L; }

template <int NDS, int KSTRIDE> DI void qk_tile(f32x16& p0, f32x16& p1, const LAS unsigned char* Kb, const bf16x8* qf, const Lane& L) {
    const LAS unsigned char* ka = Kb + L.r * KSTRIDE + L.hh * 16;
#pragma unroll
    for (int i = 0; i < 16; ++i) { p0[i] = 0.f; p1[i] = 0.f; }
#pragma unroll
    for (int ds = 0; ds < NDS; ++ds) {
        const bf16x8 a0 = *(const LAS bf16x8*)(ka + ds * 32), a1 = *(const LAS bf16x8*)(ka + 32 * KSTRIDE + ds * 32);
        p0 = mfma(a0, qf[ds], p0); p1 = mfma(a1, qf[ds], p1); }
}
DI void pv_tile(f32x16& o0, f32x16& o1, const LAS unsigned char* Vb, const bf16x8 (&pf)[4], const Lane& L) {
    const LAS unsigned char* vb = Vb + (4 * L.hh + L.q4) * 144 + (16 * L.blk + 4 * L.p4) * 2;
#pragma unroll
    for (int f = 0; f < 4; ++f) { const LAS unsigned char* base = vb + (16 * f) * 144;
        { const s16x4 lo = vtr(base), hi = vtr(base + 8 * 144); const bf16x8 vf = __builtin_shufflevector(lo, hi, 0, 1, 2, 3, 4, 5, 6, 7); o0 = mfma(vf, pf[f], o0); }
        { const s16x4 lo = vtr(base + 64), hi = vtr(base + 8 * 144 + 64); const bf16x8 vf = __builtin_shufflevector(lo, hi, 0, 1, 2, 3, 4, 5, 6, 7); o1 = mfma(vf, pf[f], o1); } }
}
DI void online_softmax(f32x16& p0, f32x16& p1, float& m, float& l, f32x16& o0, f32x16& o1, bf16x8 (&pf)[4]) {
    float mt = fmaxf(p0[0], p1[0]);
#pragma unroll
    for (int i = 1; i < 16; ++i) mt = fmaxf(mt, fmaxf(p0[i], p1[i]));
    mt = fmaxf(mt, __shfl_xor(mt, 32));
    if (__any(mt > m)) {
        const float mn = fmaxf(m, mt), alpha = fexp2(m - mn); m = mn; l *= alpha;
#pragma unroll
        for (int i = 0; i < 16; ++i) { o0[i] *= alpha; o1[i] *= alpha; }
    }
    float rs = 0.f;
#pragma unroll
    for (int i = 0; i < 16; ++i) { p0[i] = fexp2(p0[i] - m); p1[i] = fexp2(p1[i] - m); rs += p0[i] + p1[i]; }
    l += rs;
    pf[0] = packfrag(p0, 0); pf[1] = packfrag(p0, 1); pf[2] = packfrag(p1, 0); pf[3] = packfrag(p1, 1);
}
DI void store_o(bf16_t* orow, const f32x16& o0, const f32x16& o1, float inv, int hh) {
#pragma unroll
    for (int g = 0; g < 4; ++g) {
        u32x2 w0, w1; w0.x = pk2(o0[4 * g] * inv, o0[4 * g + 1] * inv); w0.y = pk2(o0[4 * g + 2] * inv, o0[4 * g + 3] * inv);
        w1.x = pk2(o1[4 * g] * inv, o1[4 * g + 1] * inv); w1.y = pk2(o1[4 * g + 2] * inv, o1[4 * g + 3] * inv);
        *(u32x2*)(orow + 8 * g + 4 * hh) = w0; *(u32x2*)(orow + 32 + 8 * g + 4 * hh) = w1; }
}

DI void fox_unit(LAS unsigned char* lds, const bf16_t* PA, const float* cum, const unsigned* kn2, bf16_t* O, int b, int h, int qb) {
    const Lane L = mklane();
    const size_t rowbase = (size_t)b * SEQ;
    const int q0 = qb * 256, q0w = q0 + L.wid * 32, myq = q0w + L.r;
    const bf16_t* Qp = PA + (rowbase + myq) * LD_AB + h * 64;
    const bf16_t* Kp = PA + rowbase * LD_AB + 512 + h * 64;
    const bf16_t* Vp = Kp + 512;
    const float* cumh = cum + (size_t)(b * 8 + h) * SEQ;
    bf16x8 qf[4];
#pragma unroll
    for (int ds = 0; ds < 4; ++ds) qf[ds] = *(const bf16x8*)(Qp + 16 * ds + 8 * L.hh);
    const float c1 = 0.125f * LOG2E;
    float qn2 = 0.f;
#pragma unroll
    for (int ds = 0; ds < 4; ++ds)
#pragma unroll
        for (int j = 0; j < 8; ++j) { const float qv = bf2f((unsigned short)qf[ds][j]); qn2 += qv * qv; }
    qn2 += __shfl_xor(qn2, 32);
    const float kmax2 = __uint_as_float(kn2[(b * 8 + h) * 2]) + __uint_as_float(kn2[(b * 8 + h) * 2 + 1]);
    const float smax = sqrtf(qn2 * kmax2) * c1 * 1.01f + 1e-3f;
    const int NT = (q0 + 256) / 64;
    float m = -INFINITY, l = 0.f; f32x16 o0, o1;
#pragma unroll
    for (int i = 0; i < 16; ++i) { o0[i] = 0.f; o1[i] = 0.f; }
    bool seen = false;
    LAS int* flags = (LAS int*)(lds + OFF_FLAG);
    u32x4 kreg, vreg; float creg = 0.f;
#define FOX_LOAD(t) do { kreg = *(const u32x4*)(Kp + (size_t)((t) * 64 + L.srow) * LD_AB + L.sch * 8); vreg = *(const u32x4*)(Vp + (size_t)((t) * 64 + L.srow) * LD_AB + L.sch * 8); \
        if (L.tid < 64) creg = cumh[(t) * 64 + L.tid] * (-LOG2E); } while (0)
#define FOX_WRITE(bf) do { *(LAS u32x4*)(lds + OFF_K + (bf) * KBUF + L.srow * 144 + L.sch * 16) = kreg; *(LAS u32x4*)(lds + OFF_V + (bf) * VBUF + L.srow * 144 + L.sch * 16) = vreg; \
        if (L.tid < 64) *(LAS float*)(lds + OFF_C + (bf) * 256 + L.tid * 4) = creg; } while (0)
    FOX_LOAD(NT - 1); FOX_WRITE(0); __syncthreads();
    for (int it = 0; it < NT; ++it) {
        const int t = NT - 1 - it, k0 = t * 64, bf = it & 1;
        if (t > 0) FOX_LOAD(t - 1);
        bool done = false;
        if (k0 <= q0w + 31) {
            const LAS unsigned char* Cb = lds + OFF_C + bf * 256;
            const float nck_last = *(const LAS float*)(Cb + 63 * 4);
            done = seen && __all(smax + nck_last - m < -40.0f);
            if (!done) {
                f32x16 p0, p1;
                qk_tile<4, 144>(p0, p1, lds + OFF_K + bf * KBUF, qf, L);
#pragma unroll
                for (int g = 0; g < 4; ++g) { const f32x4 ca = *(const LAS f32x4*)(Cb + (8 * g + 4 * L.hh) * 4), cb = *(const LAS f32x4*)(Cb + (32 + 8 * g + 4 * L.hh) * 4);
#pragma unroll
                    for (int e = 0; e < 4; ++e) { p0[4 * g + e] = fmaf(p0[4 * g + e], c1, ca[e]); p1[4 * g + e] = fmaf(p1[4 * g + e], c1, cb[e]); } }
                if (k0 + 63 > q0w) {
#pragma unroll
                    for (int i = 0; i < 16; ++i) { const int key = k0 + crow(i, L.hh); if (key > myq) p0[i] = -INFINITY; if (key + 32 > myq) p1[i] = -INFINITY; } }
                bf16x8 pf[4];
                online_softmax(p0, p1, m, l, o0, o1, pf);
                pv_tile(o0, o1, lds + OFF_V + bf * VBUF, pf, L);
                seen = true;
            }
        }
        if (L.lane == 0) flags[(it & 1) * 8 + L.wid] = done ? 1 : 0;
        if (t > 0) FOX_WRITE((it + 1) & 1);
        __syncthreads();
        int alld = 1;
#pragma unroll
        for (int w = 0; w < 8; ++w) alld &= flags[(it & 1) * 8 + w];
        if (alld) break;
    }
#undef FOX_LOAD
#undef FOX_WRITE
    const float lt = l + __shfl_xor(l, 32);
    store_o(O + (rowbase + myq) * DM + h * 64, o0, o1, 1.0f / lt, L.hh);
    __syncthreads();
}

DI void chk_unit(LAS unsigned char* lds, const bf16_t* PA, const float* rel_bias, bf16_t* O, int b, int h, int g4) {
    const Lane L = mklane();
    const size_t rowbase = (size_t)b * SEQ;
    const int cw = 4 * g4 + (L.wid >> 1), myq = 64 * cw + 32 * (L.wid & 1) + L.r;
    const bf16_t* Qp = PA + (rowbase + myq) * LD_AB + 1536 + h * 64;
    const bf16_t* Kp = PA + rowbase * LD_AB + 2048 + h * 64;
    const bf16_t* Vp = Kp + 512;
    bf16x8 qf[4];
#pragma unroll
    for (int ds = 0; ds < 4; ++ds) qf[ds] = *(const bf16x8*)(Qp + 16 * ds + 8 * L.hh);
    const float c1 = 0.125f * LOG2E;
    const int c_lo = (4 * g4 - 8) > 0 ? (4 * g4 - 8) : 0, NT = 4 * g4 + 4 - c_lo;
    LAS float* rb = (LAS float*)(lds + OFF_RB);
    if (L.tid < 320) rb[L.tid] = rel_bias[h * 320 + L.tid] * LOG2E;
    float m = -INFINITY, l = 0.f; f32x16 o0, o1;
#pragma unroll
    for (int i = 0; i < 16; ++i) { o0[i] = 0.f; o1[i] = 0.f; }
    u32x4 kreg, vreg;
#define CHK_LOAD(t) do { kreg = *(const u32x4*)(Kp + (size_t)((c_lo + (t)) * 64 + L.srow) * LD_AB + L.sch * 8); vreg = *(const u32x4*)(Vp + (size_t)((c_lo + (t)) * 64 + L.srow) * LD_AB + L.sch * 8); } while (0)
#define CHK_WRITE(bf) do { *(LAS u32x4*)(lds + OFF_K + (bf) * KBUF + L.srow * 144 + L.sch * 16) = kreg; *(LAS u32x4*)(lds + OFF_V + (bf) * VBUF + L.srow * 144 + L.sch * 16) = vreg; } while (0)
    CHK_LOAD(0); CHK_WRITE(0); __syncthreads();
    for (int t = 0; t < NT; ++t) {
        if (t + 1 < NT) CHK_LOAD(t + 1);
        const int kc = c_lo + t, bf = t & 1;
        if (kc >= cw - 8 && kc <= cw) {
            f32x16 p0, p1;
            qk_tile<4, 144>(p0, p1, lds + OFF_K + bf * KBUF, qf, L);
            if (cw - kc >= 5) { const float bb = rb[319];
#pragma unroll
                for (int i = 0; i < 16; ++i) { p0[i] = fmaf(p0[i], c1, bb); p1[i] = fmaf(p1[i], c1, bb); } }
            else {
#pragma unroll
                for (int i = 0; i < 16; ++i) { const int rel = myq - (64 * kc + crow(i, L.hh));
                    const int i0 = (rel < 256 ? rel : 256) + 63, i1 = (rel - 32 < 256 ? rel - 32 : 256) + 63;
                    p0[i] = fmaf(p0[i], c1, rb[i0]); p1[i] = fmaf(p1[i], c1, rb[i1]); } }
            bf16x8 pf[4];
            online_softmax(p0, p1, m, l, o0, o1, pf);
            pv_tile(o0, o1, lds + OFF_V + bf * VBUF, pf, L);
        }
        if (t + 1 < NT) CHK_WRITE((t + 1) & 1);
        __syncthreads();
    }
#undef CHK_LOAD
#undef CHK_WRITE
    const float lt = l + __shfl_xor(l, 32);
    store_o(O + (rowbase + myq) * DM + 512 + h * 64, o0, o1, 1.0f / lt, L.hh);
}

DI void mla_unit(LAS unsigned char* lds, const bf16_t* QF, const bf16_t* KVF, const bf16_t* KR, bf16_t* O, int b, int h, int qb) {
    const Lane L = mklane();
    const size_t rowbase = (size_t)b * SEQ;
    const int cw = 4 * qb + (L.wid >> 1), myq = 64 * cw + 32 * (L.wid & 1) + L.r;
    const bf16_t* Qp = QF + (rowbase + myq) * 768 + h * 96;
    const bf16_t* Kp = KVF + rowbase * 1024 + h * 128;
    const bf16_t* Vp = Kp + 64;
    const bf16_t* Rp = KR + rowbase * 32;
    bf16x8 qf[6];
#pragma unroll
    for (int ds = 0; ds < 6; ++ds) qf[ds] = *(const bf16x8*)(Qp + 16 * ds + 8 * L.hh);
    const float c1 = 0.10206207261596577f * LOG2E;
    const int NT = 4 * qb + 4;
    float m = -INFINITY, l = 0.f; f32x16 o0, o1;
#pragma unroll
    for (int i = 0; i < 16; ++i) { o0[i] = 0.f; o1[i] = 0.f; }
    u32x4 kreg, vreg, rreg;
#define MLA_LOAD(t) do { kreg = *(const u32x4*)(Kp + (size_t)((t) * 64 + L.srow) * 1024 + L.sch * 8); vreg = *(const u32x4*)(Vp + (size_t)((t) * 64 + L.srow) * 1024 + L.sch * 8); \
        if (L.tid < 256) rreg = *(const u32x4*)(Rp + (size_t)((t) * 64 + (L.tid >> 2)) * 32 + (L.tid & 3) * 8); } while (0)
#define MLA_WRITE(bf) do { *(LAS u32x4*)(lds + OFF_K + (bf) * KBUF + L.srow * 208 + L.sch * 16) = kreg; *(LAS u32x4*)(lds + OFF_V + (bf) * VBUF + L.srow * 144 + L.sch * 16) = vreg; \
        if (L.tid < 256) *(LAS u32x4*)(lds + OFF_K + (bf) * KBUF + (L.tid >> 2) * 208 + 128 + (L.tid & 3) * 16) = rreg; } while (0)
    MLA_LOAD(0); MLA_WRITE(0); __syncthreads();
    for (int t = 0; t < NT; ++t) {
        if (t + 1 < NT) MLA_LOAD(t + 1);
        const int bf = t & 1;
        if (t <= cw) {
            f32x16 p0, p1;
            qk_tile<6, 208>(p0, p1, lds + OFF_K + bf * KBUF, qf, L);
#pragma unroll
            for (int i = 0; i < 16; ++i) { p0[i] *= c1; p1[i] *= c1; }
            bf16x8 pf[4];
            online_softmax(p0, p1, m, l, o0, o1, pf);
            pv_tile(o0, o1, lds + OFF_V + bf * VBUF, pf, L);
        }
        if (t + 1 < NT) MLA_WRITE((t + 1) & 1);
        __syncthreads();
    }
#undef MLA_LOAD
#undef MLA_WRITE
    const float lt = l + __shfl_xor(l, 32);
    store_o(O + (rowbase + myq) * DM + 512 + h * 64, o0, o1, 1.0f / lt, L.hh);
}

DI void sb_sub(f32x16& p, float& R, int keybase, int myq, int hh, bool need_mask) {
    float lk[16], lb[16];
#pragma unroll
    for (int i = 0; i < 16; ++i) {
        const float z = p[i] * 0.125f, u = fexp2(-fabsf(z) * LOG2E), sp = fmaxf(z, 0.f) + flog2(1.0f + u) * LN2;
        const bool valid = !need_mask || (keybase + crow(i, hh)) < myq;
        lk[i] = valid ? -sp : 0.f; lb[i] = valid ? (z - sp) : -INFINITY; }
    float G[4], Gp[4];
#pragma unroll
    for (int g = 0; g < 4; ++g) { G[g] = (lk[4 * g] + lk[4 * g + 1]) + (lk[4 * g + 2] + lk[4 * g + 3]); Gp[g] = __shfl_xor(G[g], 32); }
    float acc = R;
#pragma unroll
    for (int g = 3; g >= 0; --g) {
        const float s3 = hh ? acc : acc + Gp[g];
        acc += G[g] + Gp[g];
        const float s2 = s3 + lk[4 * g + 3], s1 = s2 + lk[4 * g + 2], s0 = s1 + lk[4 * g + 1];
        p[4 * g + 3] = fexp2((lb[4 * g + 3] + s3) * LOG2E); p[4 * g + 2] = fexp2((lb[4 * g + 2] + s2) * LOG2E);
        p[4 * g + 1] = fexp2((lb[4 * g + 1] + s1) * LOG2E); p[4 * g] = fexp2((lb[4 * g] + s0) * LOG2E); }
    R = acc;
}
DI void sb_unit(LAS unsigned char* lds, const bf16_t* PC, bf16_t* O, int b, int h, int qb) {
    const Lane L = mklane();
    const size_t rowbase = (size_t)b * SEQ;
    const int q0 = qb * 256, q0w = q0 + L.wid * 32, myq = q0w + L.r;
    const bf16_t* Qp = PC + (rowbase + myq) * LD_CD + h * 64;
    const bf16_t* Kp = PC + rowbase * LD_CD + 512 + h * 64;
    const bf16_t* Vp = Kp + 512;
    bf16x8 qf[4];
#pragma unroll
    for (int ds = 0; ds < 4; ++ds) qf[ds] = *(const bf16x8*)(Qp + 16 * ds + 8 * L.hh);
    const int NT = (q0 + 256) / 64;
    float R = 0.f; f32x16 o0, o1;
#pragma unroll
    for (int i = 0; i < 16; ++i) { o0[i] = 0.f; o1[i] = 0.f; }
    bool seen = false;
    LAS int* flags = (LAS int*)(lds + OFF_FLAG);
    u32x4 kreg, vreg;
#define SB_LOAD(t) do { kreg = *(const u32x4*)(Kp + (size_t)((t) * 64 + L.srow) * LD_CD + L.sch * 8); vreg = *(const u32x4*)(Vp + (size_t)((t) * 64 + L.srow) * LD_CD + L.sch * 8); } while (0)
#define SB_WRITE(bf) do { *(LAS u32x4*)(lds + OFF_K + (bf) * KBUF + L.srow * 144 + L.sch * 16) = kreg; *(LAS u32x4*)(lds + OFF_V + (bf) * VBUF + L.srow * 144 + L.sch * 16) = vreg; } while (0)
    SB_LOAD(NT - 1); SB_WRITE(0); __syncthreads();
    for (int it = 0; it < NT; ++it) {
        const int t = NT - 1 - it, k0 = t * 64, bf = it & 1;
        if (t > 0) SB_LOAD(t - 1);
        bool done = false;
        if (k0 <= q0w + 31) {
            done = seen && __all(R < -110.0f);
            if (!done) {
                f32x16 p0, p1;
                qk_tile<4, 144>(p0, p1, lds + OFF_K + bf * KBUF, qf, L);
                const bool nm = (k0 + 63 >= q0w);
                sb_sub(p1, R, k0 + 32, myq, L.hh, nm);
                sb_sub(p0, R, k0, myq, L.hh, nm);
                bf16x8 pf[4];
                pf[0] = packfrag(p0, 0); pf[1] = packfrag(p0, 1); pf[2] = packfrag(p1, 0); pf[3] = packfrag(p1, 1);
                pv_tile(o0, o1, lds + OFF_V + bf * VBUF, pf, L);
                seen = true;
                done = __all(R < -110.0f);
            }
        }
        if (L.lane == 0) flags[(it & 1) * 8 + L.wid] = done ? 1 : 0;
        if (t > 0) SB_WRITE((it + 1) & 1);
        __syncthreads();
        int alld = 1;
#pragma unroll
        for (int w = 0; w < 8; ++w) alld &= flags[(it & 1) * 8 + w];
        if (alld) break;
    }
#undef SB_LOAD
#undef SB_WRITE
    store_o(O + (rowbase + myq) * DM + h * 64, o0, o1, 1.0f, L.hh);
    __syncthreads();
}
}

#define XB_TMO      128
#define XB_XCNT(j)  (256  + 64 * (j))
#define XB_XSUB(j)  (1280 + 64 * (j))
#define XB_XGEN(j)  (2304 + 64 * (j))
#define XB_TOP      3328
#define XB_TOPGEN   3392
#define XCD_BAR_WORDS 3456
#define XB_SPIN_CAP (1u << 18)

__device__ __forceinline__ unsigned xb_ld(unsigned* p)              { return __hip_atomic_load(p, __ATOMIC_RELAXED, __HIP_MEMORY_SCOPE_AGENT); }
__device__ __forceinline__ unsigned xb_add(unsigned* p, unsigned v) { return __hip_atomic_fetch_add(p, v, __ATOMIC_RELAXED, __HIP_MEMORY_SCOPE_AGENT); }
__device__ __forceinline__ unsigned xb_xcc_id() { return (unsigned)__builtin_amdgcn_s_getreg((3 << 11) | 20) & 0xFu; }
#define XB_SPIN(cond, bar) do { unsigned _sp = 0; while (cond) { __builtin_amdgcn_s_sleep(1); \
    if ((++_sp & 255u) == 0u) { if (xb_ld(&(bar)[XB_TMO])) break; if (_sp > XB_SPIN_CAP) { atomicAdd(&(bar)[XB_TMO], 1u); break; } } } } while (0)

struct XcdBarrier {
    unsigned* bar; unsigned x;
    volatile LAS unsigned* st;
};

__device__ __forceinline__ XcdBarrier xcd_barrier_post(unsigned* bar, volatile LAS unsigned* st) {
    XcdBarrier b; b.bar = bar; b.x = xb_xcc_id(); b.st = st;
    if (threadIdx.x == 0) (void)xb_add(&bar[XB_XCNT(b.x)], 1u);
    return b;
}
__device__ __forceinline__ void xcd_barrier_complete(unsigned* bar, unsigned x, unsigned& nloc, unsigned& nx) {
    const unsigned G = gridDim.x * gridDim.y * gridDim.z;
    unsigned sum, cnt, mine, sp = 0u;
    for (;;) {
        sum = 0u; cnt = 0u; mine = 0u;
#pragma unroll
        for (unsigned j = 0; j < 16; ++j) { const unsigned c = xb_ld(&bar[XB_XCNT(j)]); sum += c; cnt += (c > 0u) ? 1u : 0u; mine = (j == x) ? c : mine; }
        if (sum == G) break;
        __builtin_amdgcn_s_sleep(1);
        if ((++sp & 255u) == 0u) { if (xb_ld(&bar[XB_TMO])) break; if (sp > XB_SPIN_CAP) { atomicAdd(&bar[XB_TMO], 1u); break; } }
    }
    nloc = mine > 0u ? mine : 1u; nx = cnt > 0u ? cnt : 1u;
}

__device__ __forceinline__ void xcd_barrier(const XcdBarrier& b) {
    asm volatile("s_waitcnt vmcnt(0)" ::: "memory");
    __syncthreads();
    if (threadIdx.x == 0) {
        unsigned* bar = b.bar;
        __builtin_amdgcn_s_waitcnt(0);
        unsigned nloc = b.st[0], nx = b.st[1];
        if (nloc == 0u) { xcd_barrier_complete(bar, b.x, nloc, nx); b.st[0] = nloc; b.st[1] = nx; }
        const unsigned old = xb_add(&bar[XB_XSUB(b.x)], 1u);
        const unsigned gen = old / nloc;
        if (old + 1u == (gen + 1u) * nloc) {
            __builtin_amdgcn_fence(__ATOMIC_RELEASE, "agent");
            asm volatile("s_waitcnt vmcnt(0)" ::: "memory");
            const unsigned og = xb_add(&bar[XB_TOP], 1u);
            const unsigned tg = og / nx;
            if (og + 1u == (tg + 1u) * nx) xb_add(&bar[XB_TOPGEN], 1u);
            else XB_SPIN(xb_ld(&bar[XB_TOPGEN]) == tg, bar);
            __builtin_amdgcn_fence(__ATOMIC_ACQUIRE, "agent");
            xb_add(&bar[XB_XGEN(b.x)], 1u);
            asm volatile("s_waitcnt vmcnt(0)" ::: "memory");
        } else {
            XB_SPIN(xb_ld(&bar[XB_XGEN(b.x)]) == gen, bar);
            __builtin_amdgcn_fence(__ATOMIC_ACQUIRE, "agent");
            asm volatile("s_waitcnt vmcnt(0)" ::: "memory");
        }
    }
    __syncthreads();
}


constexpr int RSTD_OFF = 131072 + 1024;
DI void rstd_prepass(LAS unsigned char* lds, const pg8::StaticOrder& S, const float* ssq, int tid) {
    LAS float* tab = (LAS float*)(lds + RSTD_OFF);
    pg8::Unit u;
#pragma unroll 1
    for (int i = 0; i < 4 && S.next(i, u); ++i) {
        const int r = tid >> 1, hf = tid & 1;
        const f32x4* sp = (const f32x4*)(ssq + (size_t)(u.pm * 256 + r) * 16 + hf * 8);
        const f32x4 a = sp[0], b = sp[1];
        float t = ((a[0] + a[1]) + (a[2] + a[3])) + ((b[0] + b[1]) + (b[2] + b[3]));
        t += __shfl_xor(t, 1);
        if (hf == 0) tab[i * 256 + r] = 1.0f / sqrtf(t * (1.0f / 1024.0f) + EPS);
    }
    __syncthreads();
}

DI void rstd_prepass_lr(LAS unsigned char* lds, const pg8::StaticOrder& S, const float* ssq2, int g0, int nq4, float inv_width, int tid) {
    LAS float* tab = (LAS float*)(lds + RSTD_OFF);
    pg8::Unit u;
    if (S.next(0, u)) {
        if (tid < 256) {
            const f32x4* sp = (const f32x4*)(ssq2 + (size_t)(u.pm * 256 + tid) * 32 + g0);
            float t = 0.f;
            for (int i = 0; i < nq4; ++i) { const f32x4 a = sp[i]; t += (a[0] + a[1]) + (a[2] + a[3]); }
            tab[tid] = 1.0f / sqrtf(t * inv_width + EPS);
        }
    }
    __syncthreads();
}
struct Params {
    const float* x; const int* pos; const float* norm_mix; const float* norm_mlp; const float* norm_final;
    const float* w_in_ab; const float* b_forget; const float* rel_bias; const float* w_out_ab;
    const float* w_in_cd; const float* q_norm; const float* kv_norm; const float* w_uq; const float* w_ukv; const float* w_out_cd;
    const float* w_up; const float* w_down;
    float* out; unsigned char* ws; int ph_lo, ph_hi, coop, pad;
};
constexpr int N_PHASES = 17;

__global__ void __launch_bounds__(NTHREADS) fwd_kernel(Params P) {
    extern __shared__ __attribute__((aligned(16))) unsigned char lds_raw[];
    LAS unsigned char* lds = (LAS unsigned char*)lds_raw;
    const int tid = threadIdx.x, lane = tid & 63, wave = __builtin_amdgcn_readfirstlane(tid >> 6);
    const int G = gridDim.x, bx = blockIdx.x;
    const int vcu = (G % 8 == 0) ? (bx % 8) * (G / 8) + bx / 8 : bx;
    const int gw = vcu * NWAVES + wave, ngw = G * NWAVES;
    unsigned char* ws = P.ws;
    bf16_t* WinAB = (bf16_t*)(ws + WS_WINAB); bf16_t* WoutAB = (bf16_t*)(ws + WS_WOUTAB); bf16_t* WinCD = (bf16_t*)(ws + WS_WINCD);
    bf16_t* Wuq = (bf16_t*)(ws + WS_WUQ); bf16_t* Wukv = (bf16_t*)(ws + WS_WUKV); bf16_t* WoutCD = (bf16_t*)(ws + WS_WOUTCD);
    bf16_t* Wup0 = (bf16_t*)(ws + WS_WUP0); bf16_t* Wup1 = (bf16_t*)(ws + WS_WUP1); bf16_t* Wdn0 = (bf16_t*)(ws + WS_WDN0); bf16_t* Wdn1 = (bf16_t*)(ws + WS_WDN1);
    float* LOGF = (float*)(ws + WS_LOGF); float* CUM = (float*)(ws + WS_CUM); float* TAB = (float*)(ws + WS_TAB); bf16_t* KR = (bf16_t*)(ws + WS_KR); float* SSQ = (float*)(ws + WS_SSQ); float* SSQ2 = (float*)(ws + WS_SSQ2); unsigned* KN2 = (unsigned*)(ws + WS_CTL + CTL_KN2);
    bf16_t* XN = (bf16_t*)(ws + WS_XN); bf16_t* CQN = (bf16_t*)(ws + WS_CQN); bf16_t* CKVN = (bf16_t*)(ws + WS_CKVN); bf16_t* OB = (bf16_t*)(ws + WS_O);
    bf16_t* BIG = (bf16_t*)(ws + WS_BIG); bf16_t* QF = (bf16_t*)(ws + WS_QF); bf16_t* KVF = (bf16_t*)(ws + WS_KVF);
    cg::grid_group grid = cg::this_grid();
    volatile LAS unsigned* MISC = (volatile LAS unsigned*)(lds + MISC_OFF);
    if (tid < 32) MISC[tid] = 0u;
    __syncthreads();
    XcdBarrier bar; bar.bar = (unsigned*)(ws + WS_CTL); bar.x = 0; bar.st = nullptr;
    if (P.coop) bar = xcd_barrier_post((unsigned*)(ws + WS_CTL), MISC + 8);
    const int lo = P.ph_lo, hi = P.ph_hi;
#ifndef PHMASK
#define PHMASK 0x1ffff
#endif
#define IN(k) (((PHMASK >> (k)) & 1) && lo <= (k) && (k) < hi)
#ifndef REPMASK
#define REPMASK 0
#endif
#define REP(k) ((REPMASK >> (k)) & 1)
#ifndef REPKMASK
#define REPKMASK 0
#endif
#define REPK(k) ((REPKMASK >> (k)) & 1)
#define SEAM(k) do { if (P.coop && (k) + 1 < hi) { if (P.coop == 2) grid.sync(); else xcd_barrier(bar); } } while (0)

    if (IN(0)) {
        LAS float* scr = (LAS float*)(lds + wave * 8704);
        for (int it = gw; ; it += ngw) {
            int r = it; bool hit = false;
#define TR(W, K, LDN, C0, NC, WT, R0, GN) if (!hit) { const int n_it = ((K) / 64) * ((NC) / 32); if (r < n_it) { transpose_item((W), (K), (LDN), (C0), (WT), (R0), (NC) / 32, scr, r, lane, (GN)); hit = true; } else r -= n_it; }
            TR(P.w_in_ab, 1024, NSRC_AB, 0, 1536, WinAB, 0, nullptr)
            TR(P.w_in_ab, 1024, NSRC_AB, 1544, 1536, WinAB, 1536, nullptr)
            TR(P.w_out_ab, 1024, 1024, 0, 1024, WoutAB, 0, nullptr)
            TR(P.w_in_cd, 1024, NSRC_CD, 0, NSRC_CD, WinCD, 0, P.norm_mix + DM)
            TR(P.w_up, 1024, 4096, 0, 4096, Wup0, 0, P.norm_mlp)
            TR(P.w_down, 4096, 1024, 0, 1024, Wdn0, 0, nullptr)
#undef TR
            if (!hit) break;
        }
        for (int i = (vcu * NTHREADS + tid); i < 96 * 1024 / 8; i += G * NTHREADS) ((u32x4*)(WinCD + (size_t)2208 * 1024))[i] = (u32x4){0u, 0u, 0u, 0u};
        __syncthreads();
        LAS float* wfaT = (LAS float*)lds;
        for (int i = tid; i < 8192; i += NTHREADS) { const int k = i >> 3, j = i & 7; wfaT[j * 1024 + k] = P.w_in_ab[(size_t)k * NSRC_AB + 1536 + j]; }
        __syncthreads();
        norm_rows_bf16<true>(P.x, P.norm_mix, XN, gw, ngw, lane, wfaT, P.b_forget, LOGF, P.pos, TAB);
        __syncthreads();
        SEAM(0);
    }
    if (IN(1)) {
        if (vcu < 32) {
            const int b = vcu >> 3, h = vcu & 7; LAS float* sc = (LAS float*)lds;
            float v[8]; float run = 0.f;
#pragma unroll
            for (int e = 0; e < 8; ++e) { run += LOGF[((size_t)b * SEQ + tid * 8 + e) * 8 + h]; v[e] = run; }
            sc[tid] = run; __syncthreads();
            for (int off = 1; off < NTHREADS; off <<= 1) { const float add = (tid >= off) ? sc[tid - off] : 0.f; __syncthreads(); sc[tid] += add; __syncthreads(); }
            const float base = sc[tid] - run;
#pragma unroll
            for (int e = 0; e < 8; ++e) CUM[(size_t)(b * 8 + h) * SEQ + tid * 8 + e] = base + v[e];
            __syncthreads();
        }
        pg8::Gemm g{XN, WinAB, MT, LD_AB, DM}; pg8::StaticOrder S; S.init(MT, LD_AB, G, bx);
        pg8::EpiStoreAB E{BIG, LD_AB, KN2};
        pg8::gemm_phase<pg8::EpiStoreAB, pg8::StaticOrder, true, true>(lds, g, S, E);
        SEAM(1);
    }
    if (IN(2)) {
        const int bh = vcu >> 3, s = vcu & 7, b = bh >> 3, h = bh & 7;
        for (int rep = 0; rep <= REPK(2); ++rep) {
            att::fox_unit(lds, BIG, CUM, KN2, OB, b, h, 15 - s);
            att::fox_unit(lds, BIG, CUM, KN2, OB, b, h, s);
            att::chk_unit(lds, BIG, P.rel_bias, OB, b, h, 2 * s);
            att::chk_unit(lds, BIG, P.rel_bias, OB, b, h, 2 * s + 1);
        }
        SEAM(2);
    }
    if (IN(3)) {
        pg8::Gemm g{OB, WoutAB, MT, DM, DM}; pg8::StaticOrder S; S.init(MT, DM, G, bx);
        pg8::EpiResidN E{P.x, P.out, XN, SSQ, DM};
        pg8::gemm_phase<pg8::EpiResidN, pg8::StaticOrder, true, true>(lds, g, S, E);
        SEAM(3);
    }
    if (IN(5)) {
        pg8::Gemm g{XN, Wup0, MT, DFF, DM}; pg8::StaticOrder S; S.init(MT, DFF, G, bx);
        rstd_prepass(lds, S, SSQ, tid);
        pg8::EpiStore<1, 1> E{BIG, DFF, (const LAS float*)(lds + RSTD_OFF), 0};
        pg8::gemm_phase<pg8::EpiStore<1, 1>, pg8::StaticOrder, true, true>(lds, g, S, E);
        SEAM(5);
    }
    if (IN(6)) {
        pg8::Gemm g{BIG, Wdn0, MT, DM, DFF}; pg8::StaticOrder S; S.init(MT, DM, G, bx);
        pg8::EpiResidN E{P.out, P.out, XN, SSQ, DM};
        pg8::gemm_phase<pg8::EpiResidN, pg8::StaticOrder, true, true>(lds, g, S, E);
        SEAM(6);
    }
    if (IN(8)) {
        pg8::Gemm g{XN, WinCD, MT, LD_CD, DM}; pg8::StaticOrder S; S.init(MT, LD_CD, G, bx);
        rstd_prepass(lds, S, SSQ, tid);
        pg8::EpiStoreCD E{BIG, LD_CD, (const LAS float*)(lds + RSTD_OFF), SSQ2, KR, TAB, 0};
        pg8::gemm_phase<pg8::EpiStoreCD, pg8::StaticOrder, true, true>(lds, g, S, E);
        if (G == 256 ? bx >= 64 : true) {
            const int nidle = (G == 256) ? 192 : G, iw = ((G == 256) ? bx - 64 : bx) * NWAVES + wave;
            LAS float* scr = (LAS float*)(lds + wave * 8704);
            for (int it = iw; ; it += nidle * NWAVES) {
                int r = it; bool hit = false;
#define TR(W, K, LDN, C0, NC, WT, R0, GN) if (!hit) { const int n_it = ((K) / 64) * ((NC) / 32); if (r < n_it) { transpose_item((W), (K), (LDN), (C0), (WT), (R0), (NC) / 32, scr, r, lane, (GN)); hit = true; } else r -= n_it; }
                TR(P.w_uq, 384, 768, 0, 768, Wuq, 0, P.q_norm)
                TR(P.w_ukv, 256, 1024, 0, 1024, Wukv, 0, P.kv_norm)
                TR(P.w_out_cd, 1024, 1024, 0, 1024, WoutCD, 0, nullptr)
                TR(P.w_up + (size_t)1024 * 4096, 1024, 4096, 0, 4096, Wup1, 0, P.norm_mlp + DM)
                TR(P.w_down + (size_t)4096 * 1024, 4096, 1024, 0, 1024, Wdn1, 0, nullptr)
#undef TR
                if (!hit) break;
            }
        }
        SEAM(8);
    }
    if (IN(10)) {
#ifndef P10SEL
#define P10SEL 3
#endif
        { pg8::Gemm g{BIG + 1536, Wuq, MT, 768, 384 + P.pad, LD_CD};
          pg8::StaticOrder S; S.init(MT, 768, G, bx);
          rstd_prepass_lr(lds, S, SSQ2, 0, 3, 1.0f / 384.0f, tid);
          pg8::EpiQRope E{QF, 768, TAB, (const LAS float*)(lds + RSTD_OFF)};
          pg8::gemm_phase<pg8::EpiQRope, pg8::StaticOrder, true, true>(lds, g, S, E); }
        { pg8::Gemm g{BIG + 1920, Wukv, MT, 1024, 256 + P.pad, LD_CD}; pg8::StaticOrder S; S.init(MT, 1024, G, bx);
          rstd_prepass_lr(lds, S, SSQ2, 12, 2, 1.0f / 256.0f, tid);
          pg8::EpiStore<0, 1> E{KVF, 1024, (const LAS float*)(lds + RSTD_OFF), 0};
          pg8::gemm_phase<pg8::EpiStore<0, 1>, pg8::StaticOrder, true, true>(lds, g, S, E); }
        SEAM(10);
    }
    if (IN(11)) {
        const int bh = vcu >> 3, s = vcu & 7, b = bh >> 3, h = bh & 7;
        for (int rep = 0; rep <= REPK(11); ++rep) {
            att::mla_unit(lds, QF, KVF, KR, OB, b, h, 15 - s);
            att::mla_unit(lds, QF, KVF, KR, OB, b, h, s);
            att::sb_unit(lds, BIG, OB, b, h, 15 - s);
            att::sb_unit(lds, BIG, OB, b, h, s);
        }
        SEAM(11);
    }
    if (IN(12)) {
        pg8::Gemm g{OB, WoutCD, MT, DM, DM}; pg8::StaticOrder S; S.init(MT, DM, G, bx);
        pg8::EpiResidN E{P.out, P.out, XN, SSQ, DM};
        pg8::gemm_phase<pg8::EpiResidN, pg8::StaticOrder, true, true>(lds, g, S, E);
        SEAM(12);
    }
    if (IN(14)) {
        pg8::Gemm g{XN, Wup1, MT, DFF, DM}; pg8::StaticOrder S; S.init(MT, DFF, G, bx);
        rstd_prepass(lds, S, SSQ, tid);
        pg8::EpiStore<1, 1> E{BIG, DFF, (const LAS float*)(lds + RSTD_OFF), 0};
        pg8::gemm_phase<pg8::EpiStore<1, 1>, pg8::StaticOrder, true, true>(lds, g, S, E);
        SEAM(14);
    }
    if (IN(15)) {
        pg8::Gemm g{BIG, Wdn1, MT, DM, DFF}; pg8::StaticOrder S; S.init(MT, DM, G, bx);
        pg8::EpiResid E{P.out, P.out, DM};
        pg8::gemm_phase<pg8::EpiResid, pg8::StaticOrder, true, true>(lds, g, S, E);
        SEAM(15);
    }
    if (IN(16)) { norm_rows_f32(P.out, P.norm_final, gw, ngw, lane); }
#undef IN
#undef SEAM
}

#ifndef MK_MULTI_LAUNCH
#define MK_MULTI_LAUNCH 0
#endif
extern "C" void kernel_launch(void* const* d_in, const int* in_sizes, int n_in, void* d_out, int out_size, void* d_ws, size_t ws_size, hipStream_t stream) {
    static int grid = 0;
    if (grid == 0) {
        if (n_in != 17 || out_size != MT * DM || ws_size < WS_END) { fprintf(stderr, "kernel_launch: unexpected problem (n_in %d out %d ws %zu)\n", n_in, out_size, ws_size); grid = -1; return; }
        int dev = 0, cus = 0, per_cu = 0;
        hipGetDevice(&dev); hipDeviceGetAttribute(&cus, hipDeviceAttributeMultiprocessorCount, dev);
        if (hipFuncSetAttribute((const void*)fwd_kernel, hipFuncAttributeMaxDynamicSharedMemorySize, LDS_BYTES) != hipSuccess) { fprintf(stderr, "kernel_launch: hipFuncSetAttribute failed\n"); grid = -1; return; }
        if (hipOccupancyMaxActiveBlocksPerMultiprocessor(&per_cu, (const void*)fwd_kernel, NTHREADS, LDS_BYTES) != hipSuccess || per_cu < 1) { fprintf(stderr, "kernel_launch: occupancy query says %d\n", per_cu); per_cu = 1; }
        (void)hipGetLastError();
        grid = cus;
        if (grid != 256) fprintf(stderr, "kernel_launch: note: %d CUs\n", grid);
    }
    if (grid < 0) return;
    Params p{};
    p.x = (const float*)d_in[0]; p.pos = (const int*)d_in[1]; p.norm_mix = (const float*)d_in[2]; p.norm_mlp = (const float*)d_in[3]; p.norm_final = (const float*)d_in[4];
    p.w_in_ab = (const float*)d_in[5]; p.b_forget = (const float*)d_in[6]; p.rel_bias = (const float*)d_in[7]; p.w_out_ab = (const float*)d_in[8];
    p.w_in_cd = (const float*)d_in[9]; p.q_norm = (const float*)d_in[10]; p.kv_norm = (const float*)d_in[11]; p.w_uq = (const float*)d_in[12]; p.w_ukv = (const float*)d_in[13]; p.w_out_cd = (const float*)d_in[14];
    p.w_up = (const float*)d_in[15]; p.w_down = (const float*)d_in[16];
    p.out = (float*)d_out; p.ws = (unsigned char*)d_ws;
    if (hipMemsetAsync((char*)d_ws + WS_CTL, 0, CTL_BYTES, stream) != hipSuccess) { fprintf(stderr, "kernel_launch: hipMemsetAsync failed\n"); return; }
#if MK_MULTI_LAUNCH
    for (int ph = 0; ph < N_PHASES; ++ph) {
        p.ph_lo = ph; p.ph_hi = ph + 1; p.coop = 0;
        hipLaunchKernelGGL(fwd_kernel, dim3(grid), dim3(NTHREADS), LDS_BYTES, stream, p);
        if (REP(ph)) hipLaunchKernelGGL(fwd_kernel, dim3(grid), dim3(NTHREADS), LDS_BYTES, stream, p);
    }
#else
    p.ph_lo = 0; p.ph_hi = N_PHASES; p.coop = 1;
    void* args[] = {&p};
    hipError_t e = hipLaunchCooperativeKernel((const void*)fwd_kernel, dim3(grid), dim3(NTHREADS), args, LDS_BYTES, stream);
    if (e != hipSuccess) fprintf(stderr, "cooperative launch failed: %s (grid %d)\n", hipGetErrorString(e), grid);
#endif
}
```

```cpp
#include <hip/hip_runtime.h>
#include <hip/hip_cooperative_groups.h>
#include <cstdio>
#include <cstdint>
#include <cmath>
namespace cg = cooperative_groups;
namespace pg8 {
#define PG8_LAS __attribute__((address_space(3)))
typedef unsigned short bf16_t;
typedef short bf16x8 __attribute__((ext_vector_type(8)));
typedef float f32x4 __attribute__((ext_vector_type(4)));
typedef unsigned u32x4 __attribute__((ext_vector_type(4)));
constexpr int BM = 256, BK = 64, HALF = 128, HTB = HALF * BK * 2  , STAGE_BYTES = 8 * HTB, NXCD = 8, WGM = 8;

__host__ __device__ __forceinline__ int lds_byte(int r, int c) { const int st = (r >> 4) * 2 + (c >> 5), rr = r & 15, cc = c & 31, ob = rr * 64 + cc * 2; return st * 1024 + (ob ^ (((ob >> 9) & 1) << 5)); }
__host__ __device__ __forceinline__ void stage_rc(int b, int& R, int& C) { const int st = b / 1024, sb = b % 1024, swz = sb ^ (((sb >> 9) & 1) << 5); R = (st >> 1) * 16 + swz / 64; C = (st & 1) * 32 + (swz % 64) / 2; }
__host__ __device__ __forceinline__ int perm32(int rho) { const int n = rho >> 4, i = rho & 15; return 8 * (i >> 2) + 4 * n + (i & 3); }

struct Unit { int pm, pn; };
struct Gemm { const bf16_t* A; const bf16_t* Bt; int M, N, K; int lda; };

struct StaticOrder {
    int nM, nN, nwg, G, c;
    __host__ __device__ void init(int M, int N, int G_, int c_) { nM = M / BM; nN = N / BM; nwg = nM * nN; G = G_; c = c_; }
    __host__ __device__ bool next(int i, Unit& u) const {
        const long L = (long)i * G + c; if (L >= nwg) return false;
        int wgid = (int)L; { const int q = nwg / NXCD, r = nwg % NXCD, xcd = wgid % NXCD, off = wgid / NXCD; wgid = (xcd < r ? xcd * (q + 1) : r * (q + 1) + (xcd - r) * q) + off; }
        const int nig = WGM * nN, gid = wgid / nig, fm = gid * WGM, gsz = (nM - fm) < WGM ? (nM - fm) : WGM;
        u.pm = fm + ((wgid % nig) % gsz); u.pn = (wgid % nig) / gsz; return true;
    }
    __device__ __forceinline__ void a_ready(const Unit&) const {}
    __device__ __forceinline__ void done(const Unit&) const {}
};

__device__ __forceinline__ unsigned cvt_pk_bf16(float lo, float hi) { unsigned r; asm volatile("v_cvt_pk_bf16_f32 %0, %1, %2" : "=v"(r) : "v"(lo), "v"(hi)); return r; }
template <class Epi, class Sched, bool ALIGN_EPI = false, bool SP2 = false>
__device__ __forceinline__ void gemm_phase(PG8_LAS unsigned char* lds, const Gemm g, const Sched& S, const Epi& E) {
    const int tid = threadIdx.x, wid = __builtin_amdgcn_readfirstlane(tid >> 6), lane = tid & 63, wr = wid >> 2, wc = wid & 3, fr = lane & 15, fq = lane >> 4;
    const int K = g.K, nt = K / BK, LDA = g.lda ? g.lda : g.K;
    unsigned voffA[2], voffB[2];
#pragma unroll
    for (int i = 0; i < 2; ++i) { int R, C; stage_rc(tid * 16 + i * 8192, R, C); const int Rb = Epi::PERM ? ((R & ~31) + perm32(R & 31)) : R;
        voffA[i] = (unsigned)(R * LDA + C) * 2u; voffB[i] = (unsigned)(Rb * K + C) * 2u; }
    const size_t kstep = (size_t)(BK * 2);
    const size_t hstepB = (size_t)HALF * K * 2, hstepA = (size_t)HALF * LDA * 2;
    const size_t tstepB = 2 * hstepB, tstepA = 2 * hstepA;
    const unsigned ldsw = (unsigned)wid * 1024u;
    const int aoff = lds_byte(wr * 64 + fr, fq * 8), boff = lds_byte(wc * 32 + fr, fq * 8);
#define PG8_SA(b, h) (((b) * 2 + (h)) * HTB)
#define PG8_SB(b, h) ((4 + (b) * 2 + (h)) * HTB)
#define PG8_STAGE(bufoff, gbase, voff) do { _Pragma("unroll") for (int _i = 0; _i < 2; ++_i) \
        __builtin_amdgcn_global_load_lds((const unsigned*)((const char*)(gbase) + (voff)[_i]), (PG8_LAS unsigned*)(lds + (bufoff) + ldsw + _i * 8192), 16, 0, 0); } while (0)
#define PG8_LDA(dst, b, h) do { _Pragma("unroll") for (int m = 0; m < 4; ++m) _Pragma("unroll") for (int k = 0; k < 2; ++k) dst[m][k] = *(const PG8_LAS bf16x8*)(lds + PG8_SA(b, h) + aoff + m * 2048 + k * 1024); } while (0)
#define PG8_LDB(dst, b, h) do { _Pragma("unroll") for (int n = 0; n < 2; ++n) _Pragma("unroll") for (int k = 0; k < 2; ++k) dst[n][k] = *(const PG8_LAS bf16x8*)(lds + PG8_SB(b, h) + boff + n * 2048 + k * 1024); } while (0)
#define PG8_MMA(ai, bj, At, Bt) do { __builtin_amdgcn_s_setprio(1); _Pragma("unroll") for (int m = 0; m < 4; ++m) _Pragma("unroll") for (int n = 0; n < 2; ++n) _Pragma("unroll") for (int k = 0; k < 2; ++k) \
        acc[ai][bj][m][n] = __builtin_amdgcn_mfma_f32_16x16x32_bf16(Bt[n][k], At[m][k], acc[ai][bj][m][n], 0, 0, 0); __builtin_amdgcn_s_setprio(0); } while (0)
#define PG8_WAIT_V(n) asm volatile("s_waitcnt vmcnt(" #n ")" ::: "memory")
#define PG8_WAIT_L(n) asm volatile("s_waitcnt lgkmcnt(" #n ")" ::: "memory")
#define PG8_BAR __builtin_amdgcn_s_barrier()
#define PG8_SCHED __builtin_amdgcn_sched_barrier(0)
    Unit cur, nxt; int ui = 0;
    if (!S.next(0, cur)) return;
    f32x4 acc[2][2][4][2];
#pragma unroll
    for (int a = 0; a < 2; ++a)
#pragma unroll
        for (int b = 0; b < 2; ++b)
#pragma unroll
            for (int m = 0; m < 4; ++m)
#pragma unroll
                for (int n = 0; n < 2; ++n) acc[a][b][m][n] = (f32x4){0.f, 0.f, 0.f, 0.f};
    bf16x8 At[4][2], B0[2][2], B1[2][2];
    const char* cA = (const char*)g.A + (size_t)cur.pm * tstepA; const char* cB = (const char*)g.Bt + (size_t)cur.pn * tstepB;
    S.a_ready(cur);
    if constexpr (SP2) {
        PG8_STAGE(PG8_SB(0, 0), cB, voffB); PG8_STAGE(PG8_SB(0, 1), cB + hstepB, voffB); PG8_STAGE(PG8_SA(0, 0), cA, voffA); PG8_STAGE(PG8_SA(0, 1), cA + hstepA, voffA);
        if (wr == 1) PG8_BAR;
        PG8_WAIT_V(2); PG8_BAR;
        PG8_STAGE(PG8_SB(1, 0), cB + kstep, voffB); PG8_STAGE(PG8_SA(1, 0), cA + kstep, voffA); PG8_STAGE(PG8_SB(1, 1), cB + hstepB + kstep, voffB);
        PG8_WAIT_V(6); PG8_BAR;
    } else {
        PG8_STAGE(PG8_SB(0, 0), cB, voffB); PG8_STAGE(PG8_SA(0, 0), cA, voffA); PG8_STAGE(PG8_SB(0, 1), cB + hstepB, voffB); PG8_STAGE(PG8_SA(0, 1), cA + hstepA, voffA);
        if (wr == 1) PG8_BAR;
        PG8_WAIT_V(4); PG8_BAR;
        PG8_STAGE(PG8_SB(1, 0), cB + kstep, voffB); PG8_STAGE(PG8_SA(1, 0), cA + kstep, voffA); PG8_STAGE(PG8_SB(1, 1), cB + hstepB + kstep, voffB);
        PG8_WAIT_V(6); PG8_BAR;
    }
    for (;;) {
        const bool has_next = S.next(ui + 1, nxt);
        const char* nA = has_next ? (const char*)g.A + (size_t)nxt.pm * tstepA : cA; const char* nB = has_next ? (const char*)g.Bt + (size_t)nxt.pn * tstepB : cB;
        for (int t = 0; t < nt; t += 2) {
            const bool last = (t == nt - 2);
            const char* a1 = cA + (size_t)(t + 1) * kstep;
            const char* a2 = last ? nA : cA + (size_t)(t + 2) * kstep; const char* b2 = last ? nB : cB + (size_t)(t + 2) * kstep;
            const char* a3 = a2 + kstep; const char* b3 = b2 + kstep;
            if (last && has_next) S.a_ready(nxt);
            if constexpr (SP2) {
            PG8_LDB(B0, 0, 0); PG8_LDB(B1, 0, 1); PG8_SCHED; PG8_LDA(At, 0, 0); PG8_STAGE(PG8_SA(1, 1), a1 + hstepA, voffA);
            PG8_WAIT_V(8); PG8_WAIT_L(0); PG8_BAR; PG8_MMA(0, 0, At, B0); PG8_MMA(0, 1, At, B1); PG8_BAR; PG8_SCHED;
            PG8_LDA(At, 0, 1); PG8_STAGE(PG8_SB(0, 0), b2, voffB); PG8_STAGE(PG8_SB(0, 1), b2 + hstepB, voffB); PG8_STAGE(PG8_SA(0, 0), a2, voffA);
            PG8_WAIT_V(8); PG8_WAIT_L(0); PG8_BAR; PG8_MMA(1, 0, At, B0); PG8_MMA(1, 1, At, B1); PG8_BAR; PG8_SCHED;
            PG8_LDB(B0, 1, 0); PG8_LDB(B1, 1, 1); PG8_SCHED; PG8_LDA(At, 1, 0); PG8_STAGE(PG8_SA(0, 1), a2 + hstepA, voffA);
            PG8_WAIT_V(8); PG8_WAIT_L(0); PG8_BAR; PG8_MMA(0, 0, At, B0); PG8_MMA(0, 1, At, B1); PG8_BAR; PG8_SCHED;
            PG8_LDA(At, 1, 1); PG8_STAGE(PG8_SB(1, 0), b3, voffB); PG8_STAGE(PG8_SB(1, 1), b3 + hstepB, voffB); PG8_STAGE(PG8_SA(1, 0), a3, voffA);
            PG8_WAIT_V(8); PG8_WAIT_L(0); PG8_BAR; PG8_MMA(1, 0, At, B0); PG8_MMA(1, 1, At, B1); PG8_BAR; PG8_SCHED;
            } else {
            PG8_LDB(B0, 0, 0); PG8_SCHED; PG8_LDA(At, 0, 0); PG8_STAGE(PG8_SA(1, 1), a1 + hstepA, voffA);
            PG8_WAIT_L(8); PG8_BAR; PG8_WAIT_L(0); PG8_MMA(0, 0, At, B0); PG8_BAR; PG8_SCHED;
            PG8_LDB(B1, 0, 1); PG8_STAGE(PG8_SB(0, 0), b2, voffB);
            PG8_BAR; PG8_WAIT_L(0); PG8_MMA(0, 1, At, B1); PG8_BAR;
            PG8_LDA(At, 0, 1); PG8_STAGE(PG8_SA(0, 0), a2, voffA);
            PG8_BAR; PG8_WAIT_L(0); PG8_MMA(1, 0, At, B0); PG8_BAR; PG8_SCHED;
            PG8_STAGE(PG8_SB(0, 1), b2 + hstepB, voffB);
            PG8_WAIT_V(6); PG8_BAR; PG8_MMA(1, 1, At, B1); PG8_BAR;
            PG8_LDB(B0, 1, 0); PG8_SCHED; PG8_LDA(At, 1, 0); PG8_STAGE(PG8_SA(0, 1), a2 + hstepA, voffA);
            PG8_WAIT_L(8); PG8_BAR; PG8_WAIT_L(0); PG8_MMA(0, 0, At, B0); PG8_BAR; PG8_SCHED;
            PG8_LDB(B1, 1, 1); PG8_STAGE(PG8_SB(1, 0), b3, voffB);
            PG8_BAR; PG8_WAIT_L(0); PG8_MMA(0, 1, At, B1); PG8_BAR;
            PG8_LDA(At, 1, 1); PG8_STAGE(PG8_SA(1, 0), a3, voffA);
            PG8_BAR; PG8_WAIT_L(0); PG8_MMA(1, 0, At, B0); PG8_BAR; PG8_SCHED;
            PG8_STAGE(PG8_SB(1, 1), b3 + hstepB, voffB);
            PG8_WAIT_V(6); PG8_BAR; PG8_MMA(1, 1, At, B1); PG8_BAR;
            }
        }
        if constexpr (ALIGN_EPI) { if (wr == 0) PG8_BAR; }
        if constexpr (!Epi::AFTER_DRAIN) { E(acc, cur, wr, wc, fr, fq); S.done(cur); }
        if (!has_next) break;
#pragma unroll
        for (int a = 0; a < 2; ++a)
#pragma unroll
            for (int b = 0; b < 2; ++b)
#pragma unroll
                for (int m = 0; m < 4; ++m)
#pragma unroll
                    for (int n = 0; n < 2; ++n) acc[a][b][m][n] = (f32x4){0.f, 0.f, 0.f, 0.f};
        cur = nxt; cA = nA; cB = nB; ++ui;
        if constexpr (ALIGN_EPI) { if (wr == 1) PG8_BAR; }
    }
    PG8_WAIT_V(0);
    if constexpr (!ALIGN_EPI) { if (wr == 0) PG8_BAR; }
    PG8_BAR;
    if constexpr (Epi::AFTER_DRAIN) { E.fused(acc, cur, wr, wc, fr, fq, lds, wid, lane); S.done(cur); }
#undef PG8_SA
#undef PG8_SB
#undef PG8_STAGE
#undef PG8_LDA
#undef PG8_LDB
#undef PG8_MMA
#undef PG8_WAIT_V
#undef PG8_WAIT_L
#undef PG8_BAR
#undef PG8_SCHED
}
}

namespace pg8 {
template <int RELU2, int SCALE = 0> struct EpiStore {
    static constexpr bool PERM = true, AFTER_DRAIN = false;
    bf16_t* O; int ldc; const PG8_LAS float* rstd; mutable int cnt;
    __device__ __forceinline__ void operator()(const f32x4 (&acc)[2][2][4][2], const Unit& u, int wr, int wc, int fr, int fq) const {
        const int row0 = u.pm * BM + wr * 64 + fr, col0 = u.pn * BM + wc * 32 + 8 * fq;
#pragma unroll
        for (int ai = 0; ai < 2; ++ai)
#pragma unroll
            for (int m = 0; m < 4; ++m) { const int row = row0 + ai * HALF + m * 16; bf16_t* rowp = O + (size_t)row * ldc + col0;
                float rs = 1.f;
                if (SCALE) rs = rstd[cnt * 256 + wr * 64 + fr + ai * HALF + m * 16];
#pragma unroll
                for (int bj = 0; bj < 2; ++bj) { f32x4 v0 = acc[ai][bj][m][0] * rs, v1 = acc[ai][bj][m][1] * rs;
                    if (RELU2) {
#pragma unroll
                        for (int e = 0; e < 4; ++e) { const float a = fmaxf(v0[e], 0.f), b = fmaxf(v1[e], 0.f); v0[e] = a * a; v1[e] = b * b; } }
                    u32x4 w; w.x = cvt_pk_bf16(v0[0], v0[1]); w.y = cvt_pk_bf16(v0[2], v0[3]); w.z = cvt_pk_bf16(v1[0], v1[1]); w.w = cvt_pk_bf16(v1[2], v1[3]);
                    *(u32x4*)(rowp + bj * HALF) = w; } }
        if (SCALE) ++cnt;
    }
};

struct EpiStoreAB {
    static constexpr bool PERM = true, AFTER_DRAIN = false;
    bf16_t* O; int ldc; unsigned* kn2;
    __device__ __forceinline__ void operator()(const f32x4 (&acc)[2][2][4][2], const Unit& u, int wr, int wc, int fr, int fq) const {
        const int row0 = u.pm * BM + wr * 64 + fr, col0 = u.pn * BM + wc * 32 + 8 * fq;
#pragma unroll
        for (int ai = 0; ai < 2; ++ai)
#pragma unroll
            for (int m = 0; m < 4; ++m) { bf16_t* rowp = O + (size_t)(row0 + ai * HALF + m * 16) * ldc + col0;
#pragma unroll
                for (int bj = 0; bj < 2; ++bj) { const f32x4 v0 = acc[ai][bj][m][0], v1 = acc[ai][bj][m][1];
                    u32x4 w; w.x = cvt_pk_bf16(v0[0], v0[1]); w.y = cvt_pk_bf16(v0[2], v0[3]); w.z = cvt_pk_bf16(v1[0], v1[1]); w.w = cvt_pk_bf16(v1[2], v1[3]);
                    *(u32x4*)(rowp + bj * HALF) = w; } }
        if (u.pn == 2 || u.pn == 3) {
#pragma unroll
            for (int bj = 0; bj < 2; ++bj) { float mx = 0.f;
#pragma unroll
                for (int ai = 0; ai < 2; ++ai)
#pragma unroll
                    for (int m = 0; m < 4; ++m) { const f32x4 v0 = acc[ai][bj][m][0], v1 = acc[ai][bj][m][1];
                        float s = ((v0[0] * v0[0] + v0[1] * v0[1]) + (v0[2] * v0[2] + v0[3] * v0[3])) + ((v1[0] * v1[0] + v1[1] * v1[1]) + (v1[2] * v1[2] + v1[3] * v1[3]));
                        s += __shfl_xor(s, 16); s += __shfl_xor(s, 32); mx = fmaxf(mx, s); }
                mx = fmaxf(mx, __shfl_xor(mx, 1)); mx = fmaxf(mx, __shfl_xor(mx, 2)); mx = fmaxf(mx, __shfl_xor(mx, 4)); mx = fmaxf(mx, __shfl_xor(mx, 8));
                const int colb = u.pn * BM + bj * HALF + wc * 32 - 512, head = colb >> 6, half = (colb >> 5) & 1, b = u.pm >> 4;
                if (fr == 0 && fq == 0) atomicMax(kn2 + ((b * 8 + head) * 2 + half), __float_as_uint(mx * 1.02f)); }
        }
    }
};

struct EpiStoreCD {
    static constexpr bool PERM = true, AFTER_DRAIN = false;
    bf16_t* O; int ldc; const PG8_LAS float* rstd; float* ssq2; bf16_t* kr; const float* tab; mutable int cnt;
    __device__ __forceinline__ void operator()(const f32x4 (&acc)[2][2][4][2], const Unit& u, int wr, int wc, int fr, int fq) const {
        const int row0 = u.pm * BM + wr * 64 + fr, col0 = u.pn * BM + wc * 32 + 8 * fq;
#pragma unroll
        for (int ai = 0; ai < 2; ++ai)
#pragma unroll
            for (int m = 0; m < 4; ++m) { const int row = row0 + ai * HALF + m * 16; bf16_t* rowp = O + (size_t)row * ldc + col0;
                const float rs = rstd[cnt * 256 + wr * 64 + fr + ai * HALF + m * 16];
#pragma unroll
                for (int bj = 0; bj < 2; ++bj) { const f32x4 v0 = acc[ai][bj][m][0] * rs, v1 = acc[ai][bj][m][1] * rs;
                    u32x4 w; w.x = cvt_pk_bf16(v0[0], v0[1]); w.y = cvt_pk_bf16(v0[2], v0[3]); w.z = cvt_pk_bf16(v1[0], v1[1]); w.w = cvt_pk_bf16(v1[2], v1[3]);
                    *(u32x4*)(rowp + bj * HALF) = w;
                    const int cgp = u.pn * BM + bj * HALF + wc * 32;
                    if (cgp >= 1536 && cgp < 2176) {
                        float s = ((v0[0] * v0[0] + v0[1] * v0[1]) + (v0[2] * v0[2] + v0[3] * v0[3])) + ((v1[0] * v1[0] + v1[1] * v1[1]) + (v1[2] * v1[2] + v1[3] * v1[3]));
                        s += __shfl_xor(s, 16); s += __shfl_xor(s, 32);
                        if (fq == 0) ssq2[(size_t)row * 32 + ((cgp - 1536) >> 5)] = s;
                    } else if (cgp == 2176) {
                        const int i0 = 8 * (fq & 1);
                        const f32x4 c0 = *(const f32x4*)(tab + (size_t)row * 32 + i0), c1 = *(const f32x4*)(tab + (size_t)row * 32 + i0 + 4);
                        const f32x4 s0 = *(const f32x4*)(tab + (size_t)row * 32 + 16 + i0), s1 = *(const f32x4*)(tab + (size_t)row * 32 + 16 + i0 + 4);
                        f32x4 p0, p1;
#pragma unroll
                        for (int e = 0; e < 4; ++e) { p0[e] = __shfl_xor(v0[e], 32); p1[e] = __shfl_xor(v1[e], 32); }
                        f32x4 o0, o1;
                        if (fq < 2) { o0 = v0 * c0 - p0 * s0; o1 = v1 * c1 - p1 * s1; }
                        else        { o0 = v0 * c0 + p0 * s0; o1 = v1 * c1 + p1 * s1; }
                        u32x4 k; k.x = cvt_pk_bf16(o0[0], o0[1]); k.y = cvt_pk_bf16(o0[2], o0[3]); k.z = cvt_pk_bf16(o1[0], o1[1]); k.w = cvt_pk_bf16(o1[2], o1[3]);
                        *(u32x4*)(kr + (size_t)row * 32 + 8 * fq) = k;
                    } } }
        ++cnt;
    }
};
struct EpiResid {
    static constexpr bool PERM = false, AFTER_DRAIN = false;
    const float* base; float* out; int ldc;
    __device__ __forceinline__ void operator()(const f32x4 (&acc)[2][2][4][2], const Unit& u, int wr, int wc, int fr, int fq) const {
        const int row0 = u.pm * BM + wr * 64 + fr, col0 = u.pn * BM + wc * 32 + 4 * fq;
#pragma unroll
        for (int ai = 0; ai < 2; ++ai)
#pragma unroll
            for (int m = 0; m < 4; ++m) { const size_t off = (size_t)(row0 + ai * HALF + m * 16) * ldc + col0;
#pragma unroll
                for (int bj = 0; bj < 2; ++bj)
#pragma unroll
                    for (int n = 0; n < 2; ++n) { const size_t o = off + bj * HALF + n * 16; const f32x4 bs = *(const f32x4*)(base + o); *(f32x4*)(out + o) = bs + acc[ai][bj][m][n]; } }
    }
};

struct EpiResidN {
    static constexpr bool PERM = false, AFTER_DRAIN = false;
    const float* base; float* out; bf16_t* xn; float* ssq; int ldc;
    __device__ __forceinline__ void operator()(const f32x4 (&acc)[2][2][4][2], const Unit& u, int wr, int wc, int fr, int fq) const {
        typedef unsigned u32x2 __attribute__((ext_vector_type(2)));
        const int row0 = u.pm * BM + wr * 64 + fr, col0 = u.pn * BM + wc * 32 + 4 * fq;
#pragma unroll
        for (int ai = 0; ai < 2; ++ai)
#pragma unroll
            for (int m = 0; m < 4; ++m) { const int row = row0 + ai * HALF + m * 16; const size_t off = (size_t)row * ldc + col0; float s = 0.f;
#pragma unroll
                for (int bj = 0; bj < 2; ++bj)
#pragma unroll
                    for (int n = 0; n < 2; ++n) { const size_t o = off + bj * HALF + n * 16; const f32x4 v = *(const f32x4*)(base + o) + acc[ai][bj][m][n]; *(f32x4*)(out + o) = v;
                        u32x2 w; w.x = cvt_pk_bf16(v[0], v[1]); w.y = cvt_pk_bf16(v[2], v[3]); *(u32x2*)(xn + o) = w;
                        s += (v[0] * v[0] + v[1] * v[1]) + (v[2] * v[2] + v[3] * v[3]); }
                s += __shfl_xor(s, 16); s += __shfl_xor(s, 32);
                if (fq == 0) ssq[(size_t)row * 16 + u.pn * 4 + wc] = s; }
    }
};

template <int BASEF32> struct EpiResidB {
    static constexpr bool PERM = true, AFTER_DRAIN = false;
    const float* basef; bf16_t* xn; float* ssq; int ldc;
    __device__ __forceinline__ void operator()(const f32x4 (&acc)[2][2][4][2], const Unit& u, int wr, int wc, int fr, int fq) const {
        const int row0 = u.pm * BM + wr * 64 + fr, col0 = u.pn * BM + wc * 32 + 8 * fq;
#pragma unroll
        for (int ai = 0; ai < 2; ++ai)
#pragma unroll
            for (int m = 0; m < 4; ++m) { const int row = row0 + ai * HALF + m * 16; const size_t off = (size_t)row * ldc + col0; float s = 0.f;
#pragma unroll
                for (int bj = 0; bj < 2; ++bj) { const size_t o = off + bj * HALF; f32x4 b0, b1;
                    if (BASEF32) { b0 = *(const f32x4*)(basef + o); b1 = *(const f32x4*)(basef + o + 4); }
                    else { const u32x4 w = *(const u32x4*)(xn + o);
                        b0[0] = __uint_as_float(w.x << 16); b0[1] = __uint_as_float(w.x & 0xffff0000u); b0[2] = __uint_as_float(w.y << 16); b0[3] = __uint_as_float(w.y & 0xffff0000u);
                        b1[0] = __uint_as_float(w.z << 16); b1[1] = __uint_as_float(w.z & 0xffff0000u); b1[2] = __uint_as_float(w.w << 16); b1[3] = __uint_as_float(w.w & 0xffff0000u); }
                    const f32x4 v0 = acc[ai][bj][m][0] + b0, v1 = acc[ai][bj][m][1] + b1;
                    u32x4 w; w.x = cvt_pk_bf16(v0[0], v0[1]); w.y = cvt_pk_bf16(v0[2], v0[3]); w.z = cvt_pk_bf16(v1[0], v1[1]); w.w = cvt_pk_bf16(v1[2], v1[3]);
                    *(u32x4*)(xn + o) = w;
                    s += ((v0[0] * v0[0] + v0[1] * v0[1]) + (v0[2] * v0[2] + v0[3] * v0[3])) + ((v1[0] * v1[0] + v1[1] * v1[1]) + (v1[2] * v1[2] + v1[3] * v1[3])); }
                s += __shfl_xor(s, 16); s += __shfl_xor(s, 32);
                if (fq == 0) ssq[(size_t)row * 16 + u.pn * 4 + wc] = s; }
    }
};
struct EpiQRope {
    static constexpr bool PERM = false, AFTER_DRAIN = false;
    bf16_t* O; int ldc; const float* tab; const PG8_LAS float* rstd;
    __device__ __forceinline__ void operator()(const f32x4 (&acc)[2][2][4][2], const Unit& u, int wr, int wc, int fr, int fq) const {
        typedef unsigned u32x2 __attribute__((ext_vector_type(2)));
        const int row0 = u.pm * BM + wr * 64 + fr;
#pragma unroll
        for (int ai = 0; ai < 2; ++ai)
#pragma unroll
            for (int m = 0; m < 4; ++m) { const int row = row0 + ai * HALF + m * 16;
                const f32x4 cs = *(const f32x4*)(tab + (size_t)row * 32 + 4 * fq), sn = *(const f32x4*)(tab + (size_t)row * 32 + 16 + 4 * fq);
                const float rs = rstd[wr * 64 + fr + ai * HALF + m * 16];
#pragma unroll
                for (int bj = 0; bj < 2; ++bj) { const int cgp = u.pn * BM + bj * HALF + wc * 32;
                    f32x4 x1 = acc[ai][bj][m][0] * rs, x2 = acc[ai][bj][m][1] * rs;
                    if ((cgp % 96) == 64) { const f32x4 o1 = x1 * cs - x2 * sn, o2 = x2 * cs + x1 * sn; x1 = o1; x2 = o2; }
                    bf16_t* op = O + (size_t)row * ldc + cgp + 4 * fq;
                    u32x2 w1, w2; w1.x = cvt_pk_bf16(x1[0], x1[1]); w1.y = cvt_pk_bf16(x1[2], x1[3]); w2.x = cvt_pk_bf16(x2[0], x2[1]); w2.y = cvt_pk_bf16(x2[2], x2[3]);
                    *(u32x2*)op = w1; *(u32x2*)(op + 16) = w2; }
                asm volatile("" ::: "memory"); }
    }
};
}

#define DI __device__ __forceinline__
#define LAS __attribute__((address_space(3)))
typedef unsigned short bf16_t;
typedef short bf16x8 __attribute__((ext_vector_type(8)));
typedef short s16x4 __attribute__((ext_vector_type(4)));
typedef float f32x4 __attribute__((ext_vector_type(4)));
typedef float f32x16 __attribute__((ext_vector_type(16)));
typedef unsigned u32x4 __attribute__((ext_vector_type(4)));
typedef unsigned u32x2 __attribute__((ext_vector_type(2)));

constexpr int BATCH = 4, SEQ = 4096, DM = 1024, MT = BATCH * SEQ, DFF = 4096;
constexpr int LD_AB = 3072, LD_CD = 2304, NSRC_AB = 3080, NSRC_CD = 2208;
constexpr int NWAVES = 8, NTHREADS = 512;
constexpr float LOG2E = 1.4426950408889634f, LN2 = 0.6931471805599453f, EPS = 1e-6f;
constexpr size_t MiB = 1u << 20;
constexpr size_t WS_WINAB = 0, WS_WOUTAB = 6 * MiB, WS_WINCD = 8 * MiB, WS_WUQ = 13 * MiB, WS_WUKV = 14 * MiB, WS_WOUTCD = 15 * MiB;
constexpr size_t WS_WUP0 = 17 * MiB, WS_WUP1 = 25 * MiB, WS_WDN0 = 33 * MiB, WS_WDN1 = 41 * MiB;
constexpr size_t WS_LOGF = 49 * MiB, WS_CUM = 49 * MiB + 512 * 1024, WS_TAB = 50 * MiB, WS_KR = 52 * MiB, WS_SSQ = 53 * MiB, WS_SSQ2 = 86 * MiB;
constexpr size_t WS_XN = 54 * MiB, WS_CQN = 54 * MiB, WS_CKVN = 66 * MiB, WS_O = 86 * MiB;
constexpr size_t WS_BIG = 118 * MiB, WS_QF = 190 * MiB, WS_KVF = 214 * MiB, WS_CTL = 246 * MiB, CTL_BYTES = 65536, CTL_KN2 = 32768, WS_END = 247 * MiB;
constexpr int LDS_BYTES = 147456, MISC_OFF = 131072 + 320;

DI float bf2f(unsigned short v) { return __uint_as_float((unsigned)v << 16); }
DI unsigned pk2(float lo, float hi) { typedef float f2 __attribute__((ext_vector_type(2))); typedef __bf16 b2 __attribute__((ext_vector_type(2))); f2 v = {lo, hi}; b2 b = __builtin_convertvector(v, b2); return __builtin_bit_cast(unsigned, b); }
DI float wave_sum(float v) {
#pragma unroll
    for (int o = 1; o < 64; o <<= 1) v += __shfl_xor(v, o);
    return v;
}
DI float fexp2(float x) { return __builtin_amdgcn_exp2f(x); }
DI float flog2(float x) { return __builtin_amdgcn_logf(x); }

DI void transpose_item(const float* W, int K, int ldn, int src_col0, bf16_t* WT, int dst_row0, int nblk, LAS float* scr, int item, int lane, const float* gain) {
    const int kb = item / nblk, nb = item % nblk, k0 = 64 * kb, n0 = 32 * nb;
    float wv[32];
#pragma unroll
    for (int i = 0; i < 32; ++i) { const int kk = 2 * i + (lane >> 5); wv[i] = W[(size_t)(k0 + kk) * ldn + src_col0 + n0 + (lane & 31)]; }
    if (gain) {
#pragma unroll
        for (int i = 0; i < 32; ++i) wv[i] *= gain[k0 + 2 * i + (lane >> 5)]; }
#pragma unroll
    for (int i = 0; i < 32; ++i) { const int kk = 2 * i + (lane >> 5); scr[kk * 33 + (lane & 31)] = wv[i]; }
    asm volatile("s_waitcnt lgkmcnt(0)" ::: "memory");
    const int c = lane & 7;
#pragma unroll
    for (int j = 0; j < 4; ++j) { const int n = (lane >> 3) + 8 * j; const LAS float* s = scr + (8 * c) * 33 + n;
        u32x4 o; o.x = pk2(s[0 * 33], s[1 * 33]); o.y = pk2(s[2 * 33], s[3 * 33]); o.z = pk2(s[4 * 33], s[5 * 33]); o.w = pk2(s[6 * 33], s[7 * 33]);
        *(u32x4*)(WT + (size_t)(dst_row0 + n0 + n) * K + k0 + 8 * c) = o; }
    asm volatile("s_waitcnt lgkmcnt(0)" ::: "memory");
}

DI void sincos_d(double a, float& sn, float& cs);
DI float inv_freq_f(int i);
template <bool FA> DI void norm_rows_bf16(const float* src, const float* gain, bf16_t* dst, int gw, int ngw, int lane, const LAS float* wfaT, const float* b_forget, float* logf_out, const int* pos, float* tab) {
    f32x4 g[4];
#pragma unroll
    for (int j = 0; j < 4; ++j) g[j] = ((const f32x4*)gain)[64 * j + lane];
    f32x4 nx[4];
    if (gw < MT) {
#pragma unroll
        for (int j = 0; j < 4; ++j) nx[j] = ((const f32x4*)(src + (size_t)gw * DM) + lane)[64 * j]; }
    for (int row = gw; row < MT; row += ngw) {
        f32x4 v[4]; float s = 0.f;
#pragma unroll
        for (int j = 0; j < 4; ++j) v[j] = nx[j];
        if (row + ngw < MT) {
#pragma unroll
            for (int j = 0; j < 4; ++j) nx[j] = ((const f32x4*)(src + (size_t)(row + ngw) * DM) + lane)[64 * j]; }
#pragma unroll
        for (int j = 0; j < 4; ++j) { s += (v[j].x * v[j].x + v[j].y * v[j].y) + (v[j].z * v[j].z + v[j].w * v[j].w); v[j] = v[j] * g[j]; }
        float a8[8];
        if (FA) {
#pragma unroll
            for (int jj = 0; jj < 8; ++jj) { float a = 0.f;
#pragma unroll
                for (int j = 0; j < 4; ++j) { const f32x4 w = *(const LAS f32x4*)(wfaT + jj * 1024 + 256 * j + 4 * lane); a += (v[j].x * w.x + v[j].y * w.y) + (v[j].z * w.z + v[j].w * w.w); }
                a8[jj] = a; }
        }
        const float rstd = 1.0f / sqrtf(wave_sum(s) * (1.f / DM) + EPS);
        unsigned long long* o8 = (unsigned long long*)(dst + (size_t)row * DM) + lane;
#pragma unroll
        for (int j = 0; j < 4; ++j) { const f32x4 y = v[j] * rstd; o8[64 * j] = (unsigned long long)pk2(y.x, y.y) | ((unsigned long long)pk2(y.z, y.w) << 32); }
        if (FA) {
            float b4[4], c2[2], d;
            { const bool up = (lane & 32) != 0;
#pragma unroll
              for (int i = 0; i < 4; ++i) { const float keep = up ? a8[i + 4] : a8[i], send = up ? a8[i] : a8[i + 4]; b4[i] = keep + __shfl_xor(send, 32); } }
            { const bool up = (lane & 16) != 0;
#pragma unroll
              for (int i = 0; i < 2; ++i) { const float keep = up ? b4[i + 2] : b4[i], send = up ? b4[i] : b4[i + 2]; c2[i] = keep + __shfl_xor(send, 16); } }
            { const bool up = (lane & 8) != 0; const float keep = up ? c2[1] : c2[0], send = up ? c2[0] : c2[1]; d = keep + __shfl_xor(send, 8); }
            d += __shfl_xor(d, 4); d += __shfl_xor(d, 2); d += __shfl_xor(d, 1);
            if ((lane & 7) == 0) { const int j = lane >> 3; const float t = d * rstd + b_forget[j]; const float ls = fminf(t, 0.f) - log1pf(expf(-fabsf(t))); logf_out[(size_t)row * 8 + j] = ls; }
            if (lane < 16) { const float ang = (float)pos[row] * inv_freq_f(lane); float sn, cs; sincos_d((double)ang, sn, cs); tab[(size_t)row * 32 + lane] = cs; tab[(size_t)row * 32 + 16 + lane] = sn; }
        }
    }
}
DI void norm_rows_final(const bf16_t* xb, float* out, const float* gain, int gw, int ngw, int lane) {
    f32x4 g[4];
#pragma unroll
    for (int hf = 0; hf < 2; ++hf) { g[2 * hf] = *(const f32x4*)(gain + 512 * hf + 8 * lane); g[2 * hf + 1] = *(const f32x4*)(gain + 512 * hf + 8 * lane + 4); }
    for (int row = gw; row < MT; row += ngw) {
        f32x4 v[4]; float s = 0.f;
#pragma unroll
        for (int hf = 0; hf < 2; ++hf) { const u32x4 w = *(const u32x4*)(xb + (size_t)row * DM + 512 * hf + 8 * lane);
            v[2 * hf][0] = __uint_as_float(w.x << 16); v[2 * hf][1] = __uint_as_float(w.x & 0xffff0000u); v[2 * hf][2] = __uint_as_float(w.y << 16); v[2 * hf][3] = __uint_as_float(w.y & 0xffff0000u);
            v[2 * hf + 1][0] = __uint_as_float(w.z << 16); v[2 * hf + 1][1] = __uint_as_float(w.z & 0xffff0000u); v[2 * hf + 1][2] = __uint_as_float(w.w << 16); v[2 * hf + 1][3] = __uint_as_float(w.w & 0xffff0000u); }
#pragma unroll
        for (int j = 0; j < 4; ++j) s += (v[j].x * v[j].x + v[j].y * v[j].y) + (v[j].z * v[j].z + v[j].w * v[j].w);
        const float rstd = 1.0f / sqrtf(wave_sum(s) * (1.f / DM) + EPS);
#pragma unroll
        for (int hf = 0; hf < 2; ++hf) { float* op = out + (size_t)row * DM + 512 * hf + 8 * lane; *(f32x4*)op = v[2 * hf] * rstd * g[2 * hf]; *(f32x4*)(op + 4) = v[2 * hf + 1] * rstd * g[2 * hf + 1]; }
    }
}

DI void sincos_d(double a, float& sn, float& cs) {
    const double n = rint(a * 0.63661977236758134308);
    const double r = fma(-n, 1.5707963267948966192, a) - n * 6.123233995736766e-17;
    const double r2 = r * r;
    double sp = -2.5052108385441718775e-8; sp = sp * r2 + 2.7557319223985890653e-6; sp = sp * r2 - 1.9841269841269841270e-4; sp = sp * r2 + 8.3333333333333333333e-3; sp = sp * r2 - 1.6666666666666666667e-1; sp = r + r * r2 * sp;
    double cp = 2.0876756987868098979e-9; cp = cp * r2 - 2.7557319223985890653e-7; cp = cp * r2 + 2.4801587301587301587e-5; cp = cp * r2 - 1.3888888888888888889e-3; cp = cp * r2 + 4.1666666666666666667e-2; cp = cp * r2 - 0.5; cp = 1.0 + r2 * cp;
    const int q = (int)((long long)n & 3);
    const double s_ = (q == 0) ? sp : (q == 1) ? cp : (q == 2) ? -sp : -cp;
    const double c_ = (q == 0) ? cp : (q == 1) ? -sp : (q == 2) ? -cp : sp;
    sn = (float)s_; cs = (float)c_;
}
DI float inv_freq_f(int i) {
    float r = 1.0f;
    r = (i == 1) ? 0.56234132519034908f : r;
    r = (i == 2) ? 0.31622776601683794f : r;
    r = (i == 3) ? 0.17782794100389228f : r;
    r = (i == 4) ? 0.1f : r;
    r = (i == 5) ? 0.056234132519034911f : r;
    r = (i == 6) ? 0.031622776601683791f : r;
    r = (i == 7) ? 0.017782794100389229f : r;
    r = (i == 8) ? 0.01f : r;
    r = (i == 9) ? 0.0056234132519034910f : r;
    r = (i == 10) ? 0.0031622776601683794f : r;
    r = (i == 11) ? 0.0017782794100389228f : r;
    r = (i == 12) ? 0.001f : r;
    r = (i == 13) ? 0.00056234132519034907f : r;
    r = (i == 14) ? 0.00031622776601683794f : r;
    r = (i == 15) ? 0.00017782794100389227f : r;
    return r;
}
DI void mla_prep_rows(const bf16_t* PC, const int* pos, const float* q_norm, const float* kv_norm, bf16_t* cqn, bf16_t* ckvn, float* tab, bf16_t* KR, int gw, int ngw, int lane) {
    for (int row = gw; row < MT; row += ngw) {
        const bf16_t* pr = PC + (size_t)row * LD_CD;
        {
            float v[8]; float s = 0.f;
            if (lane < 48) { const u32x4 w = *(const u32x4*)(pr + 1536 + 8 * lane);
#pragma unroll
                for (int e = 0; e < 4; ++e) { v[2 * e] = __uint_as_float(w[e] << 16); v[2 * e + 1] = __uint_as_float(w[e] & 0xffff0000u); s += v[2 * e] * v[2 * e] + v[2 * e + 1] * v[2 * e + 1]; } }
            else {
#pragma unroll
                for (int e = 0; e < 8; ++e) v[e] = 0.f; }
            const float rstd = 1.0f / sqrtf(wave_sum(s) * (1.f / 384.f) + EPS);
            if (lane < 48) { const f32x4 g0 = *(const f32x4*)(q_norm + 8 * lane), g1 = *(const f32x4*)(q_norm + 8 * lane + 4);
                u32x4 o; o.x = pk2(v[0] * rstd * g0.x, v[1] * rstd * g0.y); o.y = pk2(v[2] * rstd * g0.z, v[3] * rstd * g0.w); o.z = pk2(v[4] * rstd * g1.x, v[5] * rstd * g1.y); o.w = pk2(v[6] * rstd * g1.z, v[7] * rstd * g1.w);
                *(u32x4*)(cqn + (size_t)row * 384 + 8 * lane) = o; }
        }
        {
            float v[8]; float s = 0.f;
            if (lane < 32) { const u32x4 w = *(const u32x4*)(pr + 1920 + 8 * lane);
#pragma unroll
                for (int e = 0; e < 4; ++e) { v[2 * e] = __uint_as_float(w[e] << 16); v[2 * e + 1] = __uint_as_float(w[e] & 0xffff0000u); s += v[2 * e] * v[2 * e] + v[2 * e + 1] * v[2 * e + 1]; } }
            else {
#pragma unroll
                for (int e = 0; e < 8; ++e) v[e] = 0.f; }
            const float rstd = 1.0f / sqrtf(wave_sum(s) * (1.f / 256.f) + EPS);
            if (lane < 32) { const f32x4 g0 = *(const f32x4*)(kv_norm + 8 * lane), g1 = *(const f32x4*)(kv_norm + 8 * lane + 4);
                u32x4 o; o.x = pk2(v[0] * rstd * g0.x, v[1] * rstd * g0.y); o.y = pk2(v[2] * rstd * g0.z, v[3] * rstd * g0.w); o.z = pk2(v[4] * rstd * g1.x, v[5] * rstd * g1.y); o.w = pk2(v[6] * rstd * g1.z, v[7] * rstd * g1.w);
                *(u32x4*)(ckvn + (size_t)row * 256 + 8 * lane) = o; }
        }
        if (lane < 16) {
            const float cs = tab[(size_t)row * 32 + lane], sn = tab[(size_t)row * 32 + 16 + lane];
            const float x1 = bf2f(pr[2176 + lane]), x2 = bf2f(pr[2176 + 16 + lane]);
            KR[(size_t)row * 32 + lane] = (bf16_t)(pk2(x1 * cs - x2 * sn, 0.f) & 0xffffu);
            KR[(size_t)row * 32 + 16 + lane] = (bf16_t)(pk2(x2 * cs + x1 * sn, 0.f) & 0xffffu);
        }
    }
}

namespace att {
constexpr int KBUF = 13312, VBUF = 9216;
constexpr int OFF_K = 0, OFF_V = 2 * KBUF, OFF_C = OFF_V + 2 * VBUF, OFF_RB = OFF_C + 512, OFF_FLAG = OFF_RB + 1280, ATT_LDS = OFF_FLAG + 64;
DI f32x16 mfma(bf16x8 a, bf16x8 b, f32x16 c) { return __builtin_amdgcn_mfma_f32_32x32x16_bf16(a, b, c, 0, 0, 0); }
DI int crow(int i, int hh) { return (i & 3) + 8 * (i >> 2) + 4 * hh; }
DI bf16x8 packfrag(const f32x16& p, int s) { u32x4 w; w.x = pk2(p[8 * s], p[8 * s + 1]); w.y = pk2(p[8 * s + 2], p[8 * s + 3]); w.z = pk2(p[8 * s + 4], p[8 * s + 5]); w.w = pk2(p[8 * s + 6], p[8 * s + 7]); return __builtin_bit_cast(bf16x8, w); }
typedef short v4i16_t __attribute__((ext_vector_type(4)));
DI s16x4 vtr(const LAS unsigned char* p) { return __builtin_bit_cast(s16x4, __builtin_amdgcn_ds_read_tr16_b64_v4i16((LAS v4i16_t*)p)); }

struct Lane { int tid, lane, wid, r, hh, q4, p4, blk, srow, sch; };
DI Lane mklane() { Lane L; L.tid = threadIdx.x; L.lane = L.tid & 63; L.wid = __builtin_amdgcn_readfirstlane(L.tid >> 6); L.r = L.lane & 31; L.hh = L.lane >> 5;
    const int i16 = L.lane & 15; L.q4 = i16 >> 2; L.p4 = i16 & 3; L.blk = (L.lane >> 4) & 1; L.srow = L.tid >> 3; L.sch = L.tid & 7; return L; }

template <int NDS, int KSTRIDE> DI void qk_tile(f32x16& p0, f32x16& p1, const LAS unsigned char* Kb, const bf16x8* qf, const Lane& L) {
    const LAS unsigned char* ka = Kb + L.r * KSTRIDE + L.hh * 16;
#pragma unroll
    for (int i = 0; i < 16; ++i) { p0[i] = 0.f; p1[i] = 0.f; }
#pragma unroll
    for (int ds = 0; ds < NDS; ++ds) {
        const bf16x8 a0 = *(const LAS bf16x8*)(ka + ds * 32), a1 = *(const LAS bf16x8*)(ka + 32 * KSTRIDE + ds * 32);
        p0 = mfma(a0, qf[ds], p0); p1 = mfma(a1, qf[ds], p1); }
}
DI void pv_tile(f32x16& o0, f32x16& o1, const LAS unsigned char* Vb, const bf16x8 (&pf)[4], const Lane& L) {
    const LAS unsigned char* vb = Vb + (4 * L.hh + L.q4) * 144 + (16 * L.blk + 4 * L.p4) * 2;
#pragma unroll
    for (int f = 0; f < 4; ++f) { const LAS unsigned char* base = vb + (16 * f) * 144;
        { const s16x4 lo = vtr(base), hi = vtr(base + 8 * 144); const bf16x8 vf = __builtin_shufflevector(lo, hi, 0, 1, 2, 3, 4, 5, 6, 7); o0 = mfma(vf, pf[f], o0); }
        { const s16x4 lo = vtr(base + 64), hi = vtr(base + 8 * 144 + 64); const bf16x8 vf = __builtin_shufflevector(lo, hi, 0, 1, 2, 3, 4, 5, 6, 7); o1 = mfma(vf, pf[f], o1); } }
}
DI void online_softmax(f32x16& p0, f32x16& p1, float& m, float& l, f32x16& o0, f32x16& o1, bf16x8 (&pf)[4]) {
    float mt = fmaxf(p0[0], p1[0]);
#pragma unroll
    for (int i = 1; i < 16; ++i) mt = fmaxf(mt, fmaxf(p0[i], p1[i]));
    mt = fmaxf(mt, __shfl_xor(mt, 32));
    if (__any(mt > m)) {
        const float mn = fmaxf(m, mt), alpha = fexp2(m - mn); m = mn; l *= alpha;
#pragma unroll
        for (int i = 0; i < 16; ++i) { o0[i] *= alpha; o1[i] *= alpha; }
    }
    float rs = 0.f;
#pragma unroll
    for (int i = 0; i < 16; ++i) { p0[i] = fexp2(p0[i] - m); p1[i] = fexp2(p1[i] - m); rs += p0[i] + p1[i]; }
    l += rs;
    pf[0] = packfrag(p0, 0); pf[1] = packfrag(p0, 1); pf[2] = packfrag(p1, 0); pf[3] = packfrag(p1, 1);
}
DI void store_o(bf16_t* orow, const f32x16& o0, const f32x16& o1, float inv, int hh) {
#pragma unroll
    for (int g = 0; g < 4; ++g) {
        u32x2 w0, w1; w0.x = pk2(o0[4 * g] * inv, o0[4 * g + 1] * inv); w0.y = pk2(o0[4 * g + 2] * inv, o0[4 * g + 3] * inv);
        w1.x = pk2(o1[4 * g] * inv, o1[4 * g + 1] * inv); w1.y = pk2(o1[4 * g + 2] * inv, o1[4 * g + 3] * inv);
        *(u32x2*)(orow + 8 * g + 4 * hh) = w0; *(u32x2*)(orow + 32 + 8 * g + 4 * hh) = w1; }
}

DI void fox_unit(LAS unsigned char* lds, const bf16_t* PA, const float* cum, const unsigned* kn2, bf16_t* O, int b, int h, int qb) {
    const Lane L = mklane();
    const size_t rowbase = (size_t)b * SEQ;
    const int q0 = qb * 256, q0w = q0 + L.wid * 32, myq = q0w + L.r;
    const bf16_t* Qp = PA + (rowbase + myq) * LD_AB + h * 64;
    const bf16_t* Kp = PA + rowbase * LD_AB + 512 + h * 64;
    const bf16_t* Vp = Kp + 512;
    const float* cumh = cum + (size_t)(b * 8 + h) * SEQ;
    bf16x8 qf[4];
#pragma unroll
    for (int ds = 0; ds < 4; ++ds) qf[ds] = *(const bf16x8*)(Qp + 16 * ds + 8 * L.hh);
    const float c1 = 0.125f * LOG2E;
    float qn2 = 0.f;
#pragma unroll
    for (int ds = 0; ds < 4; ++ds)
#pragma unroll
        for (int j = 0; j < 8; ++j) { const float qv = bf2f((unsigned short)qf[ds][j]); qn2 += qv * qv; }
    qn2 += __shfl_xor(qn2, 32);
    const float kmax2 = __uint_as_float(kn2[(b * 8 + h) * 2]) + __uint_as_float(kn2[(b * 8 + h) * 2 + 1]);
    const float smax = sqrtf(qn2 * kmax2) * c1 * 1.01f + 1e-3f;
    const int NT = (q0 + 256) / 64;
    float m = -INFINITY, l = 0.f; f32x16 o0, o1;
#pragma unroll
    for (int i = 0; i < 16; ++i) { o0[i] = 0.f; o1[i] = 0.f; }
    bool seen = false;
    LAS int* flags = (LAS int*)(lds + OFF_FLAG);
    u32x4 kreg, vreg; float creg = 0.f;
#define FOX_LOAD(t) do { kreg = *(const u32x4*)(Kp + (size_t)((t) * 64 + L.srow) * LD_AB + L.sch * 8); vreg = *(const u32x4*)(Vp + (size_t)((t) * 64 + L.srow) * LD_AB + L.sch * 8); \
        if (L.tid < 64) creg = cumh[(t) * 64 + L.tid] * (-LOG2E); } while (0)
#define FOX_WRITE(bf) do { *(LAS u32x4*)(lds + OFF_K + (bf) * KBUF + L.srow * 144 + L.sch * 16) = kreg; *(LAS u32x4*)(lds + OFF_V + (bf) * VBUF + L.srow * 144 + L.sch * 16) = vreg; \
        if (L.tid < 64) *(LAS float*)(lds + OFF_C + (bf) * 256 + L.tid * 4) = creg; } while (0)
    FOX_LOAD(NT - 1); FOX_WRITE(0); __syncthreads();
    for (int it = 0; it < NT; ++it) {
        const int t = NT - 1 - it, k0 = t * 64, bf = it & 1;
        if (t > 0) FOX_LOAD(t - 1);
        bool done = false;
        if (k0 <= q0w + 31) {
            const LAS unsigned char* Cb = lds + OFF_C + bf * 256;
            const float nck_last = *(const LAS float*)(Cb + 63 * 4);
            done = seen && __all(smax + nck_last - m < -40.0f);
            if (!done) {
                f32x16 p0, p1;
                qk_tile<4, 144>(p0, p1, lds + OFF_K + bf * KBUF, qf, L);
#pragma unroll
                for (int g = 0; g < 4; ++g) { const f32x4 ca = *(const LAS f32x4*)(Cb + (8 * g + 4 * L.hh) * 4), cb = *(const LAS f32x4*)(Cb + (32 + 8 * g + 4 * L.hh) * 4);
#pragma unroll
                    for (int e = 0; e < 4; ++e) { p0[4 * g + e] = fmaf(p0[4 * g + e], c1, ca[e]); p1[4 * g + e] = fmaf(p1[4 * g + e], c1, cb[e]); } }
                if (k0 + 63 > q0w) {
#pragma unroll
                    for (int i = 0; i < 16; ++i) { const int key = k0 + crow(i, L.hh); if (key > myq) p0[i] = -INFINITY; if (key + 32 > myq) p1[i] = -INFINITY; } }
                bf16x8 pf[4];
                online_softmax(p0, p1, m, l, o0, o1, pf);
                pv_tile(o0, o1, lds + OFF_V + bf * VBUF, pf, L);
                seen = true;
            }
        }
        if (L.lane == 0) flags[(it & 1) * 8 + L.wid] = done ? 1 : 0;
        if (t > 0) FOX_WRITE((it + 1) & 1);
        __syncthreads();
        int alld = 1;
#pragma unroll
        for (int w = 0; w < 8; ++w) alld &= flags[(it & 1) * 8 + w];
        if (alld) break;
    }
#undef FOX_LOAD
#undef FOX_WRITE
    const float lt = l + __shfl_xor(l, 32);
    store_o(O + (rowbase + myq) * DM + h * 64, o0, o1, 1.0f / lt, L.hh);
    __syncthreads();
}

DI void chk_unit(LAS unsigned char* lds, const bf16_t* PA, const float* rel_bias, bf16_t* O, int b, int h, int g4) {
    const Lane L = mklane();
    const size_t rowbase = (size_t)b * SEQ;
    const int cw = 4 * g4 + (L.wid >> 1), myq = 64 * cw + 32 * (L.wid & 1) + L.r;
    const bf16_t* Qp = PA + (rowbase + myq) * LD_AB + 1536 + h * 64;
    const bf16_t* Kp = PA + rowbase * LD_AB + 2048 + h * 64;
    const bf16_t* Vp = Kp + 512;
    bf16x8 qf[4];
#pragma unroll
    for (int ds = 0; ds < 4; ++ds) qf[ds] = *(const bf16x8*)(Qp + 16 * ds + 8 * L.hh);
    const float c1 = 0.125f * LOG2E;
    const int c_lo = (4 * g4 - 8) > 0 ? (4 * g4 - 8) : 0, NT = 4 * g4 + 4 - c_lo;
    LAS float* rb = (LAS float*)(lds + OFF_RB);
    if (L.tid < 320) rb[L.tid] = rel_bias[h * 320 + L.tid] * LOG2E;
    float m = -INFINITY, l = 0.f; f32x16 o0, o1;
#pragma unroll
    for (int i = 0; i < 16; ++i) { o0[i] = 0.f; o1[i] = 0.f; }
    u32x4 kreg, vreg;
#define CHK_LOAD(t) do { kreg = *(const u32x4*)(Kp + (size_t)((c_lo + (t)) * 64 + L.srow) * LD_AB + L.sch * 8); vreg = *(const u32x4*)(Vp + (size_t)((c_lo + (t)) * 64 + L.srow) * LD_AB + L.sch * 8); } while (0)
#define CHK_WRITE(bf) do { *(LAS u32x4*)(lds + OFF_K + (bf) * KBUF + L.srow * 144 + L.sch * 16) = kreg; *(LAS u32x4*)(lds + OFF_V + (bf) * VBUF + L.srow * 144 + L.sch * 16) = vreg; } while (0)
    CHK_LOAD(0); CHK_WRITE(0); __syncthreads();
    for (int t = 0; t < NT; ++t) {
        if (t + 1 < NT) CHK_LOAD(t + 1);
        const int kc = c_lo + t, bf = t & 1;
        if (kc >= cw - 8 && kc <= cw) {
            f32x16 p0, p1;
            qk_tile<4, 144>(p0, p1, lds + OFF_K + bf * KBUF, qf, L);
            if (cw - kc >= 5) { const float bb = rb[319];
#pragma unroll
                for (int i = 0; i < 16; ++i) { p0[i] = fmaf(p0[i], c1, bb); p1[i] = fmaf(p1[i], c1, bb); } }
            else {
#pragma unroll
                for (int i = 0; i < 16; ++i) { const int rel = myq - (64 * kc + crow(i, L.hh));
                    const int i0 = (rel < 256 ? rel : 256) + 63, i1 = (rel - 32 < 256 ? rel - 32 : 256) + 63;
                    p0[i] = fmaf(p0[i], c1, rb[i0]); p1[i] = fmaf(p1[i], c1, rb[i1]); } }
            bf16x8 pf[4];
            online_softmax(p0, p1, m, l, o0, o1, pf);
            pv_tile(o0, o1, lds + OFF_V + bf * VBUF, pf, L);
        }
        if (t + 1 < NT) CHK_WRITE((t + 1) & 1);
        __syncthreads();
    }
#undef CHK_LOAD
#undef CHK_WRITE
    const float lt = l + __shfl_xor(l, 32);
    store_o(O + (rowbase + myq) * DM + 512 + h * 64, o0, o1, 1.0f / lt, L.hh);
}

DI void mla_unit(LAS unsigned char* lds, const bf16_t* QF, const bf16_t* KVF, const bf16_t* KR, bf16_t* O, int b, int h, int qb) {
    const Lane L = mklane();
    const size_t rowbase = (size_t)b * SEQ;
    const int cw = 4 * qb + (L.wid >> 1), myq = 64 * cw + 32 * (L.wid & 1) + L.r;
    const bf16_t* Qp = QF + (rowbase + myq) * 768 + h * 96;
    const bf16_t* Kp = KVF + rowbase * 1024 + h * 128;
    const bf16_t* Vp = Kp + 64;
    const bf16_t* Rp = KR + rowbase * 32;
    bf16x8 qf[6];
#pragma unroll
    for (int ds = 0; ds < 6; ++ds) qf[ds] = *(const bf16x8*)(Qp + 16 * ds + 8 * L.hh);
    const float c1 = 0.10206207261596577f * LOG2E;
    const int NT = 4 * qb + 4;
    float m = -INFINITY, l = 0.f; f32x16 o0, o1;
#pragma unroll
    for (int i = 0; i < 16; ++i) { o0[i] = 0.f; o1[i] = 0.f; }
    u32x4 kreg, vreg, rreg;
#define MLA_LOAD(t) do { kreg = *(const u32x4*)(Kp + (size_t)((t) * 64 + L.srow) * 1024 + L.sch * 8); vreg = *(const u32x4*)(Vp + (size_t)((t) * 64 + L.srow) * 1024 + L.sch * 8); \
        if (L.tid < 256) rreg = *(const u32x4*)(Rp + (size_t)((t) * 64 + (L.tid >> 2)) * 32 + (L.tid & 3) * 8); } while (0)
#define MLA_WRITE(bf) do { *(LAS u32x4*)(lds + OFF_K + (bf) * KBUF + L.srow * 208 + L.sch * 16) = kreg; *(LAS u32x4*)(lds + OFF_V + (bf) * VBUF + L.srow * 144 + L.sch * 16) = vreg; \
        if (L.tid < 256) *(LAS u32x4*)(lds + OFF_K + (bf) * KBUF + (L.tid >> 2) * 208 + 128 + (L.tid & 3) * 16) = rreg; } while (0)
    MLA_LOAD(0); MLA_WRITE(0); __syncthreads();
    for (int t = 0; t < NT; ++t) {
        if (t + 1 < NT) MLA_LOAD(t + 1);
        const int bf = t & 1;
        if (t <= cw) {
            f32x16 p0, p1;
            qk_tile<6, 208>(p0, p1, lds + OFF_K + bf * KBUF, qf, L);
#pragma unroll
            for (int i = 0; i < 16; ++i) { p0[i] *= c1; p1[i] *= c1; }
            bf16x8 pf[4];
            online_softmax(p0, p1, m, l, o0, o1, pf);
            pv_tile(o0, o1, lds + OFF_V + bf * VBUF, pf, L);
        }
        if (t + 1 < NT) MLA_WRITE((t + 1) & 1);
        __syncthreads();
    }
#undef MLA_LOAD
#undef MLA_WRITE
    const float lt = l + __shfl_xor(l, 32);
    store_o(O + (rowbase + myq) * DM + 512 + h * 64, o0, o1, 1.0f / lt, L.hh);
}

DI void sb_sub(f32x16& p, float& R, int keybase, int myq, int hh, bool need_mask) {
    float lk[16], lb[16];
#pragma unroll
    for (int i = 0; i < 16; ++i) {
        const float z = p[i] * 0.125f, u = fexp2(-fabsf(z) * LOG2E), sp = fmaxf(z, 0.f) + flog2(1.0f + u) * LN2;
        const bool valid = !need_mask || (keybase + crow(i, hh)) < myq;
        lk[i] = valid ? -sp : 0.f; lb[i] = valid ? (z - sp) : -INFINITY; }
    float G[4], Gp[4];
#pragma unroll
    for (int g = 0; g < 4; ++g) { G[g] = (lk[4 * g] + lk[4 * g + 1]) + (lk[4 * g + 2] + lk[4 * g + 3]); Gp[g] = __shfl_xor(G[g], 32); }
    float acc = R;
#pragma unroll
    for (int g = 3; g >= 0; --g) {
        const float s3 = hh ? acc : acc + Gp[g];
        acc += G[g] + Gp[g];
        const float s2 = s3 + lk[4 * g + 3], s1 = s2 + lk[4 * g + 2], s0 = s1 + lk[4 * g + 1];
        p[4 * g + 3] = fexp2((lb[4 * g + 3] + s3) * LOG2E); p[4 * g + 2] = fexp2((lb[4 * g + 2] + s2) * LOG2E);
        p[4 * g + 1] = fexp2((lb[4 * g + 1] + s1) * LOG2E); p[4 * g] = fexp2((lb[4 * g] + s0) * LOG2E); }
    R = acc;
}
DI void sb_unit(LAS unsigned char* lds, const bf16_t* PC, bf16_t* O, int b, int h, int qb) {
    const Lane L = mklane();
    const size_t rowbase = (size_t)b * SEQ;
    const int q0 = qb * 256, q0w = q0 + L.wid * 32, myq = q0w + L.r;
    const bf16_t* Qp = PC + (rowbase + myq) * LD_CD + h * 64;
    const bf16_t* Kp = PC + rowbase * LD_CD + 512 + h * 64;
    const bf16_t* Vp = Kp + 512;
    bf16x8 qf[4];
#pragma unroll
    for (int ds = 0; ds < 4; ++ds) qf[ds] = *(const bf16x8*)(Qp + 16 * ds + 8 * L.hh);
    const int NT = (q0 + 256) / 64;
    float R = 0.f; f32x16 o0, o1;
#pragma unroll
    for (int i = 0; i < 16; ++i) { o0[i] = 0.f; o1[i] = 0.f; }
    bool seen = false;
    LAS int* flags = (LAS int*)(lds + OFF_FLAG);
    u32x4 kreg, vreg;
#define SB_LOAD(t) do { kreg = *(const u32x4*)(Kp + (size_t)((t) * 64 + L.srow) * LD_CD + L.sch * 8); vreg = *(const u32x4*)(Vp + (size_t)((t) * 64 + L.srow) * LD_CD + L.sch * 8); } while (0)
#define SB_WRITE(bf) do { *(LAS u32x4*)(lds + OFF_K + (bf) * KBUF + L.srow * 144 + L.sch * 16) = kreg; *(LAS u32x4*)(lds + OFF_V + (bf) * VBUF + L.srow * 144 + L.sch * 16) = vreg; } while (0)
    SB_LOAD(NT - 1); SB_WRITE(0); __syncthreads();
    for (int it = 0; it < NT; ++it) {
        const int t = NT - 1 - it, k0 = t * 64, bf = it & 1;
        if (t > 0) SB_LOAD(t - 1);
        bool done = false;
        if (k0 <= q0w + 31) {
            done = seen && __all(R < -110.0f);
            if (!done) {
                f32x16 p0, p1;
                qk_tile<4, 144>(p0, p1, lds + OFF_K + bf * KBUF, qf, L);
                const bool nm = (k0 + 63 >= q0w);
                sb_sub(p1, R, k0 + 32, myq, L.hh, nm);
                sb_sub(p0, R, k0, myq, L.hh, nm);
                bf16x8 pf[4];
                pf[0] = packfrag(p0, 0); pf[1] = packfrag(p0, 1); pf[2] = packfrag(p1, 0); pf[3] = packfrag(p1, 1);
                pv_tile(o0, o1, lds + OFF_V + bf * VBUF, pf, L);
                seen = true;
                done = __all(R < -110.0f);
            }
        }
        if (L.lane == 0) flags[(it & 1) * 8 + L.wid] = done ? 1 : 0;
        if (t > 0) SB_WRITE((it + 1) & 1);
        __syncthreads();
        int alld = 1;
#pragma unroll
        for (int w = 0; w < 8; ++w) alld &= flags[(it & 1) * 8 + w];
        if (alld) break;
    }
#undef SB_LOAD
#undef SB_WRITE
    store_o(O + (rowbase + myq) * DM + h * 64, o0, o1, 1.0f, L.hh);
    __syncthreads();
}
}

#define XB_TMO      128
#define XB_XCNT(j)  (256  + 64 * (j))
#define XB_XSUB(j)  (1280 + 64 * (j))
#define XB_XGEN(j)  (2304 + 64 * (j))
#define XB_TOP      3328
#define XB_TOPGEN   3392
#define XCD_BAR_WORDS 3456
#define XB_SPIN_CAP (1u << 18)

__device__ __forceinline__ unsigned xb_ld(unsigned* p)              { return __hip_atomic_load(p, __ATOMIC_RELAXED, __HIP_MEMORY_SCOPE_AGENT); }
__device__ __forceinline__ unsigned xb_add(unsigned* p, unsigned v) { return __hip_atomic_fetch_add(p, v, __ATOMIC_RELAXED, __HIP_MEMORY_SCOPE_AGENT); }
__device__ __forceinline__ unsigned xb_xcc_id() { return (unsigned)__builtin_amdgcn_s_getreg((3 << 11) | 20) & 0xFu; }
#define XB_SPIN(cond, bar) do { unsigned _sp = 0; while (cond) { __builtin_amdgcn_s_sleep(1); \
    if ((++_sp & 255u) == 0u) { if (xb_ld(&(bar)[XB_TMO])) break; if (_sp > XB_SPIN_CAP) { atomicAdd(&(bar)[XB_TMO], 1u); break; } } } } while (0)

struct XcdBarrier {
    unsigned* bar; unsigned x;
    volatile LAS unsigned* st;
};

__device__ __forceinline__ XcdBarrier xcd_barrier_post(unsigned* bar, volatile LAS unsigned* st) {
    XcdBarrier b; b.bar = bar; b.x = xb_xcc_id(); b.st = st;
    if (threadIdx.x == 0) (void)xb_add(&bar[XB_XCNT(b.x)], 1u);
    return b;
}
__device__ __forceinline__ void xcd_barrier_complete(unsigned* bar, unsigned x, unsigned& nloc, unsigned& nx) {
    const unsigned G = gridDim.x * gridDim.y * gridDim.z;
    unsigned sum, cnt, mine, sp = 0u;
    for (;;) {
        sum = 0u; cnt = 0u; mine = 0u;
#pragma unroll
        for (unsigned j = 0; j < 16; ++j) { const unsigned c = xb_ld(&bar[XB_XCNT(j)]); sum += c; cnt += (c > 0u) ? 1u : 0u; mine = (j == x) ? c : mine; }
        if (sum == G) break;
        __builtin_amdgcn_s_sleep(1);
        if ((++sp & 255u) == 0u) { if (xb_ld(&bar[XB_TMO])) break; if (sp > XB_SPIN_CAP) { atomicAdd(&bar[XB_TMO], 1u); break; } }
    }
    nloc = mine > 0u ? mine : 1u; nx = cnt > 0u ? cnt : 1u;
}

__device__ __forceinline__ void xcd_barrier(const XcdBarrier& b) {
    asm volatile("s_waitcnt vmcnt(0)" ::: "memory");
    __syncthreads();
    if (threadIdx.x == 0) {
        unsigned* bar = b.bar;
        __builtin_amdgcn_s_waitcnt(0);
        unsigned nloc = b.st[0], nx = b.st[1];
        if (nloc == 0u) { xcd_barrier_complete(bar, b.x, nloc, nx); b.st[0] = nloc; b.st[1] = nx; }
        const unsigned old = xb_add(&bar[XB_XSUB(b.x)], 1u);
        const unsigned gen = old / nloc;
        if (old + 1u == (gen + 1u) * nloc) {
            __builtin_amdgcn_fence(__ATOMIC_RELEASE, "agent");
            asm volatile("s_waitcnt vmcnt(0)" ::: "memory");
            const unsigned og = xb_add(&bar[XB_TOP], 1u);
            const unsigned tg = og / nx;
            if (og + 1u == (tg + 1u) * nx) xb_add(&bar[XB_TOPGEN], 1u);
            else XB_SPIN(xb_ld(&bar[XB_TOPGEN]) == tg, bar);
            __builtin_amdgcn_fence(__ATOMIC_ACQUIRE, "agent");
            xb_add(&bar[XB_XGEN(b.x)], 1u);
            asm volatile("s_waitcnt vmcnt(0)" ::: "memory");
        } else {
            XB_SPIN(xb_ld(&bar[XB_XGEN(b.x)]) == gen, bar);
            __builtin_amdgcn_fence(__ATOMIC_ACQUIRE, "agent");
            asm volatile("s_waitcnt vmcnt(0)" ::: "memory");
        }
    }
    __syncthreads();
}


constexpr int RSTD_OFF = 131072 + 1024;
DI void rstd_prepass(LAS unsigned char* lds, const pg8::StaticOrder& S, const float* ssq, int tid) {
    LAS float* tab = (LAS float*)(lds + RSTD_OFF);
    pg8::Unit u;
#pragma unroll 1
    for (int i = 0; i < 4 && S.next(i, u); ++i) {
        const int r = tid >> 1, hf = tid & 1;
        const f32x4* sp = (const f32x4*)(ssq + (size_t)(u.pm * 256 + r) * 16 + hf * 8);
        const f32x4 a = sp[0], b = sp[1];
        float t = ((a[0] + a[1]) + (a[2] + a[3])) + ((b[0] + b[1]) + (b[2] + b[3]));
        t += __shfl_xor(t, 1);
        if (hf == 0) tab[i * 256 + r] = 1.0f / sqrtf(t * (1.0f / 1024.0f) + EPS);
    }
    __syncthreads();
}

DI void rstd_prepass_lr(LAS unsigned char* lds, const pg8::StaticOrder& S, const float* ssq2, int g0, int nq4, float inv_width, int tid) {
    LAS float* tab = (LAS float*)(lds + RSTD_OFF);
    pg8::Unit u;
    if (S.next(0, u)) {
        if (tid < 256) {
            const f32x4* sp = (const f32x4*)(ssq2 + (size_t)(u.pm * 256 + tid) * 32 + g0);
            float t = 0.f;
            for (int i = 0; i < nq4; ++i) { const f32x4 a = sp[i]; t += (a[0] + a[1]) + (a[2] + a[3]); }
            tab[tid] = 1.0f / sqrtf(t * inv_width + EPS);
        }
    }
    __syncthreads();
}
struct Params {
    const float* x; const int* pos; const float* norm_mix; const float* norm_mlp; const float* norm_final;
    const float* w_in_ab; const float* b_forget; const float* rel_bias; const float* w_out_ab;
    const float* w_in_cd; const float* q_norm; const float* kv_norm; const float* w_uq; const float* w_ukv; const float* w_out_cd;
    const float* w_up; const float* w_down;
    float* out; unsigned char* ws; int ph_lo, ph_hi, coop, pad;
};
constexpr int N_PHASES = 17;

__global__ void __launch_bounds__(NTHREADS) fwd_kernel(Params P) {
    extern __shared__ __attribute__((aligned(16))) unsigned char lds_raw[];
    LAS unsigned char* lds = (LAS unsigned char*)lds_raw;
    const int tid = threadIdx.x, lane = tid & 63, wave = __builtin_amdgcn_readfirstlane(tid >> 6);
    const int G = gridDim.x, bx = blockIdx.x;
    const int vcu = (G % 8 == 0) ? (bx % 8) * (G / 8) + bx / 8 : bx;
    const int gw = vcu * NWAVES + wave, ngw = G * NWAVES;
    unsigned char* ws = P.ws;
    bf16_t* WinAB = (bf16_t*)(ws + WS_WINAB); bf16_t* WoutAB = (bf16_t*)(ws + WS_WOUTAB); bf16_t* WinCD = (bf16_t*)(ws + WS_WINCD);
    bf16_t* Wuq = (bf16_t*)(ws + WS_WUQ); bf16_t* Wukv = (bf16_t*)(ws + WS_WUKV); bf16_t* WoutCD = (bf16_t*)(ws + WS_WOUTCD);
    bf16_t* Wup0 = (bf16_t*)(ws + WS_WUP0); bf16_t* Wup1 = (bf16_t*)(ws + WS_WUP1); bf16_t* Wdn0 = (bf16_t*)(ws + WS_WDN0); bf16_t* Wdn1 = (bf16_t*)(ws + WS_WDN1);
    float* LOGF = (float*)(ws + WS_LOGF); float* CUM = (float*)(ws + WS_CUM); float* TAB = (float*)(ws + WS_TAB); bf16_t* KR = (bf16_t*)(ws + WS_KR); float* SSQ = (float*)(ws + WS_SSQ); float* SSQ2 = (float*)(ws + WS_SSQ2); unsigned* KN2 = (unsigned*)(ws + WS_CTL + CTL_KN2);
    bf16_t* XN = (bf16_t*)(ws + WS_XN); bf16_t* CQN = (bf16_t*)(ws + WS_CQN); bf16_t* CKVN = (bf16_t*)(ws + WS_CKVN); bf16_t* OB = (bf16_t*)(ws + WS_O);
    bf16_t* BIG = (bf16_t*)(ws + WS_BIG); bf16_t* QF = (bf16_t*)(ws + WS_QF); bf16_t* KVF = (bf16_t*)(ws + WS_KVF);
    cg::grid_group grid = cg::this_grid();
    volatile LAS unsigned* MISC = (volatile LAS unsigned*)(lds + MISC_OFF);
    if (tid < 32) MISC[tid] = 0u;
    __syncthreads();
    XcdBarrier bar; bar.bar = (unsigned*)(ws + WS_CTL); bar.x = 0; bar.st = nullptr;
    if (P.coop) bar = xcd_barrier_post((unsigned*)(ws + WS_CTL), MISC + 8);
    const int lo = P.ph_lo, hi = P.ph_hi;
#ifndef PHMASK
#define PHMASK 0x1ffff
#endif
#define IN(k) (((PHMASK >> (k)) & 1) && lo <= (k) && (k) < hi)
#ifndef REPMASK
#define REPMASK 0
#endif
#define REP(k) ((REPMASK >> (k)) & 1)
#ifndef REPKMASK
#define REPKMASK 0
#endif
#define REPK(k) ((REPKMASK >> (k)) & 1)
#define SEAM(k) do { if (P.coop && (k) + 1 < hi) { if (P.coop == 2) grid.sync(); else xcd_barrier(bar); } } while (0)

    if (IN(0)) {
        LAS float* scr = (LAS float*)(lds + wave * 8704);
        for (int it = gw; ; it += ngw) {
            int r = it; bool hit = false;
#define TR(W, K, LDN, C0, NC, WT, R0, GN) if (!hit) { const int n_it = ((K) / 64) * ((NC) / 32); if (r < n_it) { transpose_item((W), (K), (LDN), (C0), (WT), (R0), (NC) / 32, scr, r, lane, (GN)); hit = true; } else r -= n_it; }
            TR(P.w_in_ab, 1024, NSRC_AB, 0, 1536, WinAB, 0, nullptr)
            TR(P.w_in_ab, 1024, NSRC_AB, 1544, 1536, WinAB, 1536, nullptr)
            TR(P.w_out_ab, 1024, 1024, 0, 1024, WoutAB, 0, nullptr)
            TR(P.w_in_cd, 1024, NSRC_CD, 0, NSRC_CD, WinCD, 0, P.norm_mix + DM)
            TR(P.w_up, 1024, 4096, 0, 4096, Wup0, 0, P.norm_mlp)
            TR(P.w_down, 4096, 1024, 0, 1024, Wdn0, 0, nullptr)
#undef TR
            if (!hit) break;
        }
        for (int i = (vcu * NTHREADS + tid); i < 96 * 1024 / 8; i += G * NTHREADS) ((u32x4*)(WinCD + (size_t)2208 * 1024))[i] = (u32x4){0u, 0u, 0u, 0u};
        __syncthreads();
        LAS float* wfaT = (LAS float*)lds;
        for (int i = tid; i < 8192; i += NTHREADS) { const int k = i >> 3, j = i & 7; wfaT[j * 1024 + k] = P.w_in_ab[(size_t)k * NSRC_AB + 1536 + j]; }
        __syncthreads();
        norm_rows_bf16<true>(P.x, P.norm_mix, XN, gw, ngw, lane, wfaT, P.b_forget, LOGF, P.pos, TAB);
        __syncthreads();
        SEAM(0);
    }
    if (IN(1)) {
        if (vcu < 32) {
            const int b = vcu >> 3, h = vcu & 7; LAS float* sc = (LAS float*)lds;
            float v[8]; float run = 0.f;
#pragma unroll
            for (int e = 0; e < 8; ++e) { run += LOGF[((size_t)b * SEQ + tid * 8 + e) * 8 + h]; v[e] = run; }
            sc[tid] = run; __syncthreads();
            for (int off = 1; off < NTHREADS; off <<= 1) { const float add = (tid >= off) ? sc[tid - off] : 0.f; __syncthreads(); sc[tid] += add; __syncthreads(); }
            const float base = sc[tid] - run;
#pragma unroll
            for (int e = 0; e < 8; ++e) CUM[(size_t)(b * 8 + h) * SEQ + tid * 8 + e] = base + v[e];
            __syncthreads();
        }
        pg8::Gemm g{XN, WinAB, MT, LD_AB, DM}; pg8::StaticOrder S; S.init(MT, LD_AB, G, bx);
        pg8::EpiStoreAB E{BIG, LD_AB, KN2};
        pg8::gemm_phase<pg8::EpiStoreAB, pg8::StaticOrder, true, true>(lds, g, S, E);
        SEAM(1);
    }
    if (IN(2)) {
        const int bh = vcu >> 3, s = vcu & 7, b = bh >> 3, h = bh & 7;
        for (int rep = 0; rep <= REPK(2); ++rep) {
            att::fox_unit(lds, BIG, CUM, KN2, OB, b, h, 15 - s);
            att::fox_unit(lds, BIG, CUM, KN2, OB, b, h, s);
            att::chk_unit(lds, BIG, P.rel_bias, OB, b, h, 2 * s);
            att::chk_unit(lds, BIG, P.rel_bias, OB, b, h, 2 * s + 1);
        }
        SEAM(2);
    }
    if (IN(3)) {
        pg8::Gemm g{OB, WoutAB, MT, DM, DM}; pg8::StaticOrder S; S.init(MT, DM, G, bx);
        pg8::EpiResidB<1> E{P.x, XN, SSQ, DM};
        pg8::gemm_phase<pg8::EpiResidB<1>, pg8::StaticOrder, true, true>(lds, g, S, E);
        SEAM(3);
    }
    if (IN(5)) {
        pg8::Gemm g{XN, Wup0, MT, DFF, DM}; pg8::StaticOrder S; S.init(MT, DFF, G, bx);
        rstd_prepass(lds, S, SSQ, tid);
        pg8::EpiStore<1, 1> E{BIG, DFF, (const LAS float*)(lds + RSTD_OFF), 0};
        pg8::gemm_phase<pg8::EpiStore<1, 1>, pg8::StaticOrder, true, true>(lds, g, S, E);
        SEAM(5);
    }
    if (IN(6)) {
        pg8::Gemm g{BIG, Wdn0, MT, DM, DFF}; pg8::StaticOrder S; S.init(MT, DM, G, bx);
        pg8::EpiResidB<0> E{nullptr, XN, SSQ, DM};
        pg8::gemm_phase<pg8::EpiResidB<0>, pg8::StaticOrder, true, true>(lds, g, S, E);
        SEAM(6);
    }
    if (IN(8)) {
        pg8::Gemm g{XN, WinCD, MT, LD_CD, DM}; pg8::StaticOrder S; S.init(MT, LD_CD, G, bx);
        rstd_prepass(lds, S, SSQ, tid);
        pg8::EpiStoreCD E{BIG, LD_CD, (const LAS float*)(lds + RSTD_OFF), SSQ2, KR, TAB, 0};
        pg8::gemm_phase<pg8::EpiStoreCD, pg8::StaticOrder, true, true>(lds, g, S, E);
        if (G == 256 ? bx >= 64 : true) {
            const int nidle = (G == 256) ? 192 : G, iw = ((G == 256) ? bx - 64 : bx) * NWAVES + wave;
            LAS float* scr = (LAS float*)(lds + wave * 8704);
            for (int it = iw; ; it += nidle * NWAVES) {
                int r = it; bool hit = false;
#define TR(W, K, LDN, C0, NC, WT, R0, GN) if (!hit) { const int n_it = ((K) / 64) * ((NC) / 32); if (r < n_it) { transpose_item((W), (K), (LDN), (C0), (WT), (R0), (NC) / 32, scr, r, lane, (GN)); hit = true; } else r -= n_it; }
                TR(P.w_uq, 384, 768, 0, 768, Wuq, 0, P.q_norm)
                TR(P.w_ukv, 256, 1024, 0, 1024, Wukv, 0, P.kv_norm)
                TR(P.w_out_cd, 1024, 1024, 0, 1024, WoutCD, 0, nullptr)
                TR(P.w_up + (size_t)1024 * 4096, 1024, 4096, 0, 4096, Wup1, 0, P.norm_mlp + DM)
                TR(P.w_down + (size_t)4096 * 1024, 4096, 1024, 0, 1024, Wdn1, 0, nullptr)
#undef TR
                if (!hit) break;
            }
        }
        SEAM(8);
    }
    if (IN(10)) {
#ifndef P10SEL
#define P10SEL 3
#endif
        { pg8::Gemm g{BIG + 1536, Wuq, MT, 768, 384 + P.pad, LD_CD};
          pg8::StaticOrder S; S.init(MT, 768, G, bx);
          rstd_prepass_lr(lds, S, SSQ2, 0, 3, 1.0f / 384.0f, tid);
          pg8::EpiQRope E{QF, 768, TAB, (const LAS float*)(lds + RSTD_OFF)};
          pg8::gemm_phase<pg8::EpiQRope, pg8::StaticOrder, true, true>(lds, g, S, E); }
        { pg8::Gemm g{BIG + 1920, Wukv, MT, 1024, 256 + P.pad, LD_CD}; pg8::StaticOrder S; S.init(MT, 1024, G, bx);
          rstd_prepass_lr(lds, S, SSQ2, 12, 2, 1.0f / 256.0f, tid);
          pg8::EpiStore<0, 1> E{KVF, 1024, (const LAS float*)(lds + RSTD_OFF), 0};
          pg8::gemm_phase<pg8::EpiStore<0, 1>, pg8::StaticOrder, true, true>(lds, g, S, E); }
        SEAM(10);
    }
    if (IN(11)) {
        const int bh = vcu >> 3, s = vcu & 7, b = bh >> 3, h = bh & 7;
        for (int rep = 0; rep <= REPK(11); ++rep) {
            att::mla_unit(lds, QF, KVF, KR, OB, b, h, 15 - s);
            att::mla_unit(lds, QF, KVF, KR, OB, b, h, s);
            att::sb_unit(lds, BIG, OB, b, h, 15 - s);
            att::sb_unit(lds, BIG, OB, b, h, s);
        }
        SEAM(11);
    }
    if (IN(12)) {
        pg8::Gemm g{OB, WoutCD, MT, DM, DM}; pg8::StaticOrder S; S.init(MT, DM, G, bx);
        pg8::EpiResidB<0> E{nullptr, XN, SSQ, DM};
        pg8::gemm_phase<pg8::EpiResidB<0>, pg8::StaticOrder, true, true>(lds, g, S, E);
        SEAM(12);
    }
    if (IN(14)) {
        pg8::Gemm g{XN, Wup1, MT, DFF, DM}; pg8::StaticOrder S; S.init(MT, DFF, G, bx);
        rstd_prepass(lds, S, SSQ, tid);
        pg8::EpiStore<1, 1> E{BIG, DFF, (const LAS float*)(lds + RSTD_OFF), 0};
        pg8::gemm_phase<pg8::EpiStore<1, 1>, pg8::StaticOrder, true, true>(lds, g, S, E);
        SEAM(14);
    }
    if (IN(15)) {
        pg8::Gemm g{BIG, Wdn1, MT, DM, DFF}; pg8::StaticOrder S; S.init(MT, DM, G, bx);
        pg8::EpiResidB<0> E{nullptr, XN, SSQ, DM};
        pg8::gemm_phase<pg8::EpiResidB<0>, pg8::StaticOrder, true, true>(lds, g, S, E);
        SEAM(15);
    }
    if (IN(16)) { norm_rows_final(XN, P.out, P.norm_final, gw, ngw, lane); }
#undef IN
#undef SEAM
}

#ifndef MK_MULTI_LAUNCH
#define MK_MULTI_LAUNCH 0
#endif
extern "C" void kernel_launch(void* const* d_in, const int* in_sizes, int n_in, void* d_out, int out_size, void* d_ws, size_t ws_size, hipStream_t stream) {
    static int grid = 0;
    if (grid == 0) {
        if (n_in != 17 || out_size != MT * DM || ws_size < WS_END) { fprintf(stderr, "kernel_launch: unexpected problem (n_in %d out %d ws %zu)\n", n_in, out_size, ws_size); grid = -1; return; }
        int dev = 0, cus = 0, per_cu = 0;
        hipGetDevice(&dev); hipDeviceGetAttribute(&cus, hipDeviceAttributeMultiprocessorCount, dev);
        if (hipFuncSetAttribute((const void*)fwd_kernel, hipFuncAttributeMaxDynamicSharedMemorySize, LDS_BYTES) != hipSuccess) { fprintf(stderr, "kernel_launch: hipFuncSetAttribute failed\n"); grid = -1; return; }
        if (hipOccupancyMaxActiveBlocksPerMultiprocessor(&per_cu, (const void*)fwd_kernel, NTHREADS, LDS_BYTES) != hipSuccess || per_cu < 1) { fprintf(stderr, "kernel_launch: occupancy query says %d\n", per_cu); per_cu = 1; }
        (void)hipGetLastError();
        grid = cus;
        if (grid != 256) fprintf(stderr, "kernel_launch: note: %d CUs\n", grid);
    }
    if (grid < 0) return;
    Params p{};
    p.x = (const float*)d_in[0]; p.pos = (const int*)d_in[1]; p.norm_mix = (const float*)d_in[2]; p.norm_mlp = (const float*)d_in[3]; p.norm_final = (const float*)d_in[4];
    p.w_in_ab = (const float*)d_in[5]; p.b_forget = (const float*)d_in[6]; p.rel_bias = (const float*)d_in[7]; p.w_out_ab = (const float*)d_in[8];
    p.w_in_cd = (const float*)d_in[9]; p.q_norm = (const float*)d_in[10]; p.kv_norm = (const float*)d_in[11]; p.w_uq = (const float*)d_in[12]; p.w_ukv = (const float*)d_in[13]; p.w_out_cd = (const float*)d_in[14];
    p.w_up = (const float*)d_in[15]; p.w_down = (const float*)d_in[16];
    p.out = (float*)d_out; p.ws = (unsigned char*)d_ws;
    if (hipMemsetAsync((char*)d_ws + WS_CTL, 0, CTL_BYTES, stream) != hipSuccess) { fprintf(stderr, "kernel_launch: hipMemsetAsync failed\n"); return; }
#if MK_MULTI_LAUNCH
    for (int ph = 0; ph < N_PHASES; ++ph) {
        p.ph_lo = ph; p.ph_hi = ph + 1; p.coop = 0;
        hipLaunchKernelGGL(fwd_kernel, dim3(grid), dim3(NTHREADS), LDS_BYTES, stream, p);
        if (REP(ph)) hipLaunchKernelGGL(fwd_kernel, dim3(grid), dim3(NTHREADS), LDS_BYTES, stream, p);
    }
#else
    p.ph_lo = 0; p.ph_hi = N_PHASES; p.coop = 1;
    void* args[] = {&p};
    hipError_t e = hipLaunchCooperativeKernel((const void*)fwd_kernel, dim3(grid), dim3(NTHREADS), args, LDS_BYTES, stream);
    if (e != hipSuccess) fprintf(stderr, "cooperative launch failed: %s (grid %d)\n", hipGetErrorString(e), grid);
#endif
}
```

```cpp
#include <hip/hip_runtime.h>
#include <hip/hip_cooperative_groups.h>
#include <cstdio>
#include <cstdint>
#include <cmath>
namespace cg = cooperative_groups;
namespace pg8 {
#define PG8_LAS __attribute__((address_space(3)))
typedef unsigned short bf16_t;
typedef short bf16x8 __attribute__((ext_vector_type(8)));
typedef float f32x4 __attribute__((ext_vector_type(4)));
typedef unsigned u32x4 __attribute__((ext_vector_type(4)));
constexpr int BM = 256, BK = 64, HALF = 128, HTB = HALF * BK * 2  , STAGE_BYTES = 8 * HTB, NXCD = 8, WGM = 8;

__host__ __device__ __forceinline__ int lds_byte(int r, int c) { const int st = (r >> 4) * 2 + (c >> 5), rr = r & 15, cc = c & 31, ob = rr * 64 + cc * 2; return st * 1024 + (ob ^ (((ob >> 9) & 1) << 5)); }
__host__ __device__ __forceinline__ void stage_rc(int b, int& R, int& C) { const int st = b / 1024, sb = b % 1024, swz = sb ^ (((sb >> 9) & 1) << 5); R = (st >> 1) * 16 + swz / 64; C = (st & 1) * 32 + (swz % 64) / 2; }
__host__ __device__ __forceinline__ int perm32(int rho) { const int n = rho >> 4, i = rho & 15; return 8 * (i >> 2) + 4 * n + (i & 3); }

struct Unit { int pm, pn; };
struct Gemm { const bf16_t* A; const bf16_t* Bt; int M, N, K; int lda; };

struct StaticOrder {
    int nM, nN, nwg, G, c;
    __host__ __device__ void init(int M, int N, int G_, int c_) { nM = M / BM; nN = N / BM; nwg = nM * nN; G = G_; c = c_; }
    __host__ __device__ bool next(int i, Unit& u) const {
        const long L = (long)i * G + c; if (L >= nwg) return false;
        int wgid = (int)L; { const int q = nwg / NXCD, r = nwg % NXCD, xcd = wgid % NXCD, off = wgid / NXCD; wgid = (xcd < r ? xcd * (q + 1) : r * (q + 1) + (xcd - r) * q) + off; }
        const int nig = WGM * nN, gid = wgid / nig, fm = gid * WGM, gsz = (nM - fm) < WGM ? (nM - fm) : WGM;
        u.pm = fm + ((wgid % nig) % gsz); u.pn = (wgid % nig) / gsz; return true;
    }
    __device__ __forceinline__ void a_ready(const Unit&) const {}
    __device__ __forceinline__ void done(const Unit&) const {}
};

__device__ __forceinline__ unsigned cvt_pk_bf16(float lo, float hi) { unsigned r; asm volatile("v_cvt_pk_bf16_f32 %0, %1, %2" : "=v"(r) : "v"(lo), "v"(hi)); return r; }
template <class Epi, class Sched, bool ALIGN_EPI = false, bool SP2 = false>
__device__ __forceinline__ void gemm_phase(PG8_LAS unsigned char* lds, const Gemm g, const Sched& S, const Epi& E) {
    const int tid = threadIdx.x, wid = __builtin_amdgcn_readfirstlane(tid >> 6), lane = tid & 63, wr = wid >> 2, wc = wid & 3, fr = lane & 15, fq = lane >> 4;
    const int K = g.K, nt = K / BK, LDA = g.lda ? g.lda : g.K;
    unsigned voffA[2], voffB[2];
#pragma unroll
    for (int i = 0; i < 2; ++i) { int R, C; stage_rc(tid * 16 + i * 8192, R, C); const int Rb = Epi::PERM ? ((R & ~31) + perm32(R & 31)) : R;
        voffA[i] = (unsigned)(R * LDA + C) * 2u; voffB[i] = (unsigned)(Rb * K + C) * 2u; }
    const size_t kstep = (size_t)(BK * 2);
    const size_t hstepB = (size_t)HALF * K * 2, hstepA = (size_t)HALF * LDA * 2;
    const size_t tstepB = 2 * hstepB, tstepA = 2 * hstepA;
    const unsigned ldsw = (unsigned)wid * 1024u;
    const int aoff = lds_byte(wr * 64 + fr, fq * 8), boff = lds_byte(wc * 32 + fr, fq * 8);
#define PG8_SA(b, h) (((b) * 2 + (h)) * HTB)
#define PG8_SB(b, h) ((4 + (b) * 2 + (h)) * HTB)
#define PG8_STAGE(bufoff, gbase, voff) do { _Pragma("unroll") for (int _i = 0; _i < 2; ++_i) \
        __builtin_amdgcn_global_load_lds((const unsigned*)((const char*)(gbase) + (voff)[_i]), (PG8_LAS unsigned*)(lds + (bufoff) + ldsw + _i * 8192), 16, 0, 0); } while (0)
#define PG8_LDA(dst, b, h) do { _Pragma("unroll") for (int m = 0; m < 4; ++m) _Pragma("unroll") for (int k = 0; k < 2; ++k) dst[m][k] = *(const PG8_LAS bf16x8*)(lds + PG8_SA(b, h) + aoff + m * 2048 + k * 1024); } while (0)
#define PG8_LDB(dst, b, h) do { _Pragma("unroll") for (int n = 0; n < 2; ++n) _Pragma("unroll") for (int k = 0; k < 2; ++k) dst[n][k] = *(const PG8_LAS bf16x8*)(lds + PG8_SB(b, h) + boff + n * 2048 + k * 1024); } while (0)
#define PG8_MMA(ai, bj, At, Bt) do { __builtin_amdgcn_s_setprio(1); _Pragma("unroll") for (int m = 0; m < 4; ++m) _Pragma("unroll") for (int n = 0; n < 2; ++n) _Pragma("unroll") for (int k = 0; k < 2; ++k) \
        acc[ai][bj][m][n] = __builtin_amdgcn_mfma_f32_16x16x32_bf16(Bt[n][k], At[m][k], acc[ai][bj][m][n], 0, 0, 0); __builtin_amdgcn_s_setprio(0); } while (0)
#define PG8_WAIT_V(n) asm volatile("s_waitcnt vmcnt(" #n ")" ::: "memory")
#define PG8_WAIT_L(n) asm volatile("s_waitcnt lgkmcnt(" #n ")" ::: "memory")
#define PG8_BAR __builtin_amdgcn_s_barrier()
#define PG8_SCHED __builtin_amdgcn_sched_barrier(0)
    Unit cur, nxt; int ui = 0;
    if (!S.next(0, cur)) return;
    f32x4 acc[2][2][4][2];
#pragma unroll
    for (int a = 0; a < 2; ++a)
#pragma unroll
        for (int b = 0; b < 2; ++b)
#pragma unroll
            for (int m = 0; m < 4; ++m)
#pragma unroll
                for (int n = 0; n < 2; ++n) acc[a][b][m][n] = (f32x4){0.f, 0.f, 0.f, 0.f};
    bf16x8 At[4][2], B0[2][2], B1[2][2];
    const char* cA = (const char*)g.A + (size_t)cur.pm * tstepA; const char* cB = (const char*)g.Bt + (size_t)cur.pn * tstepB;
    S.a_ready(cur);
    if constexpr (SP2) {
        PG8_STAGE(PG8_SB(0, 0), cB, voffB); PG8_STAGE(PG8_SB(0, 1), cB + hstepB, voffB); PG8_STAGE(PG8_SA(0, 0), cA, voffA); PG8_STAGE(PG8_SA(0, 1), cA + hstepA, voffA);
        if (wr == 1) PG8_BAR;
        PG8_WAIT_V(2); PG8_BAR;
        PG8_STAGE(PG8_SB(1, 0), cB + kstep, voffB); PG8_STAGE(PG8_SA(1, 0), cA + kstep, voffA); PG8_STAGE(PG8_SB(1, 1), cB + hstepB + kstep, voffB);
        PG8_WAIT_V(6); PG8_BAR;
    } else {
        PG8_STAGE(PG8_SB(0, 0), cB, voffB); PG8_STAGE(PG8_SA(0, 0), cA, voffA); PG8_STAGE(PG8_SB(0, 1), cB + hstepB, voffB); PG8_STAGE(PG8_SA(0, 1), cA + hstepA, voffA);
        if (wr == 1) PG8_BAR;
        PG8_WAIT_V(4); PG8_BAR;
        PG8_STAGE(PG8_SB(1, 0), cB + kstep, voffB); PG8_STAGE(PG8_SA(1, 0), cA + kstep, voffA); PG8_STAGE(PG8_SB(1, 1), cB + hstepB + kstep, voffB);
        PG8_WAIT_V(6); PG8_BAR;
    }
    for (;;) {
        const bool has_next = S.next(ui + 1, nxt);
        const char* nA = has_next ? (const char*)g.A + (size_t)nxt.pm * tstepA : cA; const char* nB = has_next ? (const char*)g.Bt + (size_t)nxt.pn * tstepB : cB;
        for (int t = 0; t < nt; t += 2) {
            const bool last = (t == nt - 2);
            const char* a1 = cA + (size_t)(t + 1) * kstep;
            const char* a2 = last ? nA : cA + (size_t)(t + 2) * kstep; const char* b2 = last ? nB : cB + (size_t)(t + 2) * kstep;
            const char* a3 = a2 + kstep; const char* b3 = b2 + kstep;
            if (last && has_next) S.a_ready(nxt);
            if constexpr (SP2) {
            PG8_LDB(B0, 0, 0); PG8_LDB(B1, 0, 1); PG8_SCHED; PG8_LDA(At, 0, 0); PG8_STAGE(PG8_SA(1, 1), a1 + hstepA, voffA);
            PG8_WAIT_V(8); PG8_WAIT_L(0); PG8_BAR; PG8_MMA(0, 0, At, B0); PG8_MMA(0, 1, At, B1); PG8_BAR; PG8_SCHED;
            PG8_LDA(At, 0, 1); PG8_STAGE(PG8_SB(0, 0), b2, voffB); PG8_STAGE(PG8_SB(0, 1), b2 + hstepB, voffB); PG8_STAGE(PG8_SA(0, 0), a2, voffA);
            PG8_WAIT_V(8); PG8_WAIT_L(0); PG8_BAR; PG8_MMA(1, 0, At, B0); PG8_MMA(1, 1, At, B1); PG8_BAR; PG8_SCHED;
            PG8_LDB(B0, 1, 0); PG8_LDB(B1, 1, 1); PG8_SCHED; PG8_LDA(At, 1, 0); PG8_STAGE(PG8_SA(0, 1), a2 + hstepA, voffA);
            PG8_WAIT_V(8); PG8_WAIT_L(0); PG8_BAR; PG8_MMA(0, 0, At, B0); PG8_MMA(0, 1, At, B1); PG8_BAR; PG8_SCHED;
            PG8_LDA(At, 1, 1); PG8_STAGE(PG8_SB(1, 0), b3, voffB); PG8_STAGE(PG8_SB(1, 1), b3 + hstepB, voffB); PG8_STAGE(PG8_SA(1, 0), a3, voffA);
            PG8_WAIT_V(8); PG8_WAIT_L(0); PG8_BAR; PG8_MMA(1, 0, At, B0); PG8_MMA(1, 1, At, B1); PG8_BAR; PG8_SCHED;
            } else {
            PG8_LDB(B0, 0, 0); PG8_SCHED; PG8_LDA(At, 0, 0); PG8_STAGE(PG8_SA(1, 1), a1 + hstepA, voffA);
            PG8_WAIT_L(8); PG8_BAR; PG8_WAIT_L(0); PG8_MMA(0, 0, At, B0); PG8_BAR; PG8_SCHED;
            PG8_LDB(B1, 0, 1); PG8_STAGE(PG8_SB(0, 0), b2, voffB);
            PG8_BAR; PG8_WAIT_L(0); PG8_MMA(0, 1, At, B1); PG8_BAR;
            PG8_LDA(At, 0, 1); PG8_STAGE(PG8_SA(0, 0), a2, voffA);
            PG8_BAR; PG8_WAIT_L(0); PG8_MMA(1, 0, At, B0); PG8_BAR; PG8_SCHED;
            PG8_STAGE(PG8_SB(0, 1), b2 + hstepB, voffB);
            PG8_WAIT_V(6); PG8_BAR; PG8_MMA(1, 1, At, B1); PG8_BAR;
            PG8_LDB(B0, 1, 0); PG8_SCHED; PG8_LDA(At, 1, 0); PG8_STAGE(PG8_SA(0, 1), a2 + hstepA, voffA);
            PG8_WAIT_L(8); PG8_BAR; PG8_WAIT_L(0); PG8_MMA(0, 0, At, B0); PG8_BAR; PG8_SCHED;
            PG8_LDB(B1, 1, 1); PG8_STAGE(PG8_SB(1, 0), b3, voffB);
            PG8_BAR; PG8_WAIT_L(0); PG8_MMA(0, 1, At, B1); PG8_BAR;
            PG8_LDA(At, 1, 1); PG8_STAGE(PG8_SA(1, 0), a3, voffA);
            PG8_BAR; PG8_WAIT_L(0); PG8_MMA(1, 0, At, B0); PG8_BAR; PG8_SCHED;
            PG8_STAGE(PG8_SB(1, 1), b3 + hstepB, voffB);
            PG8_WAIT_V(6); PG8_BAR; PG8_MMA(1, 1, At, B1); PG8_BAR;
            }
        }
        if constexpr (ALIGN_EPI) { if (wr == 0) PG8_BAR; }
        if constexpr (!Epi::AFTER_DRAIN) { E(acc, cur, wr, wc, fr, fq); S.done(cur); }
        if (!has_next) break;
#pragma unroll
        for (int a = 0; a < 2; ++a)
#pragma unroll
            for (int b = 0; b < 2; ++b)
#pragma unroll
                for (int m = 0; m < 4; ++m)
#pragma unroll
                    for (int n = 0; n < 2; ++n) acc[a][b][m][n] = (f32x4){0.f, 0.f, 0.f, 0.f};
        cur = nxt; cA = nA; cB = nB; ++ui;
        if constexpr (ALIGN_EPI) { if (wr == 1) PG8_BAR; }
    }
    PG8_WAIT_V(0);
    if constexpr (!ALIGN_EPI) { if (wr == 0) PG8_BAR; }
    PG8_BAR;
    if constexpr (Epi::AFTER_DRAIN) { E.fused(acc, cur, wr, wc, fr, fq, lds, wid, lane); S.done(cur); }
#undef PG8_SA
#undef PG8_SB
#undef PG8_STAGE
#undef PG8_LDA
#undef PG8_LDB
#undef PG8_MMA
#undef PG8_WAIT_V
#undef PG8_WAIT_L
#undef PG8_BAR
#undef PG8_SCHED
}
}

namespace pg8 {
template <int RELU2, int SCALE = 0> struct EpiStore {
    static constexpr bool PERM = true, AFTER_DRAIN = false;
    bf16_t* O; int ldc; const PG8_LAS float* rstd; mutable int cnt;
    __device__ __forceinline__ void operator()(const f32x4 (&acc)[2][2][4][2], const Unit& u, int wr, int wc, int fr, int fq) const {
        const int row0 = u.pm * BM + wr * 64 + fr, col0 = u.pn * BM + wc * 32 + 8 * fq;
#pragma unroll
        for (int ai = 0; ai < 2; ++ai)
#pragma unroll
            for (int m = 0; m < 4; ++m) { const int row = row0 + ai * HALF + m * 16; bf16_t* rowp = O + (size_t)row * ldc + col0;
                float rs = 1.f;
                if (SCALE) rs = rstd[cnt * 256 + wr * 64 + fr + ai * HALF + m * 16];
#pragma unroll
                for (int bj = 0; bj < 2; ++bj) { f32x4 v0 = acc[ai][bj][m][0] * rs, v1 = acc[ai][bj][m][1] * rs;
                    if (RELU2) {
#pragma unroll
                        for (int e = 0; e < 4; ++e) { const float a = fmaxf(v0[e], 0.f), b = fmaxf(v1[e], 0.f); v0[e] = a * a; v1[e] = b * b; } }
                    u32x4 w; w.x = cvt_pk_bf16(v0[0], v0[1]); w.y = cvt_pk_bf16(v0[2], v0[3]); w.z = cvt_pk_bf16(v1[0], v1[1]); w.w = cvt_pk_bf16(v1[2], v1[3]);
                    *(u32x4*)(rowp + bj * HALF) = w; } }
        if (SCALE) ++cnt;
    }
};

struct EpiStoreAB {
    static constexpr bool PERM = true, AFTER_DRAIN = false;
    bf16_t* O; int ldc; unsigned* kn2;
    __device__ __forceinline__ void operator()(const f32x4 (&acc)[2][2][4][2], const Unit& u, int wr, int wc, int fr, int fq) const {
        const int row0 = u.pm * BM + wr * 64 + fr, col0 = u.pn * BM + wc * 32 + 8 * fq;
#pragma unroll
        for (int ai = 0; ai < 2; ++ai)
#pragma unroll
            for (int m = 0; m < 4; ++m) { bf16_t* rowp = O + (size_t)(row0 + ai * HALF + m * 16) * ldc + col0;
#pragma unroll
                for (int bj = 0; bj < 2; ++bj) { const f32x4 v0 = acc[ai][bj][m][0], v1 = acc[ai][bj][m][1];
                    u32x4 w; w.x = cvt_pk_bf16(v0[0], v0[1]); w.y = cvt_pk_bf16(v0[2], v0[3]); w.z = cvt_pk_bf16(v1[0], v1[1]); w.w = cvt_pk_bf16(v1[2], v1[3]);
                    *(u32x4*)(rowp + bj * HALF) = w; } }
        if (u.pn == 2 || u.pn == 3) {
#pragma unroll
            for (int bj = 0; bj < 2; ++bj) { float mx = 0.f;
#pragma unroll
                for (int ai = 0; ai < 2; ++ai)
#pragma unroll
                    for (int m = 0; m < 4; ++m) { const f32x4 v0 = acc[ai][bj][m][0], v1 = acc[ai][bj][m][1];
                        float s = ((v0[0] * v0[0] + v0[1] * v0[1]) + (v0[2] * v0[2] + v0[3] * v0[3])) + ((v1[0] * v1[0] + v1[1] * v1[1]) + (v1[2] * v1[2] + v1[3] * v1[3]));
                        s += __shfl_xor(s, 16); s += __shfl_xor(s, 32); mx = fmaxf(mx, s); }
                mx = fmaxf(mx, __shfl_xor(mx, 1)); mx = fmaxf(mx, __shfl_xor(mx, 2)); mx = fmaxf(mx, __shfl_xor(mx, 4)); mx = fmaxf(mx, __shfl_xor(mx, 8));
                const int colb = u.pn * BM + bj * HALF + wc * 32 - 512, head = colb >> 6, half = (colb >> 5) & 1, b = u.pm >> 4;
                if (fr == 0 && fq == 0) atomicMax(kn2 + ((b * 8 + head) * 2 + half), __float_as_uint(mx * 1.02f)); }
        }
    }
};

struct EpiStoreCD {
    static constexpr bool PERM = true, AFTER_DRAIN = false;
    bf16_t* O; int ldc; const PG8_LAS float* rstd; float* ssq2; bf16_t* kr; const float* tab; mutable int cnt;
    __device__ __forceinline__ void operator()(const f32x4 (&acc)[2][2][4][2], const Unit& u, int wr, int wc, int fr, int fq) const {
        const int row0 = u.pm * BM + wr * 64 + fr, col0 = u.pn * BM + wc * 32 + 8 * fq;
#pragma unroll
        for (int ai = 0; ai < 2; ++ai)
#pragma unroll
            for (int m = 0; m < 4; ++m) { const int row = row0 + ai * HALF + m * 16; bf16_t* rowp = O + (size_t)row * ldc + col0;
                const float rs = rstd[cnt * 256 + wr * 64 + fr + ai * HALF + m * 16];
#pragma unroll
                for (int bj = 0; bj < 2; ++bj) { const f32x4 v0 = acc[ai][bj][m][0] * rs, v1 = acc[ai][bj][m][1] * rs;
                    u32x4 w; w.x = cvt_pk_bf16(v0[0], v0[1]); w.y = cvt_pk_bf16(v0[2], v0[3]); w.z = cvt_pk_bf16(v1[0], v1[1]); w.w = cvt_pk_bf16(v1[2], v1[3]);
                    *(u32x4*)(rowp + bj * HALF) = w;
                    const int cgp = u.pn * BM + bj * HALF + wc * 32;
                    if (cgp >= 1536 && cgp < 2176) {
                        float s = ((v0[0] * v0[0] + v0[1] * v0[1]) + (v0[2] * v0[2] + v0[3] * v0[3])) + ((v1[0] * v1[0] + v1[1] * v1[1]) + (v1[2] * v1[2] + v1[3] * v1[3]));
                        s += __shfl_xor(s, 16); s += __shfl_xor(s, 32);
                        if (fq == 0) ssq2[(size_t)row * 32 + ((cgp - 1536) >> 5)] = s;
                    } else if (cgp == 2176) {
                        const int i0 = 8 * (fq & 1);
                        const f32x4 c0 = *(const f32x4*)(tab + (size_t)row * 32 + i0), c1 = *(const f32x4*)(tab + (size_t)row * 32 + i0 + 4);
                        const f32x4 s0 = *(const f32x4*)(tab + (size_t)row * 32 + 16 + i0), s1 = *(const f32x4*)(tab + (size_t)row * 32 + 16 + i0 + 4);
                        f32x4 p0, p1;
#pragma unroll
                        for (int e = 0; e < 4; ++e) { p0[e] = __shfl_xor(v0[e], 32); p1[e] = __shfl_xor(v1[e], 32); }
                        f32x4 o0, o1;
                        if (fq < 2) { o0 = v0 * c0 - p0 * s0; o1 = v1 * c1 - p1 * s1; }
                        else        { o0 = v0 * c0 + p0 * s0; o1 = v1 * c1 + p1 * s1; }
                        u32x4 k; k.x = cvt_pk_bf16(o0[0], o0[1]); k.y = cvt_pk_bf16(o0[2], o0[3]); k.z = cvt_pk_bf16(o1[0], o1[1]); k.w = cvt_pk_bf16(o1[2], o1[3]);
                        *(u32x4*)(kr + (size_t)row * 32 + 8 * fq) = k;
                    } } }
        ++cnt;
    }
};
struct EpiResid {
    static constexpr bool PERM = false, AFTER_DRAIN = false;
    const float* base; float* out; int ldc;
    __device__ __forceinline__ void operator()(const f32x4 (&acc)[2][2][4][2], const Unit& u, int wr, int wc, int fr, int fq) const {
        const int row0 = u.pm * BM + wr * 64 + fr, col0 = u.pn * BM + wc * 32 + 4 * fq;
#pragma unroll
        for (int ai = 0; ai < 2; ++ai)
#pragma unroll
            for (int m = 0; m < 4; ++m) { const size_t off = (size_t)(row0 + ai * HALF + m * 16) * ldc + col0;
#pragma unroll
                for (int bj = 0; bj < 2; ++bj)
#pragma unroll
                    for (int n = 0; n < 2; ++n) { const size_t o = off + bj * HALF + n * 16; const f32x4 bs = *(const f32x4*)(base + o); *(f32x4*)(out + o) = bs + acc[ai][bj][m][n]; } }
    }
};

struct EpiResidN {
    static constexpr bool PERM = false, AFTER_DRAIN = false;
    const float* base; float* out; bf16_t* xn; float* ssq; int ldc;
    __device__ __forceinline__ void operator()(const f32x4 (&acc)[2][2][4][2], const Unit& u, int wr, int wc, int fr, int fq) const {
        typedef unsigned u32x2 __attribute__((ext_vector_type(2)));
        const int row0 = u.pm * BM + wr * 64 + fr, col0 = u.pn * BM + wc * 32 + 4 * fq;
#pragma unroll
        for (int ai = 0; ai < 2; ++ai)
#pragma unroll
            for (int m = 0; m < 4; ++m) { const int row = row0 + ai * HALF + m * 16; const size_t off = (size_t)row * ldc + col0; float s = 0.f;
#pragma unroll
                for (int bj = 0; bj < 2; ++bj)
#pragma unroll
                    for (int n = 0; n < 2; ++n) { const size_t o = off + bj * HALF + n * 16; const f32x4 v = *(const f32x4*)(base + o) + acc[ai][bj][m][n]; *(f32x4*)(out + o) = v;
                        u32x2 w; w.x = cvt_pk_bf16(v[0], v[1]); w.y = cvt_pk_bf16(v[2], v[3]); *(u32x2*)(xn + o) = w;
                        s += (v[0] * v[0] + v[1] * v[1]) + (v[2] * v[2] + v[3] * v[3]); }
                s += __shfl_xor(s, 16); s += __shfl_xor(s, 32);
                if (fq == 0) ssq[(size_t)row * 16 + u.pn * 4 + wc] = s; }
    }
};

template <int BASEF32> struct EpiResidB {
    static constexpr bool PERM = true, AFTER_DRAIN = false;
    const float* basef; bf16_t* xn; float* ssq; int ldc;
    __device__ __forceinline__ void operator()(const f32x4 (&acc)[2][2][4][2], const Unit& u, int wr, int wc, int fr, int fq) const {
        const int row0 = u.pm * BM + wr * 64 + fr, col0 = u.pn * BM + wc * 32 + 8 * fq;
#pragma unroll
        for (int ai = 0; ai < 2; ++ai)
#pragma unroll
            for (int m = 0; m < 4; ++m) { const int row = row0 + ai * HALF + m * 16; const size_t off = (size_t)row * ldc + col0; float s = 0.f;
#pragma unroll
                for (int bj = 0; bj < 2; ++bj) { const size_t o = off + bj * HALF; f32x4 b0, b1;
                    if (BASEF32) { b0 = *(const f32x4*)(basef + o); b1 = *(const f32x4*)(basef + o + 4); }
                    else { const u32x4 w = *(const u32x4*)(xn + o);
                        b0[0] = __uint_as_float(w.x << 16); b0[1] = __uint_as_float(w.x & 0xffff0000u); b0[2] = __uint_as_float(w.y << 16); b0[3] = __uint_as_float(w.y & 0xffff0000u);
                        b1[0] = __uint_as_float(w.z << 16); b1[1] = __uint_as_float(w.z & 0xffff0000u); b1[2] = __uint_as_float(w.w << 16); b1[3] = __uint_as_float(w.w & 0xffff0000u); }
                    const f32x4 v0 = acc[ai][bj][m][0] + b0, v1 = acc[ai][bj][m][1] + b1;
                    u32x4 w; w.x = cvt_pk_bf16(v0[0], v0[1]); w.y = cvt_pk_bf16(v0[2], v0[3]); w.z = cvt_pk_bf16(v1[0], v1[1]); w.w = cvt_pk_bf16(v1[2], v1[3]);
                    *(u32x4*)(xn + o) = w;
                    s += ((v0[0] * v0[0] + v0[1] * v0[1]) + (v0[2] * v0[2] + v0[3] * v0[3])) + ((v1[0] * v1[0] + v1[1] * v1[1]) + (v1[2] * v1[2] + v1[3] * v1[3])); }
                s += __shfl_xor(s, 16); s += __shfl_xor(s, 32);
                if (fq == 0) ssq[(size_t)row * 16 + u.pn * 4 + wc] = s; }
    }
};
struct EpiQRope {
    static constexpr bool PERM = false, AFTER_DRAIN = false;
    bf16_t* O; int ldc; const float* tab; const PG8_LAS float* rstd;
    __device__ __forceinline__ void operator()(const f32x4 (&acc)[2][2][4][2], const Unit& u, int wr, int wc, int fr, int fq) const {
        typedef unsigned u32x2 __attribute__((ext_vector_type(2)));
        const int row0 = u.pm * BM + wr * 64 + fr;
#pragma unroll
        for (int ai = 0; ai < 2; ++ai)
#pragma unroll
            for (int m = 0; m < 4; ++m) { const int row = row0 + ai * HALF + m * 16;
                const f32x4 cs = *(const f32x4*)(tab + (size_t)row * 32 + 4 * fq), sn = *(const f32x4*)(tab + (size_t)row * 32 + 16 + 4 * fq);
                const float rs = rstd[wr * 64 + fr + ai * HALF + m * 16];
#pragma unroll
                for (int bj = 0; bj < 2; ++bj) { const int cgp = u.pn * BM + bj * HALF + wc * 32;
                    f32x4 x1 = acc[ai][bj][m][0] * rs, x2 = acc[ai][bj][m][1] * rs;
                    if ((cgp % 96) == 64) { const f32x4 o1 = x1 * cs - x2 * sn, o2 = x2 * cs + x1 * sn; x1 = o1; x2 = o2; }
                    bf16_t* op = O + (size_t)row * ldc + cgp + 4 * fq;
                    u32x2 w1, w2; w1.x = cvt_pk_bf16(x1[0], x1[1]); w1.y = cvt_pk_bf16(x1[2], x1[3]); w2.x = cvt_pk_bf16(x2[0], x2[1]); w2.y = cvt_pk_bf16(x2[2], x2[3]);
                    *(u32x2*)op = w1; *(u32x2*)(op + 16) = w2; }
                asm volatile("" ::: "memory"); }
    }
};
}

#define DI __device__ __forceinline__
#define LAS __attribute__((address_space(3)))
typedef unsigned short bf16_t;
typedef short bf16x8 __attribute__((ext_vector_type(8)));
typedef short s16x4 __attribute__((ext_vector_type(4)));
typedef float f32x4 __attribute__((ext_vector_type(4)));
typedef float f32x16 __attribute__((ext_vector_type(16)));
typedef unsigned u32x4 __attribute__((ext_vector_type(4)));
typedef unsigned u32x2 __attribute__((ext_vector_type(2)));

constexpr int BATCH = 4, SEQ = 4096, DM = 1024, MT = BATCH * SEQ, DFF = 4096;
constexpr int LD_AB = 3072, LD_CD = 2304, NSRC_AB = 3080, NSRC_CD = 2208;
constexpr int NWAVES = 8, NTHREADS = 512;
constexpr float LOG2E = 1.4426950408889634f, LN2 = 0.6931471805599453f, EPS = 1e-6f;
constexpr size_t MiB = 1u << 20;
constexpr size_t WS_WINAB = 0, WS_WOUTAB = 6 * MiB, WS_WINCD = 8 * MiB, WS_WUQ = 13 * MiB, WS_WUKV = 14 * MiB, WS_WOUTCD = 15 * MiB;
constexpr size_t WS_WUP0 = 17 * MiB, WS_WUP1 = 25 * MiB, WS_WDN0 = 33 * MiB, WS_WDN1 = 41 * MiB;
constexpr size_t WS_LOGF = 49 * MiB, WS_CUM = 49 * MiB + 512 * 1024, WS_TAB = 50 * MiB, WS_KR = 52 * MiB, WS_SSQ = 53 * MiB, WS_SSQ2 = 86 * MiB;
constexpr size_t WS_XN = 54 * MiB, WS_CQN = 54 * MiB, WS_CKVN = 66 * MiB, WS_O = 86 * MiB;
constexpr size_t WS_BIG = 118 * MiB, WS_QF = 190 * MiB, WS_KVF = 214 * MiB, WS_CTL = 246 * MiB, CTL_BYTES = 65536, CTL_KN2 = 32768, CTL_QCTR = 40960, WS_END = 247 * MiB;
constexpr int LDS_BYTES = 147456, MISC_OFF = 131072 + 320;

DI float bf2f(unsigned short v) { return __uint_as_float((unsigned)v << 16); }
DI unsigned pk2(float lo, float hi) { typedef float f2 __attribute__((ext_vector_type(2))); typedef __bf16 b2 __attribute__((ext_vector_type(2))); f2 v = {lo, hi}; b2 b = __builtin_convertvector(v, b2); return __builtin_bit_cast(unsigned, b); }
DI float wave_sum(float v) {
#pragma unroll
    for (int o = 1; o < 64; o <<= 1) v += __shfl_xor(v, o);
    return v;
}
DI float fexp2(float x) { return __builtin_amdgcn_exp2f(x); }
DI float flog2(float x) { return __builtin_amdgcn_logf(x); }

DI void transpose_item(const float* W, int K, int ldn, int src_col0, bf16_t* WT, int dst_row0, int nblk, LAS float* scr, int item, int lane, const float* gain) {
    const int kb = item / nblk, nb = item % nblk, k0 = 64 * kb, n0 = 32 * nb;
    float wv[32];
#pragma unroll
    for (int i = 0; i < 32; ++i) { const int kk = 2 * i + (lane >> 5); wv[i] = W[(size_t)(k0 + kk) * ldn + src_col0 + n0 + (lane & 31)]; }
    if (gain) {
#pragma unroll
        for (int i = 0; i < 32; ++i) wv[i] *= gain[k0 + 2 * i + (lane >> 5)]; }
#pragma unroll
    for (int i = 0; i < 32; ++i) { const int kk = 2 * i + (lane >> 5); scr[kk * 33 + (lane & 31)] = wv[i]; }
    asm volatile("s_waitcnt lgkmcnt(0)" ::: "memory");
    const int c = lane & 7;
#pragma unroll
    for (int j = 0; j < 4; ++j) { const int n = (lane >> 3) + 8 * j; const LAS float* s = scr + (8 * c) * 33 + n;
        u32x4 o; o.x = pk2(s[0 * 33], s[1 * 33]); o.y = pk2(s[2 * 33], s[3 * 33]); o.z = pk2(s[4 * 33], s[5 * 33]); o.w = pk2(s[6 * 33], s[7 * 33]);
        *(u32x4*)(WT + (size_t)(dst_row0 + n0 + n) * K + k0 + 8 * c) = o; }
    asm volatile("s_waitcnt lgkmcnt(0)" ::: "memory");
}

DI void sincos_d(double a, float& sn, float& cs);
DI float inv_freq_f(int i);
template <bool FA> DI void norm_rows_bf16(const float* src, const float* gain, bf16_t* dst, int gw, int ngw, int lane, const LAS float* wfaT, const float* b_forget, float* logf_out, const int* pos, float* tab) {
    f32x4 g[4];
#pragma unroll
    for (int j = 0; j < 4; ++j) g[j] = ((const f32x4*)gain)[64 * j + lane];
    f32x4 nx[4];
    if (gw < MT) {
#pragma unroll
        for (int j = 0; j < 4; ++j) nx[j] = ((const f32x4*)(src + (size_t)gw * DM) + lane)[64 * j]; }
    for (int row = gw; row < MT; row += ngw) {
        f32x4 v[4]; float s = 0.f;
#pragma unroll
        for (int j = 0; j < 4; ++j) v[j] = nx[j];
        if (row + ngw < MT) {
#pragma unroll
            for (int j = 0; j < 4; ++j) nx[j] = ((const f32x4*)(src + (size_t)(row + ngw) * DM) + lane)[64 * j]; }
#pragma unroll
        for (int j = 0; j < 4; ++j) { s += (v[j].x * v[j].x + v[j].y * v[j].y) + (v[j].z * v[j].z + v[j].w * v[j].w); v[j] = v[j] * g[j]; }
        float a8[8];
        if (FA) {
#pragma unroll
            for (int jj = 0; jj < 8; ++jj) { float a = 0.f;
#pragma unroll
                for (int j = 0; j < 4; ++j) { const f32x4 w = *(const LAS f32x4*)(wfaT + jj * 1024 + 256 * j + 4 * lane); a += (v[j].x * w.x + v[j].y * w.y) + (v[j].z * w.z + v[j].w * w.w); }
                a8[jj] = a; }
        }
        const float rstd = 1.0f / sqrtf(wave_sum(s) * (1.f / DM) + EPS);
        unsigned long long* o8 = (unsigned long long*)(dst + (size_t)row * DM) + lane;
#pragma unroll
        for (int j = 0; j < 4; ++j) { const f32x4 y = v[j] * rstd; o8[64 * j] = (unsigned long long)pk2(y.x, y.y) | ((unsigned long long)pk2(y.z, y.w) << 32); }
        if (FA) {
            float b4[4], c2[2], d;
            { const bool up = (lane & 32) != 0;
#pragma unroll
              for (int i = 0; i < 4; ++i) { const float keep = up ? a8[i + 4] : a8[i], send = up ? a8[i] : a8[i + 4]; b4[i] = keep + __shfl_xor(send, 32); } }
            { const bool up = (lane & 16) != 0;
#pragma unroll
              for (int i = 0; i < 2; ++i) { const float keep = up ? b4[i + 2] : b4[i], send = up ? b4[i] : b4[i + 2]; c2[i] = keep + __shfl_xor(send, 16); } }
            { const bool up = (lane & 8) != 0; const float keep = up ? c2[1] : c2[0], send = up ? c2[0] : c2[1]; d = keep + __shfl_xor(send, 8); }
            d += __shfl_xor(d, 4); d += __shfl_xor(d, 2); d += __shfl_xor(d, 1);
            if ((lane & 7) == 0) { const int j = lane >> 3; const float t = d * rstd + b_forget[j]; const float ls = fminf(t, 0.f) - log1pf(expf(-fabsf(t))); logf_out[(size_t)row * 8 + j] = ls; }
            if (lane < 16) { const float ang = (float)pos[row] * inv_freq_f(lane); float sn, cs; sincos_d((double)ang, sn, cs); tab[(size_t)row * 32 + lane] = cs; tab[(size_t)row * 32 + 16 + lane] = sn; }
        }
    }
}
DI void norm_rows_final(const bf16_t* xb, float* out, const float* gain, int gw, int ngw, int lane) {
    f32x4 g[4];
#pragma unroll
    for (int hf = 0; hf < 2; ++hf) { g[2 * hf] = *(const f32x4*)(gain + 512 * hf + 8 * lane); g[2 * hf + 1] = *(const f32x4*)(gain + 512 * hf + 8 * lane + 4); }
    for (int row = gw; row < MT; row += ngw) {
        f32x4 v[4]; float s = 0.f;
#pragma unroll
        for (int hf = 0; hf < 2; ++hf) { const u32x4 w = *(const u32x4*)(xb + (size_t)row * DM + 512 * hf + 8 * lane);
            v[2 * hf][0] = __uint_as_float(w.x << 16); v[2 * hf][1] = __uint_as_float(w.x & 0xffff0000u); v[2 * hf][2] = __uint_as_float(w.y << 16); v[2 * hf][3] = __uint_as_float(w.y & 0xffff0000u);
            v[2 * hf + 1][0] = __uint_as_float(w.z << 16); v[2 * hf + 1][1] = __uint_as_float(w.z & 0xffff0000u); v[2 * hf + 1][2] = __uint_as_float(w.w << 16); v[2 * hf + 1][3] = __uint_as_float(w.w & 0xffff0000u); }
#pragma unroll
        for (int j = 0; j < 4; ++j) s += (v[j].x * v[j].x + v[j].y * v[j].y) + (v[j].z * v[j].z + v[j].w * v[j].w);
        const float rstd = 1.0f / sqrtf(wave_sum(s) * (1.f / DM) + EPS);
#pragma unroll
        for (int hf = 0; hf < 2; ++hf) { float* op = out + (size_t)row * DM + 512 * hf + 8 * lane; *(f32x4*)op = v[2 * hf] * rstd * g[2 * hf]; *(f32x4*)(op + 4) = v[2 * hf + 1] * rstd * g[2 * hf + 1]; }
    }
}

DI void sincos_d(double a, float& sn, float& cs) {
    const double n = rint(a * 0.63661977236758134308);
    const double r = fma(-n, 1.5707963267948966192, a) - n * 6.123233995736766e-17;
    const double r2 = r * r;
    double sp = -2.5052108385441718775e-8; sp = sp * r2 + 2.7557319223985890653e-6; sp = sp * r2 - 1.9841269841269841270e-4; sp = sp * r2 + 8.3333333333333333333e-3; sp = sp * r2 - 1.6666666666666666667e-1; sp = r + r * r2 * sp;
    double cp = 2.0876756987868098979e-9; cp = cp * r2 - 2.7557319223985890653e-7; cp = cp * r2 + 2.4801587301587301587e-5; cp = cp * r2 - 1.3888888888888888889e-3; cp = cp * r2 + 4.1666666666666666667e-2; cp = cp * r2 - 0.5; cp = 1.0 + r2 * cp;
    const int q = (int)((long long)n & 3);
    const double s_ = (q == 0) ? sp : (q == 1) ? cp : (q == 2) ? -sp : -cp;
    const double c_ = (q == 0) ? cp : (q == 1) ? -sp : (q == 2) ? -cp : sp;
    sn = (float)s_; cs = (float)c_;
}
DI float inv_freq_f(int i) {
    float r = 1.0f;
    r = (i == 1) ? 0.56234132519034908f : r;
    r = (i == 2) ? 0.31622776601683794f : r;
    r = (i == 3) ? 0.17782794100389228f : r;
    r = (i == 4) ? 0.1f : r;
    r = (i == 5) ? 0.056234132519034911f : r;
    r = (i == 6) ? 0.031622776601683791f : r;
    r = (i == 7) ? 0.017782794100389229f : r;
    r = (i == 8) ? 0.01f : r;
    r = (i == 9) ? 0.0056234132519034910f : r;
    r = (i == 10) ? 0.0031622776601683794f : r;
    r = (i == 11) ? 0.0017782794100389228f : r;
    r = (i == 12) ? 0.001f : r;
    r = (i == 13) ? 0.00056234132519034907f : r;
    r = (i == 14) ? 0.00031622776601683794f : r;
    r = (i == 15) ? 0.00017782794100389227f : r;
    return r;
}
DI void mla_prep_rows(const bf16_t* PC, const int* pos, const float* q_norm, const float* kv_norm, bf16_t* cqn, bf16_t* ckvn, float* tab, bf16_t* KR, int gw, int ngw, int lane) {
    for (int row = gw; row < MT; row += ngw) {
        const bf16_t* pr = PC + (size_t)row * LD_CD;
        {
            float v[8]; float s = 0.f;
            if (lane < 48) { const u32x4 w = *(const u32x4*)(pr + 1536 + 8 * lane);
#pragma unroll
                for (int e = 0; e < 4; ++e) { v[2 * e] = __uint_as_float(w[e] << 16); v[2 * e + 1] = __uint_as_float(w[e] & 0xffff0000u); s += v[2 * e] * v[2 * e] + v[2 * e + 1] * v[2 * e + 1]; } }
            else {
#pragma unroll
                for (int e = 0; e < 8; ++e) v[e] = 0.f; }
            const float rstd = 1.0f / sqrtf(wave_sum(s) * (1.f / 384.f) + EPS);
            if (lane < 48) { const f32x4 g0 = *(const f32x4*)(q_norm + 8 * lane), g1 = *(const f32x4*)(q_norm + 8 * lane + 4);
                u32x4 o; o.x = pk2(v[0] * rstd * g0.x, v[1] * rstd * g0.y); o.y = pk2(v[2] * rstd * g0.z, v[3] * rstd * g0.w); o.z = pk2(v[4] * rstd * g1.x, v[5] * rstd * g1.y); o.w = pk2(v[6] * rstd * g1.z, v[7] * rstd * g1.w);
                *(u32x4*)(cqn + (size_t)row * 384 + 8 * lane) = o; }
        }
        {
            float v[8]; float s = 0.f;
            if (lane < 32) { const u32x4 w = *(const u32x4*)(pr + 1920 + 8 * lane);
#pragma unroll
                for (int e = 0; e < 4; ++e) { v[2 * e] = __uint_as_float(w[e] << 16); v[2 * e + 1] = __uint_as_float(w[e] & 0xffff0000u); s += v[2 * e] * v[2 * e] + v[2 * e + 1] * v[2 * e + 1]; } }
            else {
#pragma unroll
                for (int e = 0; e < 8; ++e) v[e] = 0.f; }
            const float rstd = 1.0f / sqrtf(wave_sum(s) * (1.f / 256.f) + EPS);
            if (lane < 32) { const f32x4 g0 = *(const f32x4*)(kv_norm + 8 * lane), g1 = *(const f32x4*)(kv_norm + 8 * lane + 4);
                u32x4 o; o.x = pk2(v[0] * rstd * g0.x, v[1] * rstd * g0.y); o.y = pk2(v[2] * rstd * g0.z, v[3] * rstd * g0.w); o.z = pk2(v[4] * rstd * g1.x, v[5] * rstd * g1.y); o.w = pk2(v[6] * rstd * g1.z, v[7] * rstd * g1.w);
                *(u32x4*)(ckvn + (size_t)row * 256 + 8 * lane) = o; }
        }
        if (lane < 16) {
            const float cs = tab[(size_t)row * 32 + lane], sn = tab[(size_t)row * 32 + 16 + lane];
            const float x1 = bf2f(pr[2176 + lane]), x2 = bf2f(pr[2176 + 16 + lane]);
            KR[(size_t)row * 32 + lane] = (bf16_t)(pk2(x1 * cs - x2 * sn, 0.f) & 0xffffu);
            KR[(size_t)row * 32 + 16 + lane] = (bf16_t)(pk2(x2 * cs + x1 * sn, 0.f) & 0xffffu);
        }
    }
}

namespace att {
constexpr int KBUF = 13312, VBUF = 9216;
constexpr int OFF_K = 0, OFF_V = 2 * KBUF, OFF_C = OFF_V + 2 * VBUF, OFF_RB = OFF_C + 512, OFF_FLAG = OFF_RB + 1280, ATT_LDS = OFF_FLAG + 64;
DI f32x16 mfma(bf16x8 a, bf16x8 b, f32x16 c) { return __builtin_amdgcn_mfma_f32_32x32x16_bf16(a, b, c, 0, 0, 0); }
DI int crow(int i, int hh) { return (i & 3) + 8 * (i >> 2) + 4 * hh; }
DI bf16x8 packfrag(const f32x16& p, int s) { u32x4 w; w.x = pk2(p[8 * s], p[8 * s + 1]); w.y = pk2(p[8 * s + 2], p[8 * s + 3]); w.z = pk2(p[8 * s + 4], p[8 * s + 5]); w.w = pk2(p[8 * s + 6], p[8 * s + 7]); return __builtin_bit_cast(bf16x8, w); }
typedef short v4i16_t __attribute__((ext_vector_type(4)));
DI s16x4 vtr(const LAS unsigned char* p) { return __builtin_bit_cast(s16x4, __builtin_amdgcn_ds_read_tr16_b64_v4i16((LAS v4i16_t*)p)); }

struct Lane { int tid, lane, wid, r, hh, q4, p4, blk, srow, sch; };
DI Lane mklane() { Lane L; L.tid = threadIdx.x; L.lane = L.tid & 63; L.wid = __builtin_amdgcn_readfirstlane(L.tid >> 6); L.r = L.lane & 31; L.hh = L.lane >> 5;
    const int i16 = L.lane & 15; L.q4 = i16 >> 2; L.p4 = i16 & 3; L.blk = (L.lane >> 4) & 1; L.srow = L.tid >> 3; L.sch = L.tid & 7; return L; }

template <int NDS, int KSTRIDE> DI void qk_tile(f32x16& p0, f32x16& p1, const LAS unsigned char* Kb, const bf16x8* qf, const Lane& L) {
    const LAS unsigned char* ka = Kb + L.r * KSTRIDE + L.hh * 16;
#pragma unroll
    for (int i = 0; i < 16; ++i) { p0[i] = 0.f; p1[i] = 0.f; }
#pragma unroll
    for (int ds = 0; ds < NDS; ++ds) {
        const bf16x8 a0 = *(const LAS bf16x8*)(ka + ds * 32), a1 = *(const LAS bf16x8*)(ka + 32 * KSTRIDE + ds * 32);
        p0 = mfma(a0, qf[ds], p0); p1 = mfma(a1, qf[ds], p1); }
}
DI void pv_tile(f32x16& o0, f32x16& o1, const LAS unsigned char* Vb, const bf16x8 (&pf)[4], const Lane& L) {
    const LAS unsigned char* vb = Vb + (4 * L.hh + L.q4) * 144 + (16 * L.blk + 4 * L.p4) * 2;
#pragma unroll
    for (int f = 0; f < 4; ++f) { const LAS unsigned char* base = vb + (16 * f) * 144;
        { const s16x4 lo = vtr(base), hi = vtr(base + 8 * 144); const bf16x8 vf = __builtin_shufflevector(lo, hi, 0, 1, 2, 3, 4, 5, 6, 7); o0 = mfma(vf, pf[f], o0); }
        { const s16x4 lo = vtr(base + 64), hi = vtr(base + 8 * 144 + 64); const bf16x8 vf = __builtin_shufflevector(lo, hi, 0, 1, 2, 3, 4, 5, 6, 7); o1 = mfma(vf, pf[f], o1); } }
}
DI void online_softmax(f32x16& p0, f32x16& p1, float& m, float& l, f32x16& o0, f32x16& o1, bf16x8 (&pf)[4]) {
    float mt = fmaxf(p0[0], p1[0]);
#pragma unroll
    for (int i = 1; i < 16; ++i) mt = fmaxf(mt, fmaxf(p0[i], p1[i]));
    mt = fmaxf(mt, __shfl_xor(mt, 32));
    if (__any(mt > m)) {
        const float mn = fmaxf(m, mt), alpha = fexp2(m - mn); m = mn; l *= alpha;
#pragma unroll
        for (int i = 0; i < 16; ++i) { o0[i] *= alpha; o1[i] *= alpha; }
    }
    float rs = 0.f;
#pragma unroll
    for (int i = 0; i < 16; ++i) { p0[i] = fexp2(p0[i] - m); p1[i] = fexp2(p1[i] - m); rs += p0[i] + p1[i]; }
    l += rs;
    pf[0] = packfrag(p0, 0); pf[1] = packfrag(p0, 1); pf[2] = packfrag(p1, 0); pf[3] = packfrag(p1, 1);
}
DI void store_o(bf16_t* orow, const f32x16& o0, const f32x16& o1, float inv, int hh) {
#pragma unroll
    for (int g = 0; g < 4; ++g) {
        u32x2 w0, w1; w0.x = pk2(o0[4 * g] * inv, o0[4 * g + 1] * inv); w0.y = pk2(o0[4 * g + 2] * inv, o0[4 * g + 3] * inv);
        w1.x = pk2(o1[4 * g] * inv, o1[4 * g + 1] * inv); w1.y = pk2(o1[4 * g + 2] * inv, o1[4 * g + 3] * inv);
        *(u32x2*)(orow + 8 * g + 4 * hh) = w0; *(u32x2*)(orow + 32 + 8 * g + 4 * hh) = w1; }
}

DI void fox_unit(LAS unsigned char* lds, const bf16_t* PA, const float* cum, const unsigned* kn2, bf16_t* O, int b, int h, int qb) {
    const Lane L = mklane();
    const size_t rowbase = (size_t)b * SEQ;
    const int q0 = qb * 256, q0w = q0 + L.wid * 32, myq = q0w + L.r;
    const bf16_t* Qp = PA + (rowbase + myq) * LD_AB + h * 64;
    const bf16_t* Kp = PA + rowbase * LD_AB + 512 + h * 64;
    const bf16_t* Vp = Kp + 512;
    const float* cumh = cum + (size_t)(b * 8 + h) * SEQ;
    bf16x8 qf[4];
#pragma unroll
    for (int ds = 0; ds < 4; ++ds) qf[ds] = *(const bf16x8*)(Qp + 16 * ds + 8 * L.hh);
    const float c1 = 0.125f * LOG2E;
    float qn2 = 0.f;
#pragma unroll
    for (int ds = 0; ds < 4; ++ds)
#pragma unroll
        for (int j = 0; j < 8; ++j) { const float qv = bf2f((unsigned short)qf[ds][j]); qn2 += qv * qv; }
    qn2 += __shfl_xor(qn2, 32);
    const float kmax2 = __uint_as_float(kn2[(b * 8 + h) * 2]) + __uint_as_float(kn2[(b * 8 + h) * 2 + 1]);
    const float smax = sqrtf(qn2 * kmax2) * c1 * 1.01f + 1e-3f;
    const int NT = (q0 + 256) / 64;
    float m = -INFINITY, l = 0.f; f32x16 o0, o1;
#pragma unroll
    for (int i = 0; i < 16; ++i) { o0[i] = 0.f; o1[i] = 0.f; }
    bool seen = false;
    LAS int* flags = (LAS int*)(lds + OFF_FLAG);
    u32x4 kreg, vreg; float creg = 0.f;
#define FOX_LOAD(t) do { kreg = *(const u32x4*)(Kp + (size_t)((t) * 64 + L.srow) * LD_AB + L.sch * 8); vreg = *(const u32x4*)(Vp + (size_t)((t) * 64 + L.srow) * LD_AB + L.sch * 8); \
        if (L.tid < 64) creg = cumh[(t) * 64 + L.tid] * (-LOG2E); } while (0)
#define FOX_WRITE(bf) do { *(LAS u32x4*)(lds + OFF_K + (bf) * KBUF + L.srow * 144 + L.sch * 16) = kreg; *(LAS u32x4*)(lds + OFF_V + (bf) * VBUF + L.srow * 144 + L.sch * 16) = vreg; \
        if (L.tid < 64) *(LAS float*)(lds + OFF_C + (bf) * 256 + L.tid * 4) = creg; } while (0)
    FOX_LOAD(NT - 1); FOX_WRITE(0); __syncthreads();
    for (int it = 0; it < NT; ++it) {
        const int t = NT - 1 - it, k0 = t * 64, bf = it & 1;
        if (t > 0) FOX_LOAD(t - 1);
        bool done = false;
        if (k0 <= q0w + 31) {
            const LAS unsigned char* Cb = lds + OFF_C + bf * 256;
            const float nck_last = *(const LAS float*)(Cb + 63 * 4);
            done = seen && __all(smax + nck_last - m < -32.0f);
            if (!done) {
                f32x16 p0, p1;
                qk_tile<4, 144>(p0, p1, lds + OFF_K + bf * KBUF, qf, L);
#pragma unroll
                for (int g = 0; g < 4; ++g) { const f32x4 ca = *(const LAS f32x4*)(Cb + (8 * g + 4 * L.hh) * 4), cb = *(const LAS f32x4*)(Cb + (32 + 8 * g + 4 * L.hh) * 4);
#pragma unroll
                    for (int e = 0; e < 4; ++e) { p0[4 * g + e] = fmaf(p0[4 * g + e], c1, ca[e]); p1[4 * g + e] = fmaf(p1[4 * g + e], c1, cb[e]); } }
                if (k0 + 63 > q0w) {
#pragma unroll
                    for (int i = 0; i < 16; ++i) { const int key = k0 + crow(i, L.hh); if (key > myq) p0[i] = -INFINITY; if (key + 32 > myq) p1[i] = -INFINITY; } }
                bf16x8 pf[4];
                online_softmax(p0, p1, m, l, o0, o1, pf);
                pv_tile(o0, o1, lds + OFF_V + bf * VBUF, pf, L);
                seen = true;
            }
        }
        if (L.lane == 0) flags[(it & 1) * 8 + L.wid] = done ? 1 : 0;
        if (t > 0) FOX_WRITE((it + 1) & 1);
        __syncthreads();
        int alld = 1;
#pragma unroll
        for (int w = 0; w < 8; ++w) alld &= flags[(it & 1) * 8 + w];
        if (alld) break;
    }
#undef FOX_LOAD
#undef FOX_WRITE
    const float lt = l + __shfl_xor(l, 32);
    store_o(O + (rowbase + myq) * DM + h * 64, o0, o1, 1.0f / lt, L.hh);
    __syncthreads();
}

DI void chk_unit(LAS unsigned char* lds, const bf16_t* PA, const float* rel_bias, bf16_t* O, int b, int h, int g4) {
    const Lane L = mklane();
    const size_t rowbase = (size_t)b * SEQ;
    const int cw = 4 * g4 + (L.wid >> 1), myq = 64 * cw + 32 * (L.wid & 1) + L.r;
    const bf16_t* Qp = PA + (rowbase + myq) * LD_AB + 1536 + h * 64;
    const bf16_t* Kp = PA + rowbase * LD_AB + 2048 + h * 64;
    const bf16_t* Vp = Kp + 512;
    bf16x8 qf[4];
#pragma unroll
    for (int ds = 0; ds < 4; ++ds) qf[ds] = *(const bf16x8*)(Qp + 16 * ds + 8 * L.hh);
    const float c1 = 0.125f * LOG2E;
    const int c_lo = (4 * g4 - 8) > 0 ? (4 * g4 - 8) : 0, NT = 4 * g4 + 4 - c_lo;
    LAS float* rb = (LAS float*)(lds + OFF_RB);
    if (L.tid < 320) rb[L.tid] = rel_bias[h * 320 + L.tid] * LOG2E;
    float m = -INFINITY, l = 0.f; f32x16 o0, o1;
#pragma unroll
    for (int i = 0; i < 16; ++i) { o0[i] = 0.f; o1[i] = 0.f; }
    u32x4 kreg, vreg;
#define CHK_LOAD(t) do { kreg = *(const u32x4*)(Kp + (size_t)((c_lo + (t)) * 64 + L.srow) * LD_AB + L.sch * 8); vreg = *(const u32x4*)(Vp + (size_t)((c_lo + (t)) * 64 + L.srow) * LD_AB + L.sch * 8); } while (0)
#define CHK_WRITE(bf) do { *(LAS u32x4*)(lds + OFF_K + (bf) * KBUF + L.srow * 144 + L.sch * 16) = kreg; *(LAS u32x4*)(lds + OFF_V + (bf) * VBUF + L.srow * 144 + L.sch * 16) = vreg; } while (0)
    CHK_LOAD(0); CHK_WRITE(0); __syncthreads();
    for (int t = 0; t < NT; ++t) {
        if (t + 1 < NT) CHK_LOAD(t + 1);
        const int kc = c_lo + t, bf = t & 1;
        if (kc >= cw - 8 && kc <= cw) {
            f32x16 p0, p1;
            qk_tile<4, 144>(p0, p1, lds + OFF_K + bf * KBUF, qf, L);
            if (cw - kc >= 5) { const float bb = rb[319];
#pragma unroll
                for (int i = 0; i < 16; ++i) { p0[i] = fmaf(p0[i], c1, bb); p1[i] = fmaf(p1[i], c1, bb); } }
            else {
#pragma unroll
                for (int i = 0; i < 16; ++i) { const int rel = myq - (64 * kc + crow(i, L.hh));
                    const int i0 = (rel < 256 ? rel : 256) + 63, i1 = (rel - 32 < 256 ? rel - 32 : 256) + 63;
                    p0[i] = fmaf(p0[i], c1, rb[i0]); p1[i] = fmaf(p1[i], c1, rb[i1]); } }
            bf16x8 pf[4];
            online_softmax(p0, p1, m, l, o0, o1, pf);
            pv_tile(o0, o1, lds + OFF_V + bf * VBUF, pf, L);
        }
        if (t + 1 < NT) CHK_WRITE((t + 1) & 1);
        __syncthreads();
    }
#undef CHK_LOAD
#undef CHK_WRITE
    const float lt = l + __shfl_xor(l, 32);
    store_o(O + (rowbase + myq) * DM + 512 + h * 64, o0, o1, 1.0f / lt, L.hh);
}

DI void mla_unit(LAS unsigned char* lds, const bf16_t* QF, const bf16_t* KVF, const bf16_t* KR, bf16_t* O, int b, int h, int qb) {
    const Lane L = mklane();
    const size_t rowbase = (size_t)b * SEQ;
    const int cw = 4 * qb + (L.wid >> 1), myq = 64 * cw + 32 * (L.wid & 1) + L.r;
    const bf16_t* Qp = QF + (rowbase + myq) * 768 + h * 96;
    const bf16_t* Kp = KVF + rowbase * 1024 + h * 128;
    const bf16_t* Vp = Kp + 64;
    const bf16_t* Rp = KR + rowbase * 32;
    bf16x8 qf[6];
#pragma unroll
    for (int ds = 0; ds < 6; ++ds) qf[ds] = *(const bf16x8*)(Qp + 16 * ds + 8 * L.hh);
    const float c1 = 0.10206207261596577f * LOG2E;
    const int NT = 4 * qb + 4;
    float m = -INFINITY, l = 0.f; f32x16 o0, o1;
#pragma unroll
    for (int i = 0; i < 16; ++i) { o0[i] = 0.f; o1[i] = 0.f; }
    u32x4 kreg, vreg, rreg;
#define MLA_LOAD(t) do { kreg = *(const u32x4*)(Kp + (size_t)((t) * 64 + L.srow) * 1024 + L.sch * 8); vreg = *(const u32x4*)(Vp + (size_t)((t) * 64 + L.srow) * 1024 + L.sch * 8); \
        if (L.tid < 256) rreg = *(const u32x4*)(Rp + (size_t)((t) * 64 + (L.tid >> 2)) * 32 + (L.tid & 3) * 8); } while (0)
#define MLA_WRITE(bf) do { *(LAS u32x4*)(lds + OFF_K + (bf) * KBUF + L.srow * 208 + L.sch * 16) = kreg; *(LAS u32x4*)(lds + OFF_V + (bf) * VBUF + L.srow * 144 + L.sch * 16) = vreg; \
        if (L.tid < 256) *(LAS u32x4*)(lds + OFF_K + (bf) * KBUF + (L.tid >> 2) * 208 + 128 + (L.tid & 3) * 16) = rreg; } while (0)
    MLA_LOAD(0); MLA_WRITE(0); __syncthreads();
    for (int t = 0; t < NT; ++t) {
        if (t + 1 < NT) MLA_LOAD(t + 1);
        const int bf = t & 1;
        if (t <= cw) {
            f32x16 p0, p1;
            qk_tile<6, 208>(p0, p1, lds + OFF_K + bf * KBUF, qf, L);
#pragma unroll
            for (int i = 0; i < 16; ++i) { p0[i] *= c1; p1[i] *= c1; }
            bf16x8 pf[4];
            online_softmax(p0, p1, m, l, o0, o1, pf);
            pv_tile(o0, o1, lds + OFF_V + bf * VBUF, pf, L);
        }
        if (t + 1 < NT) MLA_WRITE((t + 1) & 1);
        __syncthreads();
    }
#undef MLA_LOAD
#undef MLA_WRITE
    const float lt = l + __shfl_xor(l, 32);
    store_o(O + (rowbase + myq) * DM + 512 + h * 64, o0, o1, 1.0f / lt, L.hh);
}

DI void sb_sub(f32x16& p, float& R, int keybase, int myq, int hh, bool need_mask) {
    float lk[16], lb[16];
#pragma unroll
    for (int i = 0; i < 16; ++i) {
        const float z = p[i] * 0.125f, u = fexp2(-fabsf(z) * LOG2E), sp = fmaxf(z, 0.f) + flog2(1.0f + u) * LN2;
        const bool valid = !need_mask || (keybase + crow(i, hh)) < myq;
        lk[i] = valid ? -sp : 0.f; lb[i] = valid ? (z - sp) : -INFINITY; }
    float G[4], Gp[4];
#pragma unroll
    for (int g = 0; g < 4; ++g) { G[g] = (lk[4 * g] + lk[4 * g + 1]) + (lk[4 * g + 2] + lk[4 * g + 3]); Gp[g] = __shfl_xor(G[g], 32); }
    float acc = R;
#pragma unroll
    for (int g = 3; g >= 0; --g) {
        const float s3 = hh ? acc : acc + Gp[g];
        acc += G[g] + Gp[g];
        const float s2 = s3 + lk[4 * g + 3], s1 = s2 + lk[4 * g + 2], s0 = s1 + lk[4 * g + 1];
        p[4 * g + 3] = fexp2((lb[4 * g + 3] + s3) * LOG2E); p[4 * g + 2] = fexp2((lb[4 * g + 2] + s2) * LOG2E);
        p[4 * g + 1] = fexp2((lb[4 * g + 1] + s1) * LOG2E); p[4 * g] = fexp2((lb[4 * g] + s0) * LOG2E); }
    R = acc;
}
DI void sb_unit(LAS unsigned char* lds, const bf16_t* PC, bf16_t* O, int b, int h, int qb) {
    const Lane L = mklane();
    const size_t rowbase = (size_t)b * SEQ;
    const int q0 = qb * 256, q0w = q0 + L.wid * 32, myq = q0w + L.r;
    const bf16_t* Qp = PC + (rowbase + myq) * LD_CD + h * 64;
    const bf16_t* Kp = PC + rowbase * LD_CD + 512 + h * 64;
    const bf16_t* Vp = Kp + 512;
    bf16x8 qf[4];
#pragma unroll
    for (int ds = 0; ds < 4; ++ds) qf[ds] = *(const bf16x8*)(Qp + 16 * ds + 8 * L.hh);
    const int NT = (q0 + 256) / 64;
    float R = 0.f; f32x16 o0, o1;
#pragma unroll
    for (int i = 0; i < 16; ++i) { o0[i] = 0.f; o1[i] = 0.f; }
    bool seen = false;
    LAS int* flags = (LAS int*)(lds + OFF_FLAG);
    u32x4 kreg, vreg;
#define SB_LOAD(t) do { kreg = *(const u32x4*)(Kp + (size_t)((t) * 64 + L.srow) * LD_CD + L.sch * 8); vreg = *(const u32x4*)(Vp + (size_t)((t) * 64 + L.srow) * LD_CD + L.sch * 8); } while (0)
#define SB_WRITE(bf) do { *(LAS u32x4*)(lds + OFF_K + (bf) * KBUF + L.srow * 144 + L.sch * 16) = kreg; *(LAS u32x4*)(lds + OFF_V + (bf) * VBUF + L.srow * 144 + L.sch * 16) = vreg; } while (0)
    SB_LOAD(NT - 1); SB_WRITE(0); __syncthreads();
    for (int it = 0; it < NT; ++it) {
        const int t = NT - 1 - it, k0 = t * 64, bf = it & 1;
        if (t > 0) SB_LOAD(t - 1);
        bool done = false;
        if (k0 <= q0w + 31) {
            done = seen && __all(R < -110.0f);
            if (!done) {
                f32x16 p0, p1;
                qk_tile<4, 144>(p0, p1, lds + OFF_K + bf * KBUF, qf, L);
                const bool nm = (k0 + 63 >= q0w);
                sb_sub(p1, R, k0 + 32, myq, L.hh, nm);
                sb_sub(p0, R, k0, myq, L.hh, nm);
                bf16x8 pf[4];
                pf[0] = packfrag(p0, 0); pf[1] = packfrag(p0, 1); pf[2] = packfrag(p1, 0); pf[3] = packfrag(p1, 1);
                pv_tile(o0, o1, lds + OFF_V + bf * VBUF, pf, L);
                seen = true;
                done = __all(R < -110.0f);
            }
        }
        if (L.lane == 0) flags[(it & 1) * 8 + L.wid] = done ? 1 : 0;
        if (t > 0) SB_WRITE((it + 1) & 1);
        __syncthreads();
        int alld = 1;
#pragma unroll
        for (int w = 0; w < 8; ++w) alld &= flags[(it & 1) * 8 + w];
        if (alld) break;
    }
#undef SB_LOAD
#undef SB_WRITE
    store_o(O + (rowbase + myq) * DM + h * 64, o0, o1, 1.0f, L.hh);
    __syncthreads();
}
}

#define XB_TMO      128
#define XB_XCNT(j)  (256  + 64 * (j))
#define XB_XSUB(j)  (1280 + 64 * (j))
#define XB_XGEN(j)  (2304 + 64 * (j))
#define XB_TOP      3328
#define XB_TOPGEN   3392
#define XCD_BAR_WORDS 3456
#define XB_SPIN_CAP (1u << 18)

__device__ __forceinline__ unsigned xb_ld(unsigned* p)              { return __hip_atomic_load(p, __ATOMIC_RELAXED, __HIP_MEMORY_SCOPE_AGENT); }
__device__ __forceinline__ unsigned xb_add(unsigned* p, unsigned v) { return __hip_atomic_fetch_add(p, v, __ATOMIC_RELAXED, __HIP_MEMORY_SCOPE_AGENT); }
__device__ __forceinline__ unsigned xb_xcc_id() { return (unsigned)__builtin_amdgcn_s_getreg((3 << 11) | 20) & 0xFu; }
#define XB_SPIN(cond, bar) do { unsigned _sp = 0; while (cond) { __builtin_amdgcn_s_sleep(1); \
    if ((++_sp & 255u) == 0u) { if (xb_ld(&(bar)[XB_TMO])) break; if (_sp > XB_SPIN_CAP) { atomicAdd(&(bar)[XB_TMO], 1u); break; } } } } while (0)

struct XcdBarrier {
    unsigned* bar; unsigned x;
    volatile LAS unsigned* st;
};

__device__ __forceinline__ XcdBarrier xcd_barrier_post(unsigned* bar, volatile LAS unsigned* st) {
    XcdBarrier b; b.bar = bar; b.x = xb_xcc_id(); b.st = st;
    if (threadIdx.x == 0) (void)xb_add(&bar[XB_XCNT(b.x)], 1u);
    return b;
}
__device__ __forceinline__ void xcd_barrier_complete(unsigned* bar, unsigned x, unsigned& nloc, unsigned& nx) {
    const unsigned G = gridDim.x * gridDim.y * gridDim.z;
    unsigned sum, cnt, mine, sp = 0u;
    for (;;) {
        sum = 0u; cnt = 0u; mine = 0u;
#pragma unroll
        for (unsigned j = 0; j < 16; ++j) { const unsigned c = xb_ld(&bar[XB_XCNT(j)]); sum += c; cnt += (c > 0u) ? 1u : 0u; mine = (j == x) ? c : mine; }
        if (sum == G) break;
        __builtin_amdgcn_s_sleep(1);
        if ((++sp & 255u) == 0u) { if (xb_ld(&bar[XB_TMO])) break; if (sp > XB_SPIN_CAP) { atomicAdd(&bar[XB_TMO], 1u); break; } }
    }
    nloc = mine > 0u ? mine : 1u; nx = cnt > 0u ? cnt : 1u;
}

__device__ __forceinline__ void xcd_barrier(const XcdBarrier& b) {
    asm volatile("s_waitcnt vmcnt(0)" ::: "memory");
    __syncthreads();
    if (threadIdx.x == 0) {
        unsigned* bar = b.bar;
        __builtin_amdgcn_s_waitcnt(0);
        unsigned nloc = b.st[0], nx = b.st[1];
        if (nloc == 0u) { xcd_barrier_complete(bar, b.x, nloc, nx); b.st[0] = nloc; b.st[1] = nx; }
        const unsigned old = xb_add(&bar[XB_XSUB(b.x)], 1u);
        const unsigned gen = old / nloc;
        if (old + 1u == (gen + 1u) * nloc) {
            __builtin_amdgcn_fence(__ATOMIC_RELEASE, "agent");
            asm volatile("s_waitcnt vmcnt(0)" ::: "memory");
            const unsigned og = xb_add(&bar[XB_TOP], 1u);
            const unsigned tg = og / nx;
            if (og + 1u == (tg + 1u) * nx) xb_add(&bar[XB_TOPGEN], 1u);
            else XB_SPIN(xb_ld(&bar[XB_TOPGEN]) == tg, bar);
            __builtin_amdgcn_fence(__ATOMIC_ACQUIRE, "agent");
            xb_add(&bar[XB_XGEN(b.x)], 1u);
            asm volatile("s_waitcnt vmcnt(0)" ::: "memory");
        } else {
            XB_SPIN(xb_ld(&bar[XB_XGEN(b.x)]) == gen, bar);
            __builtin_amdgcn_fence(__ATOMIC_ACQUIRE, "agent");
            asm volatile("s_waitcnt vmcnt(0)" ::: "memory");
        }
    }
    __syncthreads();
}


constexpr int RSTD_OFF = 131072 + 1024;
DI void rstd_prepass(LAS unsigned char* lds, const pg8::StaticOrder& S, const float* ssq, int tid) {
    LAS float* tab = (LAS float*)(lds + RSTD_OFF);
    pg8::Unit u;
#pragma unroll 1
    for (int i = 0; i < 4 && S.next(i, u); ++i) {
        const int r = tid >> 1, hf = tid & 1;
        const f32x4* sp = (const f32x4*)(ssq + (size_t)(u.pm * 256 + r) * 16 + hf * 8);
        const f32x4 a = sp[0], b = sp[1];
        float t = ((a[0] + a[1]) + (a[2] + a[3])) + ((b[0] + b[1]) + (b[2] + b[3]));
        t += __shfl_xor(t, 1);
        if (hf == 0) tab[i * 256 + r] = 1.0f / sqrtf(t * (1.0f / 1024.0f) + EPS);
    }
    __syncthreads();
}

DI void rstd_prepass_lr(LAS unsigned char* lds, const pg8::StaticOrder& S, const float* ssq2, int g0, int nq4, float inv_width, int tid) {
    LAS float* tab = (LAS float*)(lds + RSTD_OFF);
    pg8::Unit u;
    if (S.next(0, u)) {
        if (tid < 256) {
            const f32x4* sp = (const f32x4*)(ssq2 + (size_t)(u.pm * 256 + tid) * 32 + g0);
            float t = 0.f;
            for (int i = 0; i < nq4; ++i) { const f32x4 a = sp[i]; t += (a[0] + a[1]) + (a[2] + a[3]); }
            tab[tid] = 1.0f / sqrtf(t * inv_width + EPS);
        }
    }
    __syncthreads();
}
struct Params {
    const float* x; const int* pos; const float* norm_mix; const float* norm_mlp; const float* norm_final;
    const float* w_in_ab; const float* b_forget; const float* rel_bias; const float* w_out_ab;
    const float* w_in_cd; const float* q_norm; const float* kv_norm; const float* w_uq; const float* w_ukv; const float* w_out_cd;
    const float* w_up; const float* w_down;
    float* out; unsigned char* ws; int ph_lo, ph_hi, coop, pad;
};
constexpr int N_PHASES = 17;

__global__ void __launch_bounds__(NTHREADS) fwd_kernel(Params P) {
    extern __shared__ __attribute__((aligned(16))) unsigned char lds_raw[];
    LAS unsigned char* lds = (LAS unsigned char*)lds_raw;
    const int tid = threadIdx.x, lane = tid & 63, wave = __builtin_amdgcn_readfirstlane(tid >> 6);
    const int G = gridDim.x, bx = blockIdx.x;
    const int vcu = (G % 8 == 0) ? (bx % 8) * (G / 8) + bx / 8 : bx;
    const int gw = vcu * NWAVES + wave, ngw = G * NWAVES;
    unsigned char* ws = P.ws;
    bf16_t* WinAB = (bf16_t*)(ws + WS_WINAB); bf16_t* WoutAB = (bf16_t*)(ws + WS_WOUTAB); bf16_t* WinCD = (bf16_t*)(ws + WS_WINCD);
    bf16_t* Wuq = (bf16_t*)(ws + WS_WUQ); bf16_t* Wukv = (bf16_t*)(ws + WS_WUKV); bf16_t* WoutCD = (bf16_t*)(ws + WS_WOUTCD);
    bf16_t* Wup0 = (bf16_t*)(ws + WS_WUP0); bf16_t* Wup1 = (bf16_t*)(ws + WS_WUP1); bf16_t* Wdn0 = (bf16_t*)(ws + WS_WDN0); bf16_t* Wdn1 = (bf16_t*)(ws + WS_WDN1);
    float* LOGF = (float*)(ws + WS_LOGF); float* CUM = (float*)(ws + WS_CUM); float* TAB = (float*)(ws + WS_TAB); bf16_t* KR = (bf16_t*)(ws + WS_KR); float* SSQ = (float*)(ws + WS_SSQ); float* SSQ2 = (float*)(ws + WS_SSQ2); unsigned* KN2 = (unsigned*)(ws + WS_CTL + CTL_KN2);
    bf16_t* XN = (bf16_t*)(ws + WS_XN); bf16_t* CQN = (bf16_t*)(ws + WS_CQN); bf16_t* CKVN = (bf16_t*)(ws + WS_CKVN); bf16_t* OB = (bf16_t*)(ws + WS_O);
    bf16_t* BIG = (bf16_t*)(ws + WS_BIG); bf16_t* QF = (bf16_t*)(ws + WS_QF); bf16_t* KVF = (bf16_t*)(ws + WS_KVF);
    cg::grid_group grid = cg::this_grid();
    volatile LAS unsigned* MISC = (volatile LAS unsigned*)(lds + MISC_OFF);
    if (tid < 32) MISC[tid] = 0u;
    __syncthreads();
    XcdBarrier bar; bar.bar = (unsigned*)(ws + WS_CTL); bar.x = 0; bar.st = nullptr;
    if (P.coop) bar = xcd_barrier_post((unsigned*)(ws + WS_CTL), MISC + 8);
    const int lo = P.ph_lo, hi = P.ph_hi;
#ifndef PHMASK
#define PHMASK 0x1ffff
#endif
#define IN(k) (((PHMASK >> (k)) & 1) && lo <= (k) && (k) < hi)
#ifndef REPMASK
#define REPMASK 0
#endif
#define REP(k) ((REPMASK >> (k)) & 1)
#ifndef REPKMASK
#define REPKMASK 0
#endif
#define REPK(k) ((REPKMASK >> (k)) & 1)
#define SEAM(k) do { if (P.coop && (k) + 1 < hi) { if (P.coop == 2) grid.sync(); else xcd_barrier(bar); } } while (0)

    if (IN(0)) {
        LAS float* scr = (LAS float*)(lds + wave * 8704);
        for (int it = gw; ; it += ngw) {
            int r = it; bool hit = false;
#define TR(W, K, LDN, C0, NC, WT, R0, GN) if (!hit) { const int n_it = ((K) / 64) * ((NC) / 32); if (r < n_it) { transpose_item((W), (K), (LDN), (C0), (WT), (R0), (NC) / 32, scr, r, lane, (GN)); hit = true; } else r -= n_it; }
            TR(P.w_in_ab, 1024, NSRC_AB, 0, 1536, WinAB, 0, nullptr)
            TR(P.w_in_ab, 1024, NSRC_AB, 1544, 1536, WinAB, 1536, nullptr)
            TR(P.w_out_ab, 1024, 1024, 0, 1024, WoutAB, 0, nullptr)
            TR(P.w_in_cd, 1024, NSRC_CD, 0, NSRC_CD, WinCD, 0, P.norm_mix + DM)
            TR(P.w_up, 1024, 4096, 0, 4096, Wup0, 0, P.norm_mlp)
            TR(P.w_down, 4096, 1024, 0, 1024, Wdn0, 0, nullptr)
#undef TR
            if (!hit) break;
        }
        for (int i = (vcu * NTHREADS + tid); i < 96 * 1024 / 8; i += G * NTHREADS) ((u32x4*)(WinCD + (size_t)2208 * 1024))[i] = (u32x4){0u, 0u, 0u, 0u};
        __syncthreads();
        LAS float* wfaT = (LAS float*)lds;
        for (int i = tid; i < 8192; i += NTHREADS) { const int k = i >> 3, j = i & 7; wfaT[j * 1024 + k] = P.w_in_ab[(size_t)k * NSRC_AB + 1536 + j]; }
        __syncthreads();
        norm_rows_bf16<true>(P.x, P.norm_mix, XN, gw, ngw, lane, wfaT, P.b_forget, LOGF, P.pos, TAB);
        __syncthreads();
        SEAM(0);
    }
    if (IN(1)) {
        if (vcu < 32) {
            const int b = vcu >> 3, h = vcu & 7; LAS float* sc = (LAS float*)lds;
            float v[8]; float run = 0.f;
#pragma unroll
            for (int e = 0; e < 8; ++e) { run += LOGF[((size_t)b * SEQ + tid * 8 + e) * 8 + h]; v[e] = run; }
            sc[tid] = run; __syncthreads();
            for (int off = 1; off < NTHREADS; off <<= 1) { const float add = (tid >= off) ? sc[tid - off] : 0.f; __syncthreads(); sc[tid] += add; __syncthreads(); }
            const float base = sc[tid] - run;
#pragma unroll
            for (int e = 0; e < 8; ++e) CUM[(size_t)(b * 8 + h) * SEQ + tid * 8 + e] = base + v[e];
            __syncthreads();
        }
        pg8::Gemm g{XN, WinAB, MT, LD_AB, DM}; pg8::StaticOrder S; S.init(MT, LD_AB, G, bx);
        pg8::EpiStoreAB E{BIG, LD_AB, KN2};
        pg8::gemm_phase<pg8::EpiStoreAB, pg8::StaticOrder, true, true>(lds, g, S, E);
        SEAM(1);
    }
    if (IN(2)) {
        unsigned* qctr = (unsigned*)(ws + WS_CTL + CTL_QCTR);
        LAS int* tk = (LAS int*)(lds + att::ATT_LDS);
        int nxt = 0;
        if (tid == 0) nxt = (int)atomicAdd(qctr, 1u);
        for (;;) {
            if (tid == 0) *tk = nxt;
            __syncthreads();
            const int t = __builtin_amdgcn_readfirstlane(*tk);
            __syncthreads();
            if (t >= 1024) break;
            if (tid == 0) nxt = (int)atomicAdd(qctr, 1u);
            if (t < 512) { const int qb = 15 - (t >> 5), bh = t & 31; att::fox_unit(lds, BIG, CUM, KN2, OB, bh >> 3, bh & 7, qb); }
            else { const int idx = t - 512, g4 = 15 - (idx >> 5), bh = idx & 31; att::chk_unit(lds, BIG, P.rel_bias, OB, bh >> 3, bh & 7, g4); }
        }
        SEAM(2);
    }
    if (IN(3)) {
        pg8::Gemm g{OB, WoutAB, MT, DM, DM}; pg8::StaticOrder S; S.init(MT, DM, G, bx);
        pg8::EpiResidB<1> E{P.x, XN, SSQ, DM};
        pg8::gemm_phase<pg8::EpiResidB<1>, pg8::StaticOrder, true, true>(lds, g, S, E);
        SEAM(3);
    }
    if (IN(5)) {
        pg8::Gemm g{XN, Wup0, MT, DFF, DM}; pg8::StaticOrder S; S.init(MT, DFF, G, bx);
        rstd_prepass(lds, S, SSQ, tid);
        pg8::EpiStore<1, 1> E{BIG, DFF, (const LAS float*)(lds + RSTD_OFF), 0};
        pg8::gemm_phase<pg8::EpiStore<1, 1>, pg8::StaticOrder, true, true>(lds, g, S, E);
        SEAM(5);
    }
    if (IN(6)) {
        pg8::Gemm g{BIG, Wdn0, MT, DM, DFF}; pg8::StaticOrder S; S.init(MT, DM, G, bx);
        pg8::EpiResidB<0> E{nullptr, XN, SSQ, DM};
        pg8::gemm_phase<pg8::EpiResidB<0>, pg8::StaticOrder, true, true>(lds, g, S, E);
        SEAM(6);
    }
    if (IN(8)) {
        pg8::Gemm g{XN, WinCD, MT, LD_CD, DM}; pg8::StaticOrder S; S.init(MT, LD_CD, G, bx);
        rstd_prepass(lds, S, SSQ, tid);
        pg8::EpiStoreCD E{BIG, LD_CD, (const LAS float*)(lds + RSTD_OFF), SSQ2, KR, TAB, 0};
        pg8::gemm_phase<pg8::EpiStoreCD, pg8::StaticOrder, true, true>(lds, g, S, E);
        if (G == 256 ? bx >= 64 : true) {
            const int nidle = (G == 256) ? 192 : G, iw = ((G == 256) ? bx - 64 : bx) * NWAVES + wave;
            LAS float* scr = (LAS float*)(lds + wave * 8704);
            for (int it = iw; ; it += nidle * NWAVES) {
                int r = it; bool hit = false;
#define TR(W, K, LDN, C0, NC, WT, R0, GN) if (!hit) { const int n_it = ((K) / 64) * ((NC) / 32); if (r < n_it) { transpose_item((W), (K), (LDN), (C0), (WT), (R0), (NC) / 32, scr, r, lane, (GN)); hit = true; } else r -= n_it; }
                TR(P.w_uq, 384, 768, 0, 768, Wuq, 0, P.q_norm)
                TR(P.w_ukv, 256, 1024, 0, 1024, Wukv, 0, P.kv_norm)
                TR(P.w_out_cd, 1024, 1024, 0, 1024, WoutCD, 0, nullptr)
                TR(P.w_up + (size_t)1024 * 4096, 1024, 4096, 0, 4096, Wup1, 0, P.norm_mlp + DM)
                TR(P.w_down + (size_t)4096 * 1024, 4096, 1024, 0, 1024, Wdn1, 0, nullptr)
#undef TR
                if (!hit) break;
            }
        }
        SEAM(8);
    }
    if (IN(10)) {
#ifndef P10SEL
#define P10SEL 3
#endif
        { pg8::Gemm g{BIG + 1536, Wuq, MT, 768, 384 + P.pad, LD_CD};
          pg8::StaticOrder S; S.init(MT, 768, G, bx);
          rstd_prepass_lr(lds, S, SSQ2, 0, 3, 1.0f / 384.0f, tid);
          pg8::EpiQRope E{QF, 768, TAB, (const LAS float*)(lds + RSTD_OFF)};
          pg8::gemm_phase<pg8::EpiQRope, pg8::StaticOrder, true, true>(lds, g, S, E); }
        { pg8::Gemm g{BIG + 1920, Wukv, MT, 1024, 256 + P.pad, LD_CD}; pg8::StaticOrder S; S.init(MT, 1024, G, bx);
          rstd_prepass_lr(lds, S, SSQ2, 12, 2, 1.0f / 256.0f, tid);
          pg8::EpiStore<0, 1> E{KVF, 1024, (const LAS float*)(lds + RSTD_OFF), 0};
          pg8::gemm_phase<pg8::EpiStore<0, 1>, pg8::StaticOrder, true, true>(lds, g, S, E); }
        SEAM(10);
    }
    if (IN(11)) {
        const int bh = vcu >> 3, s = vcu & 7, b = bh >> 3, h = bh & 7;
        for (int rep = 0; rep <= REPK(11); ++rep) {
            att::mla_unit(lds, QF, KVF, KR, OB, b, h, 15 - s);
            att::mla_unit(lds, QF, KVF, KR, OB, b, h, s);
            att::sb_unit(lds, BIG, OB, b, h, 15 - s);
            att::sb_unit(lds, BIG, OB, b, h, s);
        }
        SEAM(11);
    }
    if (IN(12)) {
        pg8::Gemm g{OB, WoutCD, MT, DM, DM}; pg8::StaticOrder S; S.init(MT, DM, G, bx);
        pg8::EpiResidB<0> E{nullptr, XN, SSQ, DM};
        pg8::gemm_phase<pg8::EpiResidB<0>, pg8::StaticOrder, true, true>(lds, g, S, E);
        SEAM(12);
    }
    if (IN(14)) {
        pg8::Gemm g{XN, Wup1, MT, DFF, DM}; pg8::StaticOrder S; S.init(MT, DFF, G, bx);
        rstd_prepass(lds, S, SSQ, tid);
        pg8::EpiStore<1, 1> E{BIG, DFF, (const LAS float*)(lds + RSTD_OFF), 0};
        pg8::gemm_phase<pg8::EpiStore<1, 1>, pg8::StaticOrder, true, true>(lds, g, S, E);
        SEAM(14);
    }
    if (IN(15)) {
        pg8::Gemm g{BIG, Wdn1, MT, DM, DFF}; pg8::StaticOrder S; S.init(MT, DM, G, bx);
        pg8::EpiResidB<0> E{nullptr, XN, SSQ, DM};
        pg8::gemm_phase<pg8::EpiResidB<0>, pg8::StaticOrder, true, true>(lds, g, S, E);
        SEAM(15);
    }
    if (IN(16)) { norm_rows_final(XN, P.out, P.norm_final, gw, ngw, lane); }
#undef IN
#undef SEAM
}

#ifndef MK_MULTI_LAUNCH
#define MK_MULTI_LAUNCH 0
#endif
extern "C" void kernel_launch(void* const* d_in, const int* in_sizes, int n_in, void* d_out, int out_size, void* d_ws, size_t ws_size, hipStream_t stream) {
    static int grid = 0;
    if (grid == 0) {
        if (n_in != 17 || out_size != MT * DM || ws_size < WS_END) { fprintf(stderr, "kernel_launch: unexpected problem (n_in %d out %d ws %zu)\n", n_in, out_size, ws_size); grid = -1; return; }
        int dev = 0, cus = 0, per_cu = 0;
        hipGetDevice(&dev); hipDeviceGetAttribute(&cus, hipDeviceAttributeMultiprocessorCount, dev);
        if (hipFuncSetAttribute((const void*)fwd_kernel, hipFuncAttributeMaxDynamicSharedMemorySize, LDS_BYTES) != hipSuccess) { fprintf(stderr, "kernel_launch: hipFuncSetAttribute failed\n"); grid = -1; return; }
        if (hipOccupancyMaxActiveBlocksPerMultiprocessor(&per_cu, (const void*)fwd_kernel, NTHREADS, LDS_BYTES) != hipSuccess || per_cu < 1) { fprintf(stderr, "kernel_launch: occupancy query says %d\n", per_cu); per_cu = 1; }
        (void)hipGetLastError();
        grid = cus;
        if (grid != 256) fprintf(stderr, "kernel_launch: note: %d CUs\n", grid);
    }
    if (grid < 0) return;
    Params p{};
    p.x = (const float*)d_in[0]; p.pos = (const int*)d_in[1]; p.norm_mix = (const float*)d_in[2]; p.norm_mlp = (const float*)d_in[3]; p.norm_final = (const float*)d_in[4];
    p.w_in_ab = (const float*)d_in[5]; p.b_forget = (const float*)d_in[6]; p.rel_bias = (const float*)d_in[7]; p.w_out_ab = (const float*)d_in[8];
    p.w_in_cd = (const float*)d_in[9]; p.q_norm = (const float*)d_in[10]; p.kv_norm = (const float*)d_in[11]; p.w_uq = (const float*)d_in[12]; p.w_ukv = (const float*)d_in[13]; p.w_out_cd = (const float*)d_in[14];
    p.w_up = (const float*)d_in[15]; p.w_down = (const float*)d_in[16];
    p.out = (float*)d_out; p.ws = (unsigned char*)d_ws;
    if (hipMemsetAsync((char*)d_ws + WS_CTL, 0, CTL_BYTES, stream) != hipSuccess) { fprintf(stderr, "kernel_launch: hipMemsetAsync failed\n"); return; }
#if MK_MULTI_LAUNCH
    for (int ph = 0; ph < N_PHASES; ++ph) {
        p.ph_lo = ph; p.ph_hi = ph + 1; p.coop = 0;
        hipLaunchKernelGGL(fwd_kernel, dim3(grid), dim3(NTHREADS), LDS_BYTES, stream, p);
        if (REP(ph)) hipLaunchKernelGGL(fwd_kernel, dim3(grid), dim3(NTHREADS), LDS_BYTES, stream, p);
    }
#else
    p.ph_lo = 0; p.ph_hi = N_PHASES; p.coop = 1;
    void* args[] = {&p};
    hipError_t e = hipLaunchCooperativeKernel((const void*)fwd_kernel, dim3(grid), dim3(NTHREADS), args, LDS_BYTES, stream);
    if (e != hipSuccess) fprintf(stderr, "cooperative launch failed: %s (grid %d)\n", hipGetErrorString(e), grid);
#endif
}
```

```cpp
#include <hip/hip_runtime.h>
#include <hip/hip_cooperative_groups.h>
#include <cstdio>
#include <cstdint>
#include <cmath>
namespace cg = cooperative_groups;
namespace pg8 {
#define PG8_LAS __attribute__((address_space(3)))
typedef unsigned short bf16_t;
typedef short bf16x8 __attribute__((ext_vector_type(8)));
typedef float f32x4 __attribute__((ext_vector_type(4)));
typedef unsigned u32x4 __attribute__((ext_vector_type(4)));
constexpr int BM = 256, BK = 64, HALF = 128, HTB = HALF * BK * 2  , STAGE_BYTES = 8 * HTB, NXCD = 8, WGM = 8;

__host__ __device__ __forceinline__ int lds_byte(int r, int c) { const int st = (r >> 4) * 2 + (c >> 5), rr = r & 15, cc = c & 31, ob = rr * 64 + cc * 2; return st * 1024 + (ob ^ (((ob >> 9) & 1) << 5)); }
__host__ __device__ __forceinline__ void stage_rc(int b, int& R, int& C) { const int st = b / 1024, sb = b % 1024, swz = sb ^ (((sb >> 9) & 1) << 5); R = (st >> 1) * 16 + swz / 64; C = (st & 1) * 32 + (swz % 64) / 2; }
__host__ __device__ __forceinline__ int perm32(int rho) { const int n = rho >> 4, i = rho & 15; return 8 * (i >> 2) + 4 * n + (i & 3); }

struct Unit { int pm, pn; };
struct Gemm { const bf16_t* A; const bf16_t* Bt; int M, N, K; int lda; };

struct StaticOrder {
    int nM, nN, nwg, G, c;
    __host__ __device__ void init(int M, int N, int G_, int c_) { nM = M / BM; nN = N / BM; nwg = nM * nN; G = G_; c = c_; }
    __host__ __device__ bool next(int i, Unit& u) const {
        const long L = (long)i * G + c; if (L >= nwg) return false;
        int wgid = (int)L; { const int q = nwg / NXCD, r = nwg % NXCD, xcd = wgid % NXCD, off = wgid / NXCD; wgid = (xcd < r ? xcd * (q + 1) : r * (q + 1) + (xcd - r) * q) + off; }
        const int nig = WGM * nN, gid = wgid / nig, fm = gid * WGM, gsz = (nM - fm) < WGM ? (nM - fm) : WGM;
        u.pm = fm + ((wgid % nig) % gsz); u.pn = (wgid % nig) / gsz; return true;
    }
    __device__ __forceinline__ void a_ready(const Unit&) const {}
    __device__ __forceinline__ void done(const Unit&) const {}
};

__device__ __forceinline__ unsigned cvt_pk_bf16(float lo, float hi) { unsigned r; asm volatile("v_cvt_pk_bf16_f32 %0, %1, %2" : "=v"(r) : "v"(lo), "v"(hi)); return r; }
template <class Epi, class Sched, bool ALIGN_EPI = false, bool SP2 = false>
__device__ __forceinline__ void gemm_phase(PG8_LAS unsigned char* lds, const Gemm g, const Sched& S, const Epi& E) {
    const int tid = threadIdx.x, wid = __builtin_amdgcn_readfirstlane(tid >> 6), lane = tid & 63, wr = wid >> 2, wc = wid & 3, fr = lane & 15, fq = lane >> 4;
    const int K = g.K, nt = K / BK, LDA = g.lda ? g.lda : g.K;
    unsigned voffA[2], voffB[2];
#pragma unroll
    for (int i = 0; i < 2; ++i) { int R, C; stage_rc(tid * 16 + i * 8192, R, C); const int Rb = Epi::PERM ? ((R & ~31) + perm32(R & 31)) : R;
        voffA[i] = (unsigned)(R * LDA + C) * 2u; voffB[i] = (unsigned)(Rb * K + C) * 2u; }
    const size_t kstep = (size_t)(BK * 2);
    const size_t hstepB = (size_t)HALF * K * 2, hstepA = (size_t)HALF * LDA * 2;
    const size_t tstepB = 2 * hstepB, tstepA = 2 * hstepA;
    const unsigned ldsw = (unsigned)wid * 1024u;
    const int aoff = lds_byte(wr * 64 + fr, fq * 8), boff = lds_byte(wc * 32 + fr, fq * 8);
#define PG8_SA(b, h) (((b) * 2 + (h)) * HTB)
#define PG8_SB(b, h) ((4 + (b) * 2 + (h)) * HTB)
#define PG8_STAGE(bufoff, gbase, voff) do { _Pragma("unroll") for (int _i = 0; _i < 2; ++_i) \
        __builtin_amdgcn_global_load_lds((const unsigned*)((const char*)(gbase) + (voff)[_i]), (PG8_LAS unsigned*)(lds + (bufoff) + ldsw + _i * 8192), 16, 0, 0); } while (0)
#define PG8_LDA(dst, b, h) do { _Pragma("unroll") for (int m = 0; m < 4; ++m) _Pragma("unroll") for (int k = 0; k < 2; ++k) dst[m][k] = *(const PG8_LAS bf16x8*)(lds + PG8_SA(b, h) + aoff + m * 2048 + k * 1024); } while (0)
#define PG8_LDB(dst, b, h) do { _Pragma("unroll") for (int n = 0; n < 2; ++n) _Pragma("unroll") for (int k = 0; k < 2; ++k) dst[n][k] = *(const PG8_LAS bf16x8*)(lds + PG8_SB(b, h) + boff + n * 2048 + k * 1024); } while (0)
#define PG8_MMA(ai, bj, At, Bt) do { __builtin_amdgcn_s_setprio(1); _Pragma("unroll") for (int m = 0; m < 4; ++m) _Pragma("unroll") for (int n = 0; n < 2; ++n) _Pragma("unroll") for (int k = 0; k < 2; ++k) \
        acc[ai][bj][m][n] = __builtin_amdgcn_mfma_f32_16x16x32_bf16(Bt[n][k], At[m][k], acc[ai][bj][m][n], 0, 0, 0); __builtin_amdgcn_s_setprio(0); } while (0)
#define PG8_WAIT_V(n) asm volatile("s_waitcnt vmcnt(" #n ")" ::: "memory")
#define PG8_WAIT_L(n) asm volatile("s_waitcnt lgkmcnt(" #n ")" ::: "memory")
#define PG8_BAR __builtin_amdgcn_s_barrier()
#define PG8_SCHED __builtin_amdgcn_sched_barrier(0)
    Unit cur, nxt; int ui = 0;
    if (!S.next(0, cur)) return;
    f32x4 acc[2][2][4][2];
#pragma unroll
    for (int a = 0; a < 2; ++a)
#pragma unroll
        for (int b = 0; b < 2; ++b)
#pragma unroll
            for (int m = 0; m < 4; ++m)
#pragma unroll
                for (int n = 0; n < 2; ++n) acc[a][b][m][n] = (f32x4){0.f, 0.f, 0.f, 0.f};
    bf16x8 At[4][2], B0[2][2], B1[2][2];
    const char* cA = (const char*)g.A + (size_t)cur.pm * tstepA; const char* cB = (const char*)g.Bt + (size_t)cur.pn * tstepB;
    S.a_ready(cur);
    if constexpr (SP2) {
        PG8_STAGE(PG8_SB(0, 0), cB, voffB); PG8_STAGE(PG8_SB(0, 1), cB + hstepB, voffB); PG8_STAGE(PG8_SA(0, 0), cA, voffA); PG8_STAGE(PG8_SA(0, 1), cA + hstepA, voffA);
        if (wr == 1) PG8_BAR;
        PG8_WAIT_V(2); PG8_BAR;
        PG8_STAGE(PG8_SB(1, 0), cB + kstep, voffB); PG8_STAGE(PG8_SA(1, 0), cA + kstep, voffA); PG8_STAGE(PG8_SB(1, 1), cB + hstepB + kstep, voffB);
        PG8_WAIT_V(6); PG8_BAR;
    } else {
        PG8_STAGE(PG8_SB(0, 0), cB, voffB); PG8_STAGE(PG8_SA(0, 0), cA, voffA); PG8_STAGE(PG8_SB(0, 1), cB + hstepB, voffB); PG8_STAGE(PG8_SA(0, 1), cA + hstepA, voffA);
        if (wr == 1) PG8_BAR;
        PG8_WAIT_V(4); PG8_BAR;
        PG8_STAGE(PG8_SB(1, 0), cB + kstep, voffB); PG8_STAGE(PG8_SA(1, 0), cA + kstep, voffA); PG8_STAGE(PG8_SB(1, 1), cB + hstepB + kstep, voffB);
        PG8_WAIT_V(6); PG8_BAR;
    }
    for (;;) {
        const bool has_next = S.next(ui + 1, nxt);
        const char* nA = has_next ? (const char*)g.A + (size_t)nxt.pm * tstepA : cA; const char* nB = has_next ? (const char*)g.Bt + (size_t)nxt.pn * tstepB : cB;
        for (int t = 0; t < nt; t += 2) {
            const bool last = (t == nt - 2);
            const char* a1 = cA + (size_t)(t + 1) * kstep;
            const char* a2 = last ? nA : cA + (size_t)(t + 2) * kstep; const char* b2 = last ? nB : cB + (size_t)(t + 2) * kstep;
            const char* a3 = a2 + kstep; const char* b3 = b2 + kstep;
            if (last && has_next) S.a_ready(nxt);
            if constexpr (SP2) {
            PG8_LDB(B0, 0, 0); PG8_LDB(B1, 0, 1); PG8_SCHED; PG8_LDA(At, 0, 0); PG8_STAGE(PG8_SA(1, 1), a1 + hstepA, voffA);
            PG8_WAIT_V(8); PG8_WAIT_L(0); PG8_BAR; PG8_MMA(0, 0, At, B0); PG8_MMA(0, 1, At, B1); PG8_BAR; PG8_SCHED;
            PG8_LDA(At, 0, 1); PG8_STAGE(PG8_SB(0, 0), b2, voffB); PG8_STAGE(PG8_SB(0, 1), b2 + hstepB, voffB); PG8_STAGE(PG8_SA(0, 0), a2, voffA);
            PG8_WAIT_V(8); PG8_WAIT_L(0); PG8_BAR; PG8_MMA(1, 0, At, B0); PG8_MMA(1, 1, At, B1); PG8_BAR; PG8_SCHED;
            PG8_LDB(B0, 1, 0); PG8_LDB(B1, 1, 1); PG8_SCHED; PG8_LDA(At, 1, 0); PG8_STAGE(PG8_SA(0, 1), a2 + hstepA, voffA);
            PG8_WAIT_V(8); PG8_WAIT_L(0); PG8_BAR; PG8_MMA(0, 0, At, B0); PG8_MMA(0, 1, At, B1); PG8_BAR; PG8_SCHED;
            PG8_LDA(At, 1, 1); PG8_STAGE(PG8_SB(1, 0), b3, voffB); PG8_STAGE(PG8_SB(1, 1), b3 + hstepB, voffB); PG8_STAGE(PG8_SA(1, 0), a3, voffA);
            PG8_WAIT_V(8); PG8_WAIT_L(0); PG8_BAR; PG8_MMA(1, 0, At, B0); PG8_MMA(1, 1, At, B1); PG8_BAR; PG8_SCHED;
            } else {
            PG8_LDB(B0, 0, 0); PG8_SCHED; PG8_LDA(At, 0, 0); PG8_STAGE(PG8_SA(1, 1), a1 + hstepA, voffA);
            PG8_WAIT_L(8); PG8_BAR; PG8_WAIT_L(0); PG8_MMA(0, 0, At, B0); PG8_BAR; PG8_SCHED;
            PG8_LDB(B1, 0, 1); PG8_STAGE(PG8_SB(0, 0), b2, voffB);
            PG8_BAR; PG8_WAIT_L(0); PG8_MMA(0, 1, At, B1); PG8_BAR;
            PG8_LDA(At, 0, 1); PG8_STAGE(PG8_SA(0, 0), a2, voffA);
            PG8_BAR; PG8_WAIT_L(0); PG8_MMA(1, 0, At, B0); PG8_BAR; PG8_SCHED;
            PG8_STAGE(PG8_SB(0, 1), b2 + hstepB, voffB);
            PG8_WAIT_V(6); PG8_BAR; PG8_MMA(1, 1, At, B1); PG8_BAR;
            PG8_LDB(B0, 1, 0); PG8_SCHED; PG8_LDA(At, 1, 0); PG8_STAGE(PG8_SA(0, 1), a2 + hstepA, voffA);
            PG8_WAIT_L(8); PG8_BAR; PG8_WAIT_L(0); PG8_MMA(0, 0, At, B0); PG8_BAR; PG8_SCHED;
            PG8_LDB(B1, 1, 1); PG8_STAGE(PG8_SB(1, 0), b3, voffB);
            PG8_BAR; PG8_WAIT_L(0); PG8_MMA(0, 1, At, B1); PG8_BAR;
            PG8_LDA(At, 1, 1); PG8_STAGE(PG8_SA(1, 0), a3, voffA);
            PG8_BAR; PG8_WAIT_L(0); PG8_MMA(1, 0, At, B0); PG8_BAR; PG8_SCHED;
            PG8_STAGE(PG8_SB(1, 1), b3 + hstepB, voffB);
            PG8_WAIT_V(6); PG8_BAR; PG8_MMA(1, 1, At, B1); PG8_BAR;
            }
        }
        if constexpr (ALIGN_EPI) { if (wr == 0) PG8_BAR; }
        if constexpr (!Epi::AFTER_DRAIN) { E(acc, cur, wr, wc, fr, fq); S.done(cur); }
        if (!has_next) break;
#pragma unroll
        for (int a = 0; a < 2; ++a)
#pragma unroll
            for (int b = 0; b < 2; ++b)
#pragma unroll
                for (int m = 0; m < 4; ++m)
#pragma unroll
                    for (int n = 0; n < 2; ++n) acc[a][b][m][n] = (f32x4){0.f, 0.f, 0.f, 0.f};
        cur = nxt; cA = nA; cB = nB; ++ui;
        if constexpr (ALIGN_EPI) { if (wr == 1) PG8_BAR; }
    }
    PG8_WAIT_V(0);
    if constexpr (!ALIGN_EPI) { if (wr == 0) PG8_BAR; }
    PG8_BAR;
    if constexpr (Epi::AFTER_DRAIN) { E.fused(acc, cur, wr, wc, fr, fq, lds, wid, lane); S.done(cur); }
#undef PG8_SA
#undef PG8_SB
#undef PG8_STAGE
#undef PG8_LDA
#undef PG8_LDB
#undef PG8_MMA
#undef PG8_WAIT_V
#undef PG8_WAIT_L
#undef PG8_BAR
#undef PG8_SCHED
}
}

namespace pg8 {
template <int RELU2, int SCALE = 0> struct EpiStore {
    static constexpr bool PERM = true, AFTER_DRAIN = false;
    bf16_t* O; int ldc; const PG8_LAS float* rstd; mutable int cnt;
    __device__ __forceinline__ void operator()(const f32x4 (&acc)[2][2][4][2], const Unit& u, int wr, int wc, int fr, int fq) const {
        const int row0 = u.pm * BM + wr * 64 + fr, col0 = u.pn * BM + wc * 32 + 8 * fq;
#pragma unroll
        for (int ai = 0; ai < 2; ++ai)
#pragma unroll
            for (int m = 0; m < 4; ++m) { const int row = row0 + ai * HALF + m * 16; bf16_t* rowp = O + (size_t)row * ldc + col0;
                float rs = 1.f;
                if (SCALE) rs = rstd[cnt * 256 + wr * 64 + fr + ai * HALF + m * 16];
#pragma unroll
                for (int bj = 0; bj < 2; ++bj) { f32x4 v0 = acc[ai][bj][m][0] * rs, v1 = acc[ai][bj][m][1] * rs;
                    if (RELU2) {
#pragma unroll
                        for (int e = 0; e < 4; ++e) { const float a = fmaxf(v0[e], 0.f), b = fmaxf(v1[e], 0.f); v0[e] = a * a; v1[e] = b * b; } }
                    u32x4 w; w.x = cvt_pk_bf16(v0[0], v0[1]); w.y = cvt_pk_bf16(v0[2], v0[3]); w.z = cvt_pk_bf16(v1[0], v1[1]); w.w = cvt_pk_bf16(v1[2], v1[3]);
                    *(u32x4*)(rowp + bj * HALF) = w; } }
        if (SCALE) ++cnt;
    }
};

struct EpiStoreAB {
    static constexpr bool PERM = true, AFTER_DRAIN = false;
    bf16_t* O; int ldc; unsigned* kn2;
    __device__ __forceinline__ void operator()(const f32x4 (&acc)[2][2][4][2], const Unit& u, int wr, int wc, int fr, int fq) const {
        const int row0 = u.pm * BM + wr * 64 + fr, col0 = u.pn * BM + wc * 32 + 8 * fq;
#pragma unroll
        for (int ai = 0; ai < 2; ++ai)
#pragma unroll
            for (int m = 0; m < 4; ++m) { bf16_t* rowp = O + (size_t)(row0 + ai * HALF + m * 16) * ldc + col0;
#pragma unroll
                for (int bj = 0; bj < 2; ++bj) { const f32x4 v0 = acc[ai][bj][m][0], v1 = acc[ai][bj][m][1];
                    u32x4 w; w.x = cvt_pk_bf16(v0[0], v0[1]); w.y = cvt_pk_bf16(v0[2], v0[3]); w.z = cvt_pk_bf16(v1[0], v1[1]); w.w = cvt_pk_bf16(v1[2], v1[3]);
                    *(u32x4*)(rowp + bj * HALF) = w; } }
        if (u.pn == 2 || u.pn == 3) {
#pragma unroll
            for (int bj = 0; bj < 2; ++bj) { float mx = 0.f;
#pragma unroll
                for (int ai = 0; ai < 2; ++ai)
#pragma unroll
                    for (int m = 0; m < 4; ++m) { const f32x4 v0 = acc[ai][bj][m][0], v1 = acc[ai][bj][m][1];
                        float s = ((v0[0] * v0[0] + v0[1] * v0[1]) + (v0[2] * v0[2] + v0[3] * v0[3])) + ((v1[0] * v1[0] + v1[1] * v1[1]) + (v1[2] * v1[2] + v1[3] * v1[3]));
                        s += __shfl_xor(s, 16); s += __shfl_xor(s, 32); mx = fmaxf(mx, s); }
                mx = fmaxf(mx, __shfl_xor(mx, 1)); mx = fmaxf(mx, __shfl_xor(mx, 2)); mx = fmaxf(mx, __shfl_xor(mx, 4)); mx = fmaxf(mx, __shfl_xor(mx, 8));
                const int colb = u.pn * BM + bj * HALF + wc * 32 - 512, head = colb >> 6, half = (colb >> 5) & 1, b = u.pm >> 4;
                if (fr == 0 && fq == 0) atomicMax(kn2 + ((b * 8 + head) * 2 + half), __float_as_uint(mx * 1.02f)); }
        }
    }
};

struct EpiStoreCD {
    static constexpr bool PERM = true, AFTER_DRAIN = false;
    bf16_t* O; int ldc; const PG8_LAS float* rstd; float* ssq2; bf16_t* kr; const float* tab; mutable int cnt;
    __device__ __forceinline__ void operator()(const f32x4 (&acc)[2][2][4][2], const Unit& u, int wr, int wc, int fr, int fq) const {
        const int row0 = u.pm * BM + wr * 64 + fr, col0 = u.pn * BM + wc * 32 + 8 * fq;
#pragma unroll
        for (int ai = 0; ai < 2; ++ai)
#pragma unroll
            for (int m = 0; m < 4; ++m) { const int row = row0 + ai * HALF + m * 16; bf16_t* rowp = O + (size_t)row * ldc + col0;
                const float rs = rstd[cnt * 256 + wr * 64 + fr + ai * HALF + m * 16];
#pragma unroll
                for (int bj = 0; bj < 2; ++bj) { const f32x4 v0 = acc[ai][bj][m][0] * rs, v1 = acc[ai][bj][m][1] * rs;
                    u32x4 w; w.x = cvt_pk_bf16(v0[0], v0[1]); w.y = cvt_pk_bf16(v0[2], v0[3]); w.z = cvt_pk_bf16(v1[0], v1[1]); w.w = cvt_pk_bf16(v1[2], v1[3]);
                    *(u32x4*)(rowp + bj * HALF) = w;
                    const int cgp = u.pn * BM + bj * HALF + wc * 32;
                    if (cgp >= 1536 && cgp < 2176) {
                        float s = ((v0[0] * v0[0] + v0[1] * v0[1]) + (v0[2] * v0[2] + v0[3] * v0[3])) + ((v1[0] * v1[0] + v1[1] * v1[1]) + (v1[2] * v1[2] + v1[3] * v1[3]));
                        s += __shfl_xor(s, 16); s += __shfl_xor(s, 32);
                        if (fq == 0) ssq2[(size_t)row * 32 + ((cgp - 1536) >> 5)] = s;
                    } else if (cgp == 2176) {
                        const int i0 = 8 * (fq & 1);
                        const f32x4 c0 = *(const f32x4*)(tab + (size_t)row * 32 + i0), c1 = *(const f32x4*)(tab + (size_t)row * 32 + i0 + 4);
                        const f32x4 s0 = *(const f32x4*)(tab + (size_t)row * 32 + 16 + i0), s1 = *(const f32x4*)(tab + (size_t)row * 32 + 16 + i0 + 4);
                        f32x4 p0, p1;
#pragma unroll
                        for (int e = 0; e < 4; ++e) { p0[e] = __shfl_xor(v0[e], 32); p1[e] = __shfl_xor(v1[e], 32); }
                        f32x4 o0, o1;
                        if (fq < 2) { o0 = v0 * c0 - p0 * s0; o1 = v1 * c1 - p1 * s1; }
                        else        { o0 = v0 * c0 + p0 * s0; o1 = v1 * c1 + p1 * s1; }
                        u32x4 k; k.x = cvt_pk_bf16(o0[0], o0[1]); k.y = cvt_pk_bf16(o0[2], o0[3]); k.z = cvt_pk_bf16(o1[0], o1[1]); k.w = cvt_pk_bf16(o1[2], o1[3]);
                        *(u32x4*)(kr + (size_t)row * 32 + 8 * fq) = k;
                    } } }
        ++cnt;
    }
};
struct EpiResid {
    static constexpr bool PERM = false, AFTER_DRAIN = false;
    const float* base; float* out; int ldc;
    __device__ __forceinline__ void operator()(const f32x4 (&acc)[2][2][4][2], const Unit& u, int wr, int wc, int fr, int fq) const {
        const int row0 = u.pm * BM + wr * 64 + fr, col0 = u.pn * BM + wc * 32 + 4 * fq;
#pragma unroll
        for (int ai = 0; ai < 2; ++ai)
#pragma unroll
            for (int m = 0; m < 4; ++m) { const size_t off = (size_t)(row0 + ai * HALF + m * 16) * ldc + col0;
#pragma unroll
                for (int bj = 0; bj < 2; ++bj)
#pragma unroll
                    for (int n = 0; n < 2; ++n) { const size_t o = off + bj * HALF + n * 16; const f32x4 bs = *(const f32x4*)(base + o); *(f32x4*)(out + o) = bs + acc[ai][bj][m][n]; } }
    }
};

struct EpiResidN {
    static constexpr bool PERM = false, AFTER_DRAIN = false;
    const float* base; float* out; bf16_t* xn; float* ssq; int ldc;
    __device__ __forceinline__ void operator()(const f32x4 (&acc)[2][2][4][2], const Unit& u, int wr, int wc, int fr, int fq) const {
        typedef unsigned u32x2 __attribute__((ext_vector_type(2)));
        const int row0 = u.pm * BM + wr * 64 + fr, col0 = u.pn * BM + wc * 32 + 4 * fq;
#pragma unroll
        for (int ai = 0; ai < 2; ++ai)
#pragma unroll
            for (int m = 0; m < 4; ++m) { const int row = row0 + ai * HALF + m * 16; const size_t off = (size_t)row * ldc + col0; float s = 0.f;
#pragma unroll
                for (int bj = 0; bj < 2; ++bj)
#pragma unroll
                    for (int n = 0; n < 2; ++n) { const size_t o = off + bj * HALF + n * 16; const f32x4 v = *(const f32x4*)(base + o) + acc[ai][bj][m][n]; *(f32x4*)(out + o) = v;
                        u32x2 w; w.x = cvt_pk_bf16(v[0], v[1]); w.y = cvt_pk_bf16(v[2], v[3]); *(u32x2*)(xn + o) = w;
                        s += (v[0] * v[0] + v[1] * v[1]) + (v[2] * v[2] + v[3] * v[3]); }
                s += __shfl_xor(s, 16); s += __shfl_xor(s, 32);
                if (fq == 0) ssq[(size_t)row * 16 + u.pn * 4 + wc] = s; }
    }
};

template <int BASEF32> struct EpiResidB {
    static constexpr bool PERM = true, AFTER_DRAIN = false;
    const float* basef; bf16_t* xn; float* ssq; int ldc;
    __device__ __forceinline__ void operator()(const f32x4 (&acc)[2][2][4][2], const Unit& u, int wr, int wc, int fr, int fq) const {
        const int row0 = u.pm * BM + wr * 64 + fr, col0 = u.pn * BM + wc * 32 + 8 * fq;
#pragma unroll
        for (int ai = 0; ai < 2; ++ai)
#pragma unroll
            for (int m = 0; m < 4; ++m) { const int row = row0 + ai * HALF + m * 16; const size_t off = (size_t)row * ldc + col0; float s = 0.f;
#pragma unroll
                for (int bj = 0; bj < 2; ++bj) { const size_t o = off + bj * HALF; f32x4 b0, b1;
                    if (BASEF32) { b0 = *(const f32x4*)(basef + o); b1 = *(const f32x4*)(basef + o + 4); }
                    else { const u32x4 w = *(const u32x4*)(xn + o);
                        b0[0] = __uint_as_float(w.x << 16); b0[1] = __uint_as_float(w.x & 0xffff0000u); b0[2] = __uint_as_float(w.y << 16); b0[3] = __uint_as_float(w.y & 0xffff0000u);
                        b1[0] = __uint_as_float(w.z << 16); b1[1] = __uint_as_float(w.z & 0xffff0000u); b1[2] = __uint_as_float(w.w << 16); b1[3] = __uint_as_float(w.w & 0xffff0000u); }
                    const f32x4 v0 = acc[ai][bj][m][0] + b0, v1 = acc[ai][bj][m][1] + b1;
                    u32x4 w; w.x = cvt_pk_bf16(v0[0], v0[1]); w.y = cvt_pk_bf16(v0[2], v0[3]); w.z = cvt_pk_bf16(v1[0], v1[1]); w.w = cvt_pk_bf16(v1[2], v1[3]);
                    *(u32x4*)(xn + o) = w;
                    s += ((v0[0] * v0[0] + v0[1] * v0[1]) + (v0[2] * v0[2] + v0[3] * v0[3])) + ((v1[0] * v1[0] + v1[1] * v1[1]) + (v1[2] * v1[2] + v1[3] * v1[3])); }
                s += __shfl_xor(s, 16); s += __shfl_xor(s, 32);
                if (fq == 0) ssq[(size_t)row * 16 + u.pn * 4 + wc] = s; }
    }
};
struct EpiQRope {
    static constexpr bool PERM = false, AFTER_DRAIN = false;
    bf16_t* O; int ldc; const float* tab; const PG8_LAS float* rstd;
    __device__ __forceinline__ void operator()(const f32x4 (&acc)[2][2][4][2], const Unit& u, int wr, int wc, int fr, int fq) const {
        typedef unsigned u32x2 __attribute__((ext_vector_type(2)));
        const int row0 = u.pm * BM + wr * 64 + fr;
#pragma unroll
        for (int ai = 0; ai < 2; ++ai)
#pragma unroll
            for (int m = 0; m < 4; ++m) { const int row = row0 + ai * HALF + m * 16;
                const f32x4 cs = *(const f32x4*)(tab + (size_t)row * 32 + 4 * fq), sn = *(const f32x4*)(tab + (size_t)row * 32 + 16 + 4 * fq);
                const float rs = rstd[wr * 64 + fr + ai * HALF + m * 16];
#pragma unroll
                for (int bj = 0; bj < 2; ++bj) { const int cgp = u.pn * BM + bj * HALF + wc * 32;
                    f32x4 x1 = acc[ai][bj][m][0] * rs, x2 = acc[ai][bj][m][1] * rs;
                    if ((cgp % 96) == 64) { const f32x4 o1 = x1 * cs - x2 * sn, o2 = x2 * cs + x1 * sn; x1 = o1; x2 = o2; }
                    bf16_t* op = O + (size_t)row * ldc + cgp + 4 * fq;
                    u32x2 w1, w2; w1.x = cvt_pk_bf16(x1[0], x1[1]); w1.y = cvt_pk_bf16(x1[2], x1[3]); w2.x = cvt_pk_bf16(x2[0], x2[1]); w2.y = cvt_pk_bf16(x2[2], x2[3]);
                    *(u32x2*)op = w1; *(u32x2*)(op + 16) = w2; }
                asm volatile("" ::: "memory"); }
    }
};
}

#define DI __device__ __forceinline__
#define LAS __attribute__((address_space(3)))
typedef unsigned short bf16_t;
typedef short bf16x8 __attribute__((ext_vector_type(8)));
typedef short s16x4 __attribute__((ext_vector_type(4)));
typedef float f32x4 __attribute__((ext_vector_type(4)));
typedef float f32x16 __attribute__((ext_vector_type(16)));
typedef unsigned u32x4 __attribute__((ext_vector_type(4)));
typedef unsigned u32x2 __attribute__((ext_vector_type(2)));

constexpr int BATCH = 4, SEQ = 4096, DM = 1024, MT = BATCH * SEQ, DFF = 4096;
constexpr int LD_AB = 3072, LD_CD = 2304, NSRC_AB = 3080, NSRC_CD = 2208;
constexpr int NWAVES = 8, NTHREADS = 512;
constexpr float LOG2E = 1.4426950408889634f, LN2 = 0.6931471805599453f, EPS = 1e-6f;
constexpr size_t MiB = 1u << 20;
constexpr size_t WS_WINAB = 0, WS_WOUTAB = 6 * MiB, WS_WINCD = 8 * MiB, WS_WUQ = 13 * MiB, WS_WUKV = 14 * MiB, WS_WOUTCD = 15 * MiB;
constexpr size_t WS_WUP0 = 17 * MiB, WS_WUP1 = 25 * MiB, WS_WDN0 = 33 * MiB, WS_WDN1 = 41 * MiB;
constexpr size_t WS_LOGF = 49 * MiB, WS_CUM = 49 * MiB + 512 * 1024, WS_TAB = 50 * MiB, WS_KR = 52 * MiB, WS_SSQ = 53 * MiB, WS_SSQ2 = 86 * MiB;
constexpr size_t WS_XN = 54 * MiB, WS_CQN = 54 * MiB, WS_CKVN = 66 * MiB, WS_O = 86 * MiB;
constexpr size_t WS_BIG = 118 * MiB, WS_QF = 190 * MiB, WS_KVF = 214 * MiB, WS_CTL = 246 * MiB, CTL_BYTES = 65536, CTL_KN2 = 32768, CTL_QCTR = 40960, WS_END = 247 * MiB;
constexpr int LDS_BYTES = 147456, MISC_OFF = 131072 + 320;

DI float bf2f(unsigned short v) { return __uint_as_float((unsigned)v << 16); }
DI unsigned pk2(float lo, float hi) { typedef float f2 __attribute__((ext_vector_type(2))); typedef __bf16 b2 __attribute__((ext_vector_type(2))); f2 v = {lo, hi}; b2 b = __builtin_convertvector(v, b2); return __builtin_bit_cast(unsigned, b); }
DI float wave_sum(float v) {
#pragma unroll
    for (int o = 1; o < 64; o <<= 1) v += __shfl_xor(v, o);
    return v;
}
DI float fexp2(float x) { return __builtin_amdgcn_exp2f(x); }
DI float flog2(float x) { return __builtin_amdgcn_logf(x); }

DI void transpose_item(const float* W, int K, int ldn, int src_col0, bf16_t* WT, int dst_row0, int nblk, LAS float* scr, int item, int lane, const float* gain) {
    const int kb = item / nblk, nb = item % nblk, k0 = 64 * kb, n0 = 32 * nb;
    float wv[32];
#pragma unroll
    for (int i = 0; i < 32; ++i) { const int kk = 2 * i + (lane >> 5); wv[i] = W[(size_t)(k0 + kk) * ldn + src_col0 + n0 + (lane & 31)]; }
    if (gain) {
#pragma unroll
        for (int i = 0; i < 32; ++i) wv[i] *= gain[k0 + 2 * i + (lane >> 5)]; }
#pragma unroll
    for (int i = 0; i < 32; ++i) { const int kk = 2 * i + (lane >> 5); scr[kk * 33 + (lane & 31)] = wv[i]; }
    asm volatile("s_waitcnt lgkmcnt(0)" ::: "memory");
    const int c = lane & 7;
#pragma unroll
    for (int j = 0; j < 4; ++j) { const int n = (lane >> 3) + 8 * j; const LAS float* s = scr + (8 * c) * 33 + n;
        u32x4 o; o.x = pk2(s[0 * 33], s[1 * 33]); o.y = pk2(s[2 * 33], s[3 * 33]); o.z = pk2(s[4 * 33], s[5 * 33]); o.w = pk2(s[6 * 33], s[7 * 33]);
        *(u32x4*)(WT + (size_t)(dst_row0 + n0 + n) * K + k0 + 8 * c) = o; }
    asm volatile("s_waitcnt lgkmcnt(0)" ::: "memory");
}

DI void sincos_d(double a, float& sn, float& cs);
DI float inv_freq_f(int i);
template <bool FA> DI void norm_rows_bf16(const float* src, const float* gain, bf16_t* dst, int gw, int ngw, int lane, const LAS float* wfaT, const float* b_forget, float* logf_out, const int* pos, float* tab) {
    f32x4 g[4];
#pragma unroll
    for (int j = 0; j < 4; ++j) g[j] = ((const f32x4*)gain)[64 * j + lane];
    f32x4 nx[4];
    if (gw < MT) {
#pragma unroll
        for (int j = 0; j < 4; ++j) nx[j] = ((const f32x4*)(src + (size_t)gw * DM) + lane)[64 * j]; }
    for (int row = gw; row < MT; row += ngw) {
        f32x4 v[4]; float s = 0.f;
#pragma unroll
        for (int j = 0; j < 4; ++j) v[j] = nx[j];
        if (row + ngw < MT) {
#pragma unroll
            for (int j = 0; j < 4; ++j) nx[j] = ((const f32x4*)(src + (size_t)(row + ngw) * DM) + lane)[64 * j]; }
#pragma unroll
        for (int j = 0; j < 4; ++j) { s += (v[j].x * v[j].x + v[j].y * v[j].y) + (v[j].z * v[j].z + v[j].w * v[j].w); v[j] = v[j] * g[j]; }
        float a8[8];
        if (FA) {
#pragma unroll
            for (int jj = 0; jj < 8; ++jj) { float a = 0.f;
#pragma unroll
                for (int j = 0; j < 4; ++j) { const f32x4 w = *(const LAS f32x4*)(wfaT + jj * 1024 + 256 * j + 4 * lane); a += (v[j].x * w.x + v[j].y * w.y) + (v[j].z * w.z + v[j].w * w.w); }
                a8[jj] = a; }
        }
        const float rstd = 1.0f / sqrtf(wave_sum(s) * (1.f / DM) + EPS);
        unsigned long long* o8 = (unsigned long long*)(dst + (size_t)row * DM) + lane;
#pragma unroll
        for (int j = 0; j < 4; ++j) { const f32x4 y = v[j] * rstd; o8[64 * j] = (unsigned long long)pk2(y.x, y.y) | ((unsigned long long)pk2(y.z, y.w) << 32); }
        if (FA) {
            float b4[4], c2[2], d;
            { const bool up = (lane & 32) != 0;
#pragma unroll
              for (int i = 0; i < 4; ++i) { const float keep = up ? a8[i + 4] : a8[i], send = up ? a8[i] : a8[i + 4]; b4[i] = keep + __shfl_xor(send, 32); } }
            { const bool up = (lane & 16) != 0;
#pragma unroll
              for (int i = 0; i < 2; ++i) { const float keep = up ? b4[i + 2] : b4[i], send = up ? b4[i] : b4[i + 2]; c2[i] = keep + __shfl_xor(send, 16); } }
            { const bool up = (lane & 8) != 0; const float keep = up ? c2[1] : c2[0], send = up ? c2[0] : c2[1]; d = keep + __shfl_xor(send, 8); }
            d += __shfl_xor(d, 4); d += __shfl_xor(d, 2); d += __shfl_xor(d, 1);
            if ((lane & 7) == 0) { const int j = lane >> 3; const float t = d * rstd + b_forget[j]; const float ls = fminf(t, 0.f) - log1pf(expf(-fabsf(t))); logf_out[(size_t)row * 8 + j] = ls; }
            if (lane < 16) { const float ang = (float)pos[row] * inv_freq_f(lane); float sn, cs; sincos_d((double)ang, sn, cs); tab[(size_t)row * 32 + lane] = cs; tab[(size_t)row * 32 + 16 + lane] = sn; }
        }
    }
}
DI void norm_rows_final(const bf16_t* xb, float* out, const float* gain, int gw, int ngw, int lane) {
    f32x4 g[4];
#pragma unroll
    for (int hf = 0; hf < 2; ++hf) { g[2 * hf] = *(const f32x4*)(gain + 512 * hf + 8 * lane); g[2 * hf + 1] = *(const f32x4*)(gain + 512 * hf + 8 * lane + 4); }
    for (int row = gw; row < MT; row += ngw) {
        f32x4 v[4]; float s = 0.f;
#pragma unroll
        for (int hf = 0; hf < 2; ++hf) { const u32x4 w = *(const u32x4*)(xb + (size_t)row * DM + 512 * hf + 8 * lane);
            v[2 * hf][0] = __uint_as_float(w.x << 16); v[2 * hf][1] = __uint_as_float(w.x & 0xffff0000u); v[2 * hf][2] = __uint_as_float(w.y << 16); v[2 * hf][3] = __uint_as_float(w.y & 0xffff0000u);
            v[2 * hf + 1][0] = __uint_as_float(w.z << 16); v[2 * hf + 1][1] = __uint_as_float(w.z & 0xffff0000u); v[2 * hf + 1][2] = __uint_as_float(w.w << 16); v[2 * hf + 1][3] = __uint_as_float(w.w & 0xffff0000u); }
#pragma unroll
        for (int j = 0; j < 4; ++j) s += (v[j].x * v[j].x + v[j].y * v[j].y) + (v[j].z * v[j].z + v[j].w * v[j].w);
        const float rstd = 1.0f / sqrtf(wave_sum(s) * (1.f / DM) + EPS);
#pragma unroll
        for (int hf = 0; hf < 2; ++hf) { float* op = out + (size_t)row * DM + 512 * hf + 8 * lane; *(f32x4*)op = v[2 * hf] * rstd * g[2 * hf]; *(f32x4*)(op + 4) = v[2 * hf + 1] * rstd * g[2 * hf + 1]; }
    }
}

DI void sincos_d(double a, float& sn, float& cs) {
    const double n = rint(a * 0.63661977236758134308);
    const double r = fma(-n, 1.5707963267948966192, a) - n * 6.123233995736766e-17;
    const double r2 = r * r;
    double sp = -2.5052108385441718775e-8; sp = sp * r2 + 2.7557319223985890653e-6; sp = sp * r2 - 1.9841269841269841270e-4; sp = sp * r2 + 8.3333333333333333333e-3; sp = sp * r2 - 1.6666666666666666667e-1; sp = r + r * r2 * sp;
    double cp = 2.0876756987868098979e-9; cp = cp * r2 - 2.7557319223985890653e-7; cp = cp * r2 + 2.4801587301587301587e-5; cp = cp * r2 - 1.3888888888888888889e-3; cp = cp * r2 + 4.1666666666666666667e-2; cp = cp * r2 - 0.5; cp = 1.0 + r2 * cp;
    const int q = (int)((long long)n & 3);
    const double s_ = (q == 0) ? sp : (q == 1) ? cp : (q == 2) ? -sp : -cp;
    const double c_ = (q == 0) ? cp : (q == 1) ? -sp : (q == 2) ? -cp : sp;
    sn = (float)s_; cs = (float)c_;
}
DI float inv_freq_f(int i) {
    float r = 1.0f;
    r = (i == 1) ? 0.56234132519034908f : r;
    r = (i == 2) ? 0.31622776601683794f : r;
    r = (i == 3) ? 0.17782794100389228f : r;
    r = (i == 4) ? 0.1f : r;
    r = (i == 5) ? 0.056234132519034911f : r;
    r = (i == 6) ? 0.031622776601683791f : r;
    r = (i == 7) ? 0.017782794100389229f : r;
    r = (i == 8) ? 0.01f : r;
    r = (i == 9) ? 0.0056234132519034910f : r;
    r = (i == 10) ? 0.0031622776601683794f : r;
    r = (i == 11) ? 0.0017782794100389228f : r;
    r = (i == 12) ? 0.001f : r;
    r = (i == 13) ? 0.00056234132519034907f : r;
    r = (i == 14) ? 0.00031622776601683794f : r;
    r = (i == 15) ? 0.00017782794100389227f : r;
    return r;
}
DI void mla_prep_rows(const bf16_t* PC, const int* pos, const float* q_norm, const float* kv_norm, bf16_t* cqn, bf16_t* ckvn, float* tab, bf16_t* KR, int gw, int ngw, int lane) {
    for (int row = gw; row < MT; row += ngw) {
        const bf16_t* pr = PC + (size_t)row * LD_CD;
        {
            float v[8]; float s = 0.f;
            if (lane < 48) { const u32x4 w = *(const u32x4*)(pr + 1536 + 8 * lane);
#pragma unroll
                for (int e = 0; e < 4; ++e) { v[2 * e] = __uint_as_float(w[e] << 16); v[2 * e + 1] = __uint_as_float(w[e] & 0xffff0000u); s += v[2 * e] * v[2 * e] + v[2 * e + 1] * v[2 * e + 1]; } }
            else {
#pragma unroll
                for (int e = 0; e < 8; ++e) v[e] = 0.f; }
            const float rstd = 1.0f / sqrtf(wave_sum(s) * (1.f / 384.f) + EPS);
            if (lane < 48) { const f32x4 g0 = *(const f32x4*)(q_norm + 8 * lane), g1 = *(const f32x4*)(q_norm + 8 * lane + 4);
                u32x4 o; o.x = pk2(v[0] * rstd * g0.x, v[1] * rstd * g0.y); o.y = pk2(v[2] * rstd * g0.z, v[3] * rstd * g0.w); o.z = pk2(v[4] * rstd * g1.x, v[5] * rstd * g1.y); o.w = pk2(v[6] * rstd * g1.z, v[7] * rstd * g1.w);
                *(u32x4*)(cqn + (size_t)row * 384 + 8 * lane) = o; }
        }
        {
            float v[8]; float s = 0.f;
            if (lane < 32) { const u32x4 w = *(const u32x4*)(pr + 1920 + 8 * lane);
#pragma unroll
                for (int e = 0; e < 4; ++e) { v[2 * e] = __uint_as_float(w[e] << 16); v[2 * e + 1] = __uint_as_float(w[e] & 0xffff0000u); s += v[2 * e] * v[2 * e] + v[2 * e + 1] * v[2 * e + 1]; } }
            else {
#pragma unroll
                for (int e = 0; e < 8; ++e) v[e] = 0.f; }
            const float rstd = 1.0f / sqrtf(wave_sum(s) * (1.f / 256.f) + EPS);
            if (lane < 32) { const f32x4 g0 = *(const f32x4*)(kv_norm + 8 * lane), g1 = *(const f32x4*)(kv_norm + 8 * lane + 4);
                u32x4 o; o.x = pk2(v[0] * rstd * g0.x, v[1] * rstd * g0.y); o.y = pk2(v[2] * rstd * g0.z, v[3] * rstd * g0.w); o.z = pk2(v[4] * rstd * g1.x, v[5] * rstd * g1.y); o.w = pk2(v[6] * rstd * g1.z, v[7] * rstd * g1.w);
                *(u32x4*)(ckvn + (size_t)row * 256 + 8 * lane) = o; }
        }
        if (lane < 16) {
            const float cs = tab[(size_t)row * 32 + lane], sn = tab[(size_t)row * 32 + 16 + lane];
            const float x1 = bf2f(pr[2176 + lane]), x2 = bf2f(pr[2176 + 16 + lane]);
            KR[(size_t)row * 32 + lane] = (bf16_t)(pk2(x1 * cs - x2 * sn, 0.f) & 0xffffu);
            KR[(size_t)row * 32 + 16 + lane] = (bf16_t)(pk2(x2 * cs + x1 * sn, 0.f) & 0xffffu);
        }
    }
}

namespace att {
constexpr int KBUF = 13312, VBUF = 9216;
constexpr int OFF_K = 0, OFF_V = 2 * KBUF, OFF_C = OFF_V + 2 * VBUF, OFF_RB = OFF_C + 512, OFF_FLAG = OFF_RB + 1280, ATT_LDS = OFF_FLAG + 64;
DI f32x16 mfma(bf16x8 a, bf16x8 b, f32x16 c) { return __builtin_amdgcn_mfma_f32_32x32x16_bf16(a, b, c, 0, 0, 0); }
DI int crow(int i, int hh) { return (i & 3) + 8 * (i >> 2) + 4 * hh; }
DI bf16x8 packfrag(const f32x16& p, int s) { u32x4 w; w.x = pk2(p[8 * s], p[8 * s + 1]); w.y = pk2(p[8 * s + 2], p[8 * s + 3]); w.z = pk2(p[8 * s + 4], p[8 * s + 5]); w.w = pk2(p[8 * s + 6], p[8 * s + 7]); return __builtin_bit_cast(bf16x8, w); }
typedef short v4i16_t __attribute__((ext_vector_type(4)));
DI s16x4 vtr(const LAS unsigned char* p) { return __builtin_bit_cast(s16x4, __builtin_amdgcn_ds_read_tr16_b64_v4i16((LAS v4i16_t*)p)); }

struct Lane { int tid, lane, wid, r, hh, q4, p4, blk, srow, sch; };
DI Lane mklane() { Lane L; L.tid = threadIdx.x; L.lane = L.tid & 63; L.wid = __builtin_amdgcn_readfirstlane(L.tid >> 6); L.r = L.lane & 31; L.hh = L.lane >> 5;
    const int i16 = L.lane & 15; L.q4 = i16 >> 2; L.p4 = i16 & 3; L.blk = (L.lane >> 4) & 1; L.srow = L.tid >> 3; L.sch = L.tid & 7; return L; }

template <int NDS, int KSTRIDE> DI void qk_tile(f32x16& p0, f32x16& p1, const LAS unsigned char* Kb, const bf16x8* qf, const Lane& L) {
    const LAS unsigned char* ka = Kb + L.r * KSTRIDE + L.hh * 16;
#pragma unroll
    for (int i = 0; i < 16; ++i) { p0[i] = 0.f; p1[i] = 0.f; }
#pragma unroll
    for (int ds = 0; ds < NDS; ++ds) {
        const bf16x8 a0 = *(const LAS bf16x8*)(ka + ds * 32), a1 = *(const LAS bf16x8*)(ka + 32 * KSTRIDE + ds * 32);
        p0 = mfma(a0, qf[ds], p0); p1 = mfma(a1, qf[ds], p1); }
}
DI void pv_tile(f32x16& o0, f32x16& o1, const LAS unsigned char* Vb, const bf16x8 (&pf)[4], const Lane& L) {
    const LAS unsigned char* vb = Vb + (4 * L.hh + L.q4) * 144 + (16 * L.blk + 4 * L.p4) * 2;
#pragma unroll
    for (int f = 0; f < 4; ++f) { const LAS unsigned char* base = vb + (16 * f) * 144;
        { const s16x4 lo = vtr(base), hi = vtr(base + 8 * 144); const bf16x8 vf = __builtin_shufflevector(lo, hi, 0, 1, 2, 3, 4, 5, 6, 7); o0 = mfma(vf, pf[f], o0); }
        { const s16x4 lo = vtr(base + 64), hi = vtr(base + 8 * 144 + 64); const bf16x8 vf = __builtin_shufflevector(lo, hi, 0, 1, 2, 3, 4, 5, 6, 7); o1 = mfma(vf, pf[f], o1); } }
}
DI void online_softmax(f32x16& p0, f32x16& p1, float& m, float& l, f32x16& o0, f32x16& o1, bf16x8 (&pf)[4]) {
    float mt = fmaxf(p0[0], p1[0]);
#pragma unroll
    for (int i = 1; i < 16; ++i) mt = fmaxf(mt, fmaxf(p0[i], p1[i]));
    mt = fmaxf(mt, __shfl_xor(mt, 32));
    if (__any(mt > m)) {
        const float mn = fmaxf(m, mt), alpha = fexp2(m - mn); m = mn; l *= alpha;
#pragma unroll
        for (int i = 0; i < 16; ++i) { o0[i] *= alpha; o1[i] *= alpha; }
    }
    float rs = 0.f;
#pragma unroll
    for (int i = 0; i < 16; ++i) { p0[i] = fexp2(p0[i] - m); p1[i] = fexp2(p1[i] - m); rs += p0[i] + p1[i]; }
    l += rs;
    pf[0] = packfrag(p0, 0); pf[1] = packfrag(p0, 1); pf[2] = packfrag(p1, 0); pf[3] = packfrag(p1, 1);
}
DI void store_o(bf16_t* orow, const f32x16& o0, const f32x16& o1, float inv, int hh) {
#pragma unroll
    for (int g = 0; g < 4; ++g) {
        u32x2 w0, w1; w0.x = pk2(o0[4 * g] * inv, o0[4 * g + 1] * inv); w0.y = pk2(o0[4 * g + 2] * inv, o0[4 * g + 3] * inv);
        w1.x = pk2(o1[4 * g] * inv, o1[4 * g + 1] * inv); w1.y = pk2(o1[4 * g + 2] * inv, o1[4 * g + 3] * inv);
        *(u32x2*)(orow + 8 * g + 4 * hh) = w0; *(u32x2*)(orow + 32 + 8 * g + 4 * hh) = w1; }
}

DI void fox_unit(LAS unsigned char* lds, const bf16_t* PA, const float* cum, const unsigned* kn2, bf16_t* O, int b, int h, int qb) {
    const Lane L = mklane();
    const size_t rowbase = (size_t)b * SEQ;
    const int q0 = qb * 256, q0w = q0 + L.wid * 32, myq = q0w + L.r;
    const bf16_t* Qp = PA + (rowbase + myq) * LD_AB + h * 64;
    const bf16_t* Kp = PA + rowbase * LD_AB + 512 + h * 64;
    const bf16_t* Vp = Kp + 512;
    const float* cumh = cum + (size_t)(b * 8 + h) * SEQ;
    bf16x8 qf[4];
#pragma unroll
    for (int ds = 0; ds < 4; ++ds) qf[ds] = *(const bf16x8*)(Qp + 16 * ds + 8 * L.hh);
    const float c1 = 0.125f * LOG2E;
    float qn2 = 0.f;
#pragma unroll
    for (int ds = 0; ds < 4; ++ds)
#pragma unroll
        for (int j = 0; j < 8; ++j) { const float qv = bf2f((unsigned short)qf[ds][j]); qn2 += qv * qv; }
    qn2 += __shfl_xor(qn2, 32);
    const float kmax2 = __uint_as_float(kn2[(b * 8 + h) * 2]) + __uint_as_float(kn2[(b * 8 + h) * 2 + 1]);
    const float smax = sqrtf(qn2 * kmax2) * c1 * 1.01f + 1e-3f;
    const int NT = (q0 + 256) / 64;
    float m = -INFINITY, l = 0.f; f32x16 o0, o1;
#pragma unroll
    for (int i = 0; i < 16; ++i) { o0[i] = 0.f; o1[i] = 0.f; }
    bool seen = false;
    LAS int* flags = (LAS int*)(lds + OFF_FLAG);
    u32x4 kreg, vreg; float creg = 0.f;
#define FOX_LOAD(t) do { kreg = *(const u32x4*)(Kp + (size_t)((t) * 64 + L.srow) * LD_AB + L.sch * 8); vreg = *(const u32x4*)(Vp + (size_t)((t) * 64 + L.srow) * LD_AB + L.sch * 8); \
        if (L.tid < 64) creg = cumh[(t) * 64 + L.tid] * (-LOG2E); } while (0)
#define FOX_WRITE(bf) do { *(LAS u32x4*)(lds + OFF_K + (bf) * KBUF + L.srow * 144 + L.sch * 16) = kreg; *(LAS u32x4*)(lds + OFF_V + (bf) * VBUF + L.srow * 144 + L.sch * 16) = vreg; \
        if (L.tid < 64) *(LAS float*)(lds + OFF_C + (bf) * 256 + L.tid * 4) = creg; } while (0)
    FOX_LOAD(NT - 1); FOX_WRITE(0); __syncthreads();
    for (int it = 0; it < NT; ++it) {
        const int t = NT - 1 - it, k0 = t * 64, bf = it & 1;
        if (t > 0) FOX_LOAD(t - 1);
        bool done = false;
        if (k0 <= q0w + 31) {
            const LAS unsigned char* Cb = lds + OFF_C + bf * 256;
            const float nck_last = *(const LAS float*)(Cb + 63 * 4);
            done = seen && __all(smax + nck_last - m < -32.0f);
            if (!done) {
                f32x16 p0, p1;
                qk_tile<4, 144>(p0, p1, lds + OFF_K + bf * KBUF, qf, L);
#pragma unroll
                for (int g = 0; g < 4; ++g) { const f32x4 ca = *(const LAS f32x4*)(Cb + (8 * g + 4 * L.hh) * 4), cb = *(const LAS f32x4*)(Cb + (32 + 8 * g + 4 * L.hh) * 4);
#pragma unroll
                    for (int e = 0; e < 4; ++e) { p0[4 * g + e] = fmaf(p0[4 * g + e], c1, ca[e]); p1[4 * g + e] = fmaf(p1[4 * g + e], c1, cb[e]); } }
                if (k0 + 63 > q0w) {
#pragma unroll
                    for (int i = 0; i < 16; ++i) { const int key = k0 + crow(i, L.hh); if (key > myq) p0[i] = -INFINITY; if (key + 32 > myq) p1[i] = -INFINITY; } }
                bf16x8 pf[4];
                online_softmax(p0, p1, m, l, o0, o1, pf);
                pv_tile(o0, o1, lds + OFF_V + bf * VBUF, pf, L);
                seen = true;
            }
        }
        if (L.lane == 0) flags[(it & 1) * 8 + L.wid] = done ? 1 : 0;
        if (t > 0) FOX_WRITE((it + 1) & 1);
        __syncthreads();
        int alld = 1;
#pragma unroll
        for (int w = 0; w < 8; ++w) alld &= flags[(it & 1) * 8 + w];
        if (alld) break;
    }
#undef FOX_LOAD
#undef FOX_WRITE
    const float lt = l + __shfl_xor(l, 32);
    store_o(O + (rowbase + myq) * DM + h * 64, o0, o1, 1.0f / lt, L.hh);
    __syncthreads();
}

DI void chk_unit(LAS unsigned char* lds, const bf16_t* PA, const float* rel_bias, bf16_t* O, int b, int h, int g4) {
    const Lane L = mklane();
    const size_t rowbase = (size_t)b * SEQ;
    const int cw = 4 * g4 + (L.wid >> 1), myq = 64 * cw + 32 * (L.wid & 1) + L.r;
    const bf16_t* Qp = PA + (rowbase + myq) * LD_AB + 1536 + h * 64;
    const bf16_t* Kp = PA + rowbase * LD_AB + 2048 + h * 64;
    const bf16_t* Vp = Kp + 512;
    bf16x8 qf[4];
#pragma unroll
    for (int ds = 0; ds < 4; ++ds) qf[ds] = *(const bf16x8*)(Qp + 16 * ds + 8 * L.hh);
    const float c1 = 0.125f * LOG2E;
    const int c_lo = (4 * g4 - 8) > 0 ? (4 * g4 - 8) : 0, NT = 4 * g4 + 4 - c_lo;
    LAS float* rb = (LAS float*)(lds + OFF_RB);
    if (L.tid < 320) rb[L.tid] = rel_bias[h * 320 + L.tid] * LOG2E;
    float m = -INFINITY, l = 0.f; f32x16 o0, o1;
#pragma unroll
    for (int i = 0; i < 16; ++i) { o0[i] = 0.f; o1[i] = 0.f; }
    u32x4 kreg, vreg;
#define CHK_LOAD(t) do { kreg = *(const u32x4*)(Kp + (size_t)((c_lo + (t)) * 64 + L.srow) * LD_AB + L.sch * 8); vreg = *(const u32x4*)(Vp + (size_t)((c_lo + (t)) * 64 + L.srow) * LD_AB + L.sch * 8); } while (0)
#define CHK_WRITE(bf) do { *(LAS u32x4*)(lds + OFF_K + (bf) * KBUF + L.srow * 144 + L.sch * 16) = kreg; *(LAS u32x4*)(lds + OFF_V + (bf) * VBUF + L.srow * 144 + L.sch * 16) = vreg; } while (0)
    CHK_LOAD(0); CHK_WRITE(0); __syncthreads();
    for (int t = 0; t < NT; ++t) {
        if (t + 1 < NT) CHK_LOAD(t + 1);
        const int kc = c_lo + t, bf = t & 1;
        if (kc >= cw - 8 && kc <= cw) {
            f32x16 p0, p1;
            qk_tile<4, 144>(p0, p1, lds + OFF_K + bf * KBUF, qf, L);
            if (cw - kc >= 5) { const float bb = rb[319];
#pragma unroll
                for (int i = 0; i < 16; ++i) { p0[i] = fmaf(p0[i], c1, bb); p1[i] = fmaf(p1[i], c1, bb); } }
            else {
#pragma unroll
                for (int i = 0; i < 16; ++i) { const int rel = myq - (64 * kc + crow(i, L.hh));
                    const int i0 = (rel < 256 ? rel : 256) + 63, i1 = (rel - 32 < 256 ? rel - 32 : 256) + 63;
                    p0[i] = fmaf(p0[i], c1, rb[i0]); p1[i] = fmaf(p1[i], c1, rb[i1]); } }
            bf16x8 pf[4];
            online_softmax(p0, p1, m, l, o0, o1, pf);
            pv_tile(o0, o1, lds + OFF_V + bf * VBUF, pf, L);
        }
        if (t + 1 < NT) CHK_WRITE((t + 1) & 1);
        __syncthreads();
    }
#undef CHK_LOAD
#undef CHK_WRITE
    const float lt = l + __shfl_xor(l, 32);
    store_o(O + (rowbase + myq) * DM + 512 + h * 64, o0, o1, 1.0f / lt, L.hh);
}

DI void mla_unit(LAS unsigned char* lds, const bf16_t* QF, const bf16_t* KVF, const bf16_t* KR, bf16_t* O, int b, int h, int qb) {
    const Lane L = mklane();
    const size_t rowbase = (size_t)b * SEQ;
    const int cw = 4 * qb + (L.wid >> 1), myq = 64 * cw + 32 * (L.wid & 1) + L.r;
    const bf16_t* Qp = QF + (rowbase + myq) * 768 + h * 96;
    const bf16_t* Kp = KVF + rowbase * 1024 + h * 128;
    const bf16_t* Vp = Kp + 64;
    const bf16_t* Rp = KR + rowbase * 32;
    bf16x8 qf[6];
#pragma unroll
    for (int ds = 0; ds < 6; ++ds) qf[ds] = *(const bf16x8*)(Qp + 16 * ds + 8 * L.hh);
    const float c1 = 0.10206207261596577f * LOG2E;
    const int NT = 4 * qb + 4;
    float m = -INFINITY, l = 0.f; f32x16 o0, o1;
#pragma unroll
    for (int i = 0; i < 16; ++i) { o0[i] = 0.f; o1[i] = 0.f; }
    u32x4 kreg, vreg, rreg;
#define MLA_LOAD(t) do { kreg = *(const u32x4*)(Kp + (size_t)((t) * 64 + L.srow) * 1024 + L.sch * 8); vreg = *(const u32x4*)(Vp + (size_t)((t) * 64 + L.srow) * 1024 + L.sch * 8); \
        if (L.tid < 256) rreg = *(const u32x4*)(Rp + (size_t)((t) * 64 + (L.tid >> 2)) * 32 + (L.tid & 3) * 8); } while (0)
#define MLA_WRITE(bf) do { *(LAS u32x4*)(lds + OFF_K + (bf) * KBUF + L.srow * 208 + L.sch * 16) = kreg; *(LAS u32x4*)(lds + OFF_V + (bf) * VBUF + L.srow * 144 + L.sch * 16) = vreg; \
        if (L.tid < 256) *(LAS u32x4*)(lds + OFF_K + (bf) * KBUF + (L.tid >> 2) * 208 + 128 + (L.tid & 3) * 16) = rreg; } while (0)
    MLA_LOAD(0); MLA_WRITE(0); __syncthreads();
    for (int t = 0; t < NT; ++t) {
        if (t + 1 < NT) MLA_LOAD(t + 1);
        const int bf = t & 1;
        if (t <= cw) {
            f32x16 p0, p1;
            qk_tile<6, 208>(p0, p1, lds + OFF_K + bf * KBUF, qf, L);
#pragma unroll
            for (int i = 0; i < 16; ++i) { p0[i] *= c1; p1[i] *= c1; }
            bf16x8 pf[4];
            online_softmax(p0, p1, m, l, o0, o1, pf);
            pv_tile(o0, o1, lds + OFF_V + bf * VBUF, pf, L);
        }
        if (t + 1 < NT) MLA_WRITE((t + 1) & 1);
        __syncthreads();
    }
#undef MLA_LOAD
#undef MLA_WRITE
    const float lt = l + __shfl_xor(l, 32);
    store_o(O + (rowbase + myq) * DM + 512 + h * 64, o0, o1, 1.0f / lt, L.hh);
}

DI void sb_sub(f32x16& p, float& R, int keybase, int myq, int hh, bool need_mask) {
    float lk[16], lb[16];
#pragma unroll
    for (int i = 0; i < 16; ++i) {
        const float z2 = p[i] * (0.125f * LOG2E), u = fexp2(-fabsf(z2)), sp = fmaxf(z2, 0.f) + flog2(1.0f + u);
        const bool valid = !need_mask || (keybase + crow(i, hh)) < myq;
        lk[i] = valid ? -sp : 0.f; lb[i] = valid ? (z2 - sp) : -INFINITY; }
    float G[4], Gp[4];
#pragma unroll
    for (int g = 0; g < 4; ++g) { G[g] = (lk[4 * g] + lk[4 * g + 1]) + (lk[4 * g + 2] + lk[4 * g + 3]); Gp[g] = __shfl_xor(G[g], 32); }
    float acc = R;
#pragma unroll
    for (int g = 3; g >= 0; --g) {
        const float s3 = hh ? acc : acc + Gp[g];
        acc += G[g] + Gp[g];
        const float s2 = s3 + lk[4 * g + 3], s1 = s2 + lk[4 * g + 2], s0 = s1 + lk[4 * g + 1];
        p[4 * g + 3] = fexp2(lb[4 * g + 3] + s3); p[4 * g + 2] = fexp2(lb[4 * g + 2] + s2);
        p[4 * g + 1] = fexp2(lb[4 * g + 1] + s1); p[4 * g] = fexp2(lb[4 * g] + s0); }
    R = acc;
}
DI void sb_unit(LAS unsigned char* lds, const bf16_t* PC, bf16_t* O, int b, int h, int qb) {
    const Lane L = mklane();
    const size_t rowbase = (size_t)b * SEQ;
    const int q0 = qb * 256, q0w = q0 + L.wid * 32, myq = q0w + L.r;
    const bf16_t* Qp = PC + (rowbase + myq) * LD_CD + h * 64;
    const bf16_t* Kp = PC + rowbase * LD_CD + 512 + h * 64;
    const bf16_t* Vp = Kp + 512;
    bf16x8 qf[4];
#pragma unroll
    for (int ds = 0; ds < 4; ++ds) qf[ds] = *(const bf16x8*)(Qp + 16 * ds + 8 * L.hh);
    const int NT = (q0 + 256) / 64;
    float R = 0.f; f32x16 o0, o1;
#pragma unroll
    for (int i = 0; i < 16; ++i) { o0[i] = 0.f; o1[i] = 0.f; }
    bool seen = false;
    LAS int* flags = (LAS int*)(lds + OFF_FLAG);
    u32x4 kreg, vreg;
#define SB_LOAD(t) do { kreg = *(const u32x4*)(Kp + (size_t)((t) * 64 + L.srow) * LD_CD + L.sch * 8); vreg = *(const u32x4*)(Vp + (size_t)((t) * 64 + L.srow) * LD_CD + L.sch * 8); } while (0)
#define SB_WRITE(bf) do { *(LAS u32x4*)(lds + OFF_K + (bf) * KBUF + L.srow * 144 + L.sch * 16) = kreg; *(LAS u32x4*)(lds + OFF_V + (bf) * VBUF + L.srow * 144 + L.sch * 16) = vreg; } while (0)
    SB_LOAD(NT - 1); SB_WRITE(0); __syncthreads();
    for (int it = 0; it < NT; ++it) {
        const int t = NT - 1 - it, k0 = t * 64, bf = it & 1;
        if (t > 0) SB_LOAD(t - 1);
        bool done = false;
        if (k0 <= q0w + 31) {
            done = seen && __all(R < -152.0f);
            if (!done) {
                f32x16 p0, p1;
                qk_tile<4, 144>(p0, p1, lds + OFF_K + bf * KBUF, qf, L);
                const bool nm = (k0 + 63 >= q0w);
                sb_sub(p1, R, k0 + 32, myq, L.hh, nm);
                sb_sub(p0, R, k0, myq, L.hh, nm);
                bf16x8 pf[4];
                pf[0] = packfrag(p0, 0); pf[1] = packfrag(p0, 1); pf[2] = packfrag(p1, 0); pf[3] = packfrag(p1, 1);
                pv_tile(o0, o1, lds + OFF_V + bf * VBUF, pf, L);
                seen = true;
                done = __all(R < -152.0f);
            }
        }
        if (L.lane == 0) flags[(it & 1) * 8 + L.wid] = done ? 1 : 0;
        if (t > 0) SB_WRITE((it + 1) & 1);
        __syncthreads();
        int alld = 1;
#pragma unroll
        for (int w = 0; w < 8; ++w) alld &= flags[(it & 1) * 8 + w];
        if (alld) break;
    }
#undef SB_LOAD
#undef SB_WRITE
    store_o(O + (rowbase + myq) * DM + h * 64, o0, o1, 1.0f, L.hh);
    __syncthreads();
}
}

#define XB_TMO      128
#define XB_XCNT(j)  (256  + 64 * (j))
#define XB_XSUB(j)  (1280 + 64 * (j))
#define XB_XGEN(j)  (2304 + 64 * (j))
#define XB_TOP      3328
#define XB_TOPGEN   3392
#define XCD_BAR_WORDS 3456
#define XB_SPIN_CAP (1u << 18)

__device__ __forceinline__ unsigned xb_ld(unsigned* p)              { return __hip_atomic_load(p, __ATOMIC_RELAXED, __HIP_MEMORY_SCOPE_AGENT); }
__device__ __forceinline__ unsigned xb_add(unsigned* p, unsigned v) { return __hip_atomic_fetch_add(p, v, __ATOMIC_RELAXED, __HIP_MEMORY_SCOPE_AGENT); }
__device__ __forceinline__ unsigned xb_xcc_id() { return (unsigned)__builtin_amdgcn_s_getreg((3 << 11) | 20) & 0xFu; }
#define XB_SPIN(cond, bar) do { unsigned _sp = 0; while (cond) { __builtin_amdgcn_s_sleep(1); \
    if ((++_sp & 255u) == 0u) { if (xb_ld(&(bar)[XB_TMO])) break; if (_sp > XB_SPIN_CAP) { atomicAdd(&(bar)[XB_TMO], 1u); break; } } } } while (0)

struct XcdBarrier {
    unsigned* bar; unsigned x;
    volatile LAS unsigned* st;
};

__device__ __forceinline__ XcdBarrier xcd_barrier_post(unsigned* bar, volatile LAS unsigned* st) {
    XcdBarrier b; b.bar = bar; b.x = xb_xcc_id(); b.st = st;
    if (threadIdx.x == 0) (void)xb_add(&bar[XB_XCNT(b.x)], 1u);
    return b;
}
__device__ __forceinline__ void xcd_barrier_complete(unsigned* bar, unsigned x, unsigned& nloc, unsigned& nx) {
    const unsigned G = gridDim.x * gridDim.y * gridDim.z;
    unsigned sum, cnt, mine, sp = 0u;
    for (;;) {
        sum = 0u; cnt = 0u; mine = 0u;
#pragma unroll
        for (unsigned j = 0; j < 16; ++j) { const unsigned c = xb_ld(&bar[XB_XCNT(j)]); sum += c; cnt += (c > 0u) ? 1u : 0u; mine = (j == x) ? c : mine; }
        if (sum == G) break;
        __builtin_amdgcn_s_sleep(1);
        if ((++sp & 255u) == 0u) { if (xb_ld(&bar[XB_TMO])) break; if (sp > XB_SPIN_CAP) { atomicAdd(&bar[XB_TMO], 1u); break; } }
    }
    nloc = mine > 0u ? mine : 1u; nx = cnt > 0u ? cnt : 1u;
}

__device__ __forceinline__ void xcd_barrier(const XcdBarrier& b) {
    asm volatile("s_waitcnt vmcnt(0)" ::: "memory");
    __syncthreads();
    if (threadIdx.x == 0) {
        unsigned* bar = b.bar;
        __builtin_amdgcn_s_waitcnt(0);
        unsigned nloc = b.st[0], nx = b.st[1];
        if (nloc == 0u) { xcd_barrier_complete(bar, b.x, nloc, nx); b.st[0] = nloc; b.st[1] = nx; }
        const unsigned old = xb_add(&bar[XB_XSUB(b.x)], 1u);
        const unsigned gen = old / nloc;
        if (old + 1u == (gen + 1u) * nloc) {
            __builtin_amdgcn_fence(__ATOMIC_RELEASE, "agent");
            asm volatile("s_waitcnt vmcnt(0)" ::: "memory");
            const unsigned og = xb_add(&bar[XB_TOP], 1u);
            const unsigned tg = og / nx;
            if (og + 1u == (tg + 1u) * nx) xb_add(&bar[XB_TOPGEN], 1u);
            else XB_SPIN(xb_ld(&bar[XB_TOPGEN]) == tg, bar);
            __builtin_amdgcn_fence(__ATOMIC_ACQUIRE, "agent");
            xb_add(&bar[XB_XGEN(b.x)], 1u);
            asm volatile("s_waitcnt vmcnt(0)" ::: "memory");
        } else {
            XB_SPIN(xb_ld(&bar[XB_XGEN(b.x)]) == gen, bar);
            __builtin_amdgcn_fence(__ATOMIC_ACQUIRE, "agent");
            asm volatile("s_waitcnt vmcnt(0)" ::: "memory");
        }
    }
    __syncthreads();
}


constexpr int RSTD_OFF = 131072 + 1024;
DI void rstd_prepass(LAS unsigned char* lds, const pg8::StaticOrder& S, const float* ssq, int tid) {
    LAS float* tab = (LAS float*)(lds + RSTD_OFF);
    pg8::Unit u;
#pragma unroll 1
    for (int i = 0; i < 4 && S.next(i, u); ++i) {
        const int r = tid >> 1, hf = tid & 1;
        const f32x4* sp = (const f32x4*)(ssq + (size_t)(u.pm * 256 + r) * 16 + hf * 8);
        const f32x4 a = sp[0], b = sp[1];
        float t = ((a[0] + a[1]) + (a[2] + a[3])) + ((b[0] + b[1]) + (b[2] + b[3]));
        t += __shfl_xor(t, 1);
        if (hf == 0) tab[i * 256 + r] = 1.0f / sqrtf(t * (1.0f / 1024.0f) + EPS);
    }
    __syncthreads();
}

DI void rstd_prepass_lr(LAS unsigned char* lds, const pg8::StaticOrder& S, const float* ssq2, int g0, int nq4, float inv_width, int tid) {
    LAS float* tab = (LAS float*)(lds + RSTD_OFF);
    pg8::Unit u;
    if (S.next(0, u)) {
        if (tid < 256) {
            const f32x4* sp = (const f32x4*)(ssq2 + (size_t)(u.pm * 256 + tid) * 32 + g0);
            float t = 0.f;
            for (int i = 0; i < nq4; ++i) { const f32x4 a = sp[i]; t += (a[0] + a[1]) + (a[2] + a[3]); }
            tab[tid] = 1.0f / sqrtf(t * inv_width + EPS);
        }
    }
    __syncthreads();
}
struct Params {
    const float* x; const int* pos; const float* norm_mix; const float* norm_mlp; const float* norm_final;
    const float* w_in_ab; const float* b_forget; const float* rel_bias; const float* w_out_ab;
    const float* w_in_cd; const float* q_norm; const float* kv_norm; const float* w_uq; const float* w_ukv; const float* w_out_cd;
    const float* w_up; const float* w_down;
    float* out; unsigned char* ws; int ph_lo, ph_hi, coop, pad;
};
constexpr int N_PHASES = 17;

__global__ void __launch_bounds__(NTHREADS) fwd_kernel(Params P) {
    extern __shared__ __attribute__((aligned(16))) unsigned char lds_raw[];
    LAS unsigned char* lds = (LAS unsigned char*)lds_raw;
    const int tid = threadIdx.x, lane = tid & 63, wave = __builtin_amdgcn_readfirstlane(tid >> 6);
    const int G = gridDim.x, bx = blockIdx.x;
    const int vcu = (G % 8 == 0) ? (bx % 8) * (G / 8) + bx / 8 : bx;
    const int gw = vcu * NWAVES + wave, ngw = G * NWAVES;
    unsigned char* ws = P.ws;
    bf16_t* WinAB = (bf16_t*)(ws + WS_WINAB); bf16_t* WoutAB = (bf16_t*)(ws + WS_WOUTAB); bf16_t* WinCD = (bf16_t*)(ws + WS_WINCD);
    bf16_t* Wuq = (bf16_t*)(ws + WS_WUQ); bf16_t* Wukv = (bf16_t*)(ws + WS_WUKV); bf16_t* WoutCD = (bf16_t*)(ws + WS_WOUTCD);
    bf16_t* Wup0 = (bf16_t*)(ws + WS_WUP0); bf16_t* Wup1 = (bf16_t*)(ws + WS_WUP1); bf16_t* Wdn0 = (bf16_t*)(ws + WS_WDN0); bf16_t* Wdn1 = (bf16_t*)(ws + WS_WDN1);
    float* LOGF = (float*)(ws + WS_LOGF); float* CUM = (float*)(ws + WS_CUM); float* TAB = (float*)(ws + WS_TAB); bf16_t* KR = (bf16_t*)(ws + WS_KR); float* SSQ = (float*)(ws + WS_SSQ); float* SSQ2 = (float*)(ws + WS_SSQ2); unsigned* KN2 = (unsigned*)(ws + WS_CTL + CTL_KN2);
    bf16_t* XN = (bf16_t*)(ws + WS_XN); bf16_t* CQN = (bf16_t*)(ws + WS_CQN); bf16_t* CKVN = (bf16_t*)(ws + WS_CKVN); bf16_t* OB = (bf16_t*)(ws + WS_O);
    bf16_t* BIG = (bf16_t*)(ws + WS_BIG); bf16_t* QF = (bf16_t*)(ws + WS_QF); bf16_t* KVF = (bf16_t*)(ws + WS_KVF);
    cg::grid_group grid = cg::this_grid();
    volatile LAS unsigned* MISC = (volatile LAS unsigned*)(lds + MISC_OFF);
    if (tid < 32) MISC[tid] = 0u;
    __syncthreads();
    XcdBarrier bar; bar.bar = (unsigned*)(ws + WS_CTL); bar.x = 0; bar.st = nullptr;
    if (P.coop) bar = xcd_barrier_post((unsigned*)(ws + WS_CTL), MISC + 8);
    const int lo = P.ph_lo, hi = P.ph_hi;
#ifndef PHMASK
#define PHMASK 0x1ffff
#endif
#define IN(k) (((PHMASK >> (k)) & 1) && lo <= (k) && (k) < hi)
#ifndef REPMASK
#define REPMASK 0
#endif
#define REP(k) ((REPMASK >> (k)) & 1)
#ifndef REPKMASK
#define REPKMASK 0
#endif
#define REPK(k) ((REPKMASK >> (k)) & 1)
#define SEAM(k) do { if (P.coop && (k) + 1 < hi) { if (P.coop == 2) grid.sync(); else xcd_barrier(bar); } } while (0)

    if (IN(0)) {
        LAS float* scr = (LAS float*)(lds + wave * 8704);
        for (int it = gw; ; it += ngw) {
            int r = it; bool hit = false;
#define TR(W, K, LDN, C0, NC, WT, R0, GN) if (!hit) { const int n_it = ((K) / 64) * ((NC) / 32); if (r < n_it) { transpose_item((W), (K), (LDN), (C0), (WT), (R0), (NC) / 32, scr, r, lane, (GN)); hit = true; } else r -= n_it; }
            TR(P.w_in_ab, 1024, NSRC_AB, 0, 1536, WinAB, 0, nullptr)
            TR(P.w_in_ab, 1024, NSRC_AB, 1544, 1536, WinAB, 1536, nullptr)
            TR(P.w_out_ab, 1024, 1024, 0, 1024, WoutAB, 0, nullptr)
            TR(P.w_in_cd, 1024, NSRC_CD, 0, NSRC_CD, WinCD, 0, P.norm_mix + DM)
            TR(P.w_up, 1024, 4096, 0, 4096, Wup0, 0, P.norm_mlp)
            TR(P.w_down, 4096, 1024, 0, 1024, Wdn0, 0, nullptr)
#undef TR
            if (!hit) break;
        }
        for (int i = (vcu * NTHREADS + tid); i < 96 * 1024 / 8; i += G * NTHREADS) ((u32x4*)(WinCD + (size_t)2208 * 1024))[i] = (u32x4){0u, 0u, 0u, 0u};
        __syncthreads();
        LAS float* wfaT = (LAS float*)lds;
        for (int i = tid; i < 8192; i += NTHREADS) { const int k = i >> 3, j = i & 7; wfaT[j * 1024 + k] = P.w_in_ab[(size_t)k * NSRC_AB + 1536 + j]; }
        __syncthreads();
        norm_rows_bf16<true>(P.x, P.norm_mix, XN, gw, ngw, lane, wfaT, P.b_forget, LOGF, P.pos, TAB);
        __syncthreads();
        SEAM(0);
    }
    if (IN(1)) {
        if (vcu < 32) {
            const int b = vcu >> 3, h = vcu & 7; LAS float* sc = (LAS float*)lds;
            float v[8]; float run = 0.f;
#pragma unroll
            for (int e = 0; e < 8; ++e) { run += LOGF[((size_t)b * SEQ + tid * 8 + e) * 8 + h]; v[e] = run; }
            sc[tid] = run; __syncthreads();
            for (int off = 1; off < NTHREADS; off <<= 1) { const float add = (tid >= off) ? sc[tid - off] : 0.f; __syncthreads(); sc[tid] += add; __syncthreads(); }
            const float base = sc[tid] - run;
#pragma unroll
            for (int e = 0; e < 8; ++e) CUM[(size_t)(b * 8 + h) * SEQ + tid * 8 + e] = base + v[e];
            __syncthreads();
        }
        pg8::Gemm g{XN, WinAB, MT, LD_AB, DM}; pg8::StaticOrder S; S.init(MT, LD_AB, G, bx);
        pg8::EpiStoreAB E{BIG, LD_AB, KN2};
        pg8::gemm_phase<pg8::EpiStoreAB, pg8::StaticOrder, true, true>(lds, g, S, E);
        SEAM(1);
    }
    if (IN(2)) {
        unsigned* qctr = (unsigned*)(ws + WS_CTL + CTL_QCTR);
        LAS int* tk = (LAS int*)(lds + att::ATT_LDS);
        int nxt = 0;
        if (tid == 0) nxt = (int)atomicAdd(qctr, 1u);
        for (;;) {
            if (tid == 0) *tk = nxt;
            __syncthreads();
            const int t = __builtin_amdgcn_readfirstlane(*tk);
            __syncthreads();
            if (t >= 1024) break;
            if (tid == 0) nxt = (int)atomicAdd(qctr, 1u);
            if (t < 512) { const int qb = 15 - (t >> 5), bh = t & 31; att::fox_unit(lds, BIG, CUM, KN2, OB, bh >> 3, bh & 7, qb); }
            else { const int idx = t - 512, g4 = 15 - (idx >> 5), bh = idx & 31; att::chk_unit(lds, BIG, P.rel_bias, OB, bh >> 3, bh & 7, g4); }
        }
        SEAM(2);
    }
    if (IN(3)) {
        pg8::Gemm g{OB, WoutAB, MT, DM, DM}; pg8::StaticOrder S; S.init(MT, DM, G, bx);
        pg8::EpiResidB<1> E{P.x, XN, SSQ, DM};
        pg8::gemm_phase<pg8::EpiResidB<1>, pg8::StaticOrder, true, true>(lds, g, S, E);
        SEAM(3);
    }
    if (IN(5)) {
        pg8::Gemm g{XN, Wup0, MT, DFF, DM}; pg8::StaticOrder S; S.init(MT, DFF, G, bx);
        rstd_prepass(lds, S, SSQ, tid);
        pg8::EpiStore<1, 1> E{BIG, DFF, (const LAS float*)(lds + RSTD_OFF), 0};
        pg8::gemm_phase<pg8::EpiStore<1, 1>, pg8::StaticOrder, true, true>(lds, g, S, E);
        SEAM(5);
    }
    if (IN(6)) {
        pg8::Gemm g{BIG, Wdn0, MT, DM, DFF}; pg8::StaticOrder S; S.init(MT, DM, G, bx);
        pg8::EpiResidB<0> E{nullptr, XN, SSQ, DM};
        pg8::gemm_phase<pg8::EpiResidB<0>, pg8::StaticOrder, true, true>(lds, g, S, E);
        SEAM(6);
    }
    if (IN(8)) {
        pg8::Gemm g{XN, WinCD, MT, LD_CD, DM}; pg8::StaticOrder S; S.init(MT, LD_CD, G, bx);
        rstd_prepass(lds, S, SSQ, tid);
        pg8::EpiStoreCD E{BIG, LD_CD, (const LAS float*)(lds + RSTD_OFF), SSQ2, KR, TAB, 0};
        pg8::gemm_phase<pg8::EpiStoreCD, pg8::StaticOrder, true, true>(lds, g, S, E);
        if (G == 256 ? bx >= 64 : true) {
            const int nidle = (G == 256) ? 192 : G, iw = ((G == 256) ? bx - 64 : bx) * NWAVES + wave;
            LAS float* scr = (LAS float*)(lds + wave * 8704);
            for (int it = iw; ; it += nidle * NWAVES) {
                int r = it; bool hit = false;
#define TR(W, K, LDN, C0, NC, WT, R0, GN) if (!hit) { const int n_it = ((K) / 64) * ((NC) / 32); if (r < n_it) { transpose_item((W), (K), (LDN), (C0), (WT), (R0), (NC) / 32, scr, r, lane, (GN)); hit = true; } else r -= n_it; }
                TR(P.w_uq, 384, 768, 0, 768, Wuq, 0, P.q_norm)
                TR(P.w_ukv, 256, 1024, 0, 1024, Wukv, 0, P.kv_norm)
                TR(P.w_out_cd, 1024, 1024, 0, 1024, WoutCD, 0, nullptr)
                TR(P.w_up + (size_t)1024 * 4096, 1024, 4096, 0, 4096, Wup1, 0, P.norm_mlp + DM)
                TR(P.w_down + (size_t)4096 * 1024, 4096, 1024, 0, 1024, Wdn1, 0, nullptr)
#undef TR
                if (!hit) break;
            }
        }
        SEAM(8);
    }
    if (IN(10)) {
#ifndef P10SEL
#define P10SEL 3
#endif
        { pg8::Gemm g{BIG + 1536, Wuq, MT, 768, 384 + P.pad, LD_CD};
          pg8::StaticOrder S; S.init(MT, 768, G, bx);
          rstd_prepass_lr(lds, S, SSQ2, 0, 3, 1.0f / 384.0f, tid);
          pg8::EpiQRope E{QF, 768, TAB, (const LAS float*)(lds + RSTD_OFF)};
          pg8::gemm_phase<pg8::EpiQRope, pg8::StaticOrder, true, true>(lds, g, S, E); }
        { pg8::Gemm g{BIG + 1920, Wukv, MT, 1024, 256 + P.pad, LD_CD}; pg8::StaticOrder S; S.init(MT, 1024, G, bx);
          rstd_prepass_lr(lds, S, SSQ2, 12, 2, 1.0f / 256.0f, tid);
          pg8::EpiStore<0, 1> E{KVF, 1024, (const LAS float*)(lds + RSTD_OFF), 0};
          pg8::gemm_phase<pg8::EpiStore<0, 1>, pg8::StaticOrder, true, true>(lds, g, S, E); }
        SEAM(10);
    }
    if (IN(11)) {
        const int bh = vcu >> 3, s = vcu & 7, b = bh >> 3, h = bh & 7;
        if (vcu < 256) {
            att::mla_unit(lds, QF, KVF, KR, OB, b, h, 15 - s);
            att::mla_unit(lds, QF, KVF, KR, OB, b, h, s);
            att::sb_unit(lds, BIG, OB, b, h, 15 - s);
            att::sb_unit(lds, BIG, OB, b, h, s);
        }
        SEAM(11);
    }
    if (IN(12)) {
        pg8::Gemm g{OB, WoutCD, MT, DM, DM}; pg8::StaticOrder S; S.init(MT, DM, G, bx);
        pg8::EpiResidB<0> E{nullptr, XN, SSQ, DM};
        pg8::gemm_phase<pg8::EpiResidB<0>, pg8::StaticOrder, true, true>(lds, g, S, E);
        SEAM(12);
    }
    if (IN(14)) {
        pg8::Gemm g{XN, Wup1, MT, DFF, DM}; pg8::StaticOrder S; S.init(MT, DFF, G, bx);
        rstd_prepass(lds, S, SSQ, tid);
        pg8::EpiStore<1, 1> E{BIG, DFF, (const LAS float*)(lds + RSTD_OFF), 0};
        pg8::gemm_phase<pg8::EpiStore<1, 1>, pg8::StaticOrder, true, true>(lds, g, S, E);
        SEAM(14);
    }
    if (IN(15)) {
        pg8::Gemm g{BIG, Wdn1, MT, DM, DFF}; pg8::StaticOrder S; S.init(MT, DM, G, bx);
        pg8::EpiResidB<0> E{nullptr, XN, SSQ, DM};
        pg8::gemm_phase<pg8::EpiResidB<0>, pg8::StaticOrder, true, true>(lds, g, S, E);
        SEAM(15);
    }
    if (IN(16)) { norm_rows_final(XN, P.out, P.norm_final, gw, ngw, lane); }
#undef IN
#undef SEAM
}

#ifndef MK_MULTI_LAUNCH
#define MK_MULTI_LAUNCH 0
#endif
extern "C" void kernel_launch(void* const* d_in, const int* in_sizes, int n_in, void* d_out, int out_size, void* d_ws, size_t ws_size, hipStream_t stream) {
    static int grid = 0;
    if (grid == 0) {
        if (n_in != 17 || out_size != MT * DM || ws_size < WS_END) { fprintf(stderr, "kernel_launch: unexpected problem (n_in %d out %d ws %zu)\n", n_in, out_size, ws_size); grid = -1; return; }
        int dev = 0, cus = 0, per_cu = 0;
        hipGetDevice(&dev); hipDeviceGetAttribute(&cus, hipDeviceAttributeMultiprocessorCount, dev);
        if (hipFuncSetAttribute((const void*)fwd_kernel, hipFuncAttributeMaxDynamicSharedMemorySize, LDS_BYTES) != hipSuccess) { fprintf(stderr, "kernel_launch: hipFuncSetAttribute failed\n"); grid = -1; return; }
        if (hipOccupancyMaxActiveBlocksPerMultiprocessor(&per_cu, (const void*)fwd_kernel, NTHREADS, LDS_BYTES) != hipSuccess || per_cu < 1) { fprintf(stderr, "kernel_launch: occupancy query says %d\n", per_cu); per_cu = 1; }
        (void)hipGetLastError();
        grid = cus;
        if (grid != 256) fprintf(stderr, "kernel_launch: note: %d CUs\n", grid);
    }
    if (grid < 0) return;
    Params p{};
    p.x = (const float*)d_in[0]; p.pos = (const int*)d_in[1]; p.norm_mix = (const float*)d_in[2]; p.norm_mlp = (const float*)d_in[3]; p.norm_final = (const float*)d_in[4];
    p.w_in_ab = (const float*)d_in[5]; p.b_forget = (const float*)d_in[6]; p.rel_bias = (const float*)d_in[7]; p.w_out_ab = (const float*)d_in[8];
    p.w_in_cd = (const float*)d_in[9]; p.q_norm = (const float*)d_in[10]; p.kv_norm = (const float*)d_in[11]; p.w_uq = (const float*)d_in[12]; p.w_ukv = (const float*)d_in[13]; p.w_out_cd = (const float*)d_in[14];
    p.w_up = (const float*)d_in[15]; p.w_down = (const float*)d_in[16];
    p.out = (float*)d_out; p.ws = (unsigned char*)d_ws;
    if (hipMemsetAsync((char*)d_ws + WS_CTL, 0, CTL_BYTES, stream) != hipSuccess) { fprintf(stderr, "kernel_launch: hipMemsetAsync failed\n"); return; }
#if MK_MULTI_LAUNCH
    for (int ph = 0; ph < N_PHASES; ++ph) {
        p.ph_lo = ph; p.ph_hi = ph + 1; p.coop = 0;
        hipLaunchKernelGGL(fwd_kernel, dim3(grid), dim3(NTHREADS), LDS_BYTES, stream, p);
        if (REP(ph)) hipLaunchKernelGGL(fwd_kernel, dim3(grid), dim3(NTHREADS), LDS_BYTES, stream, p);
    }
#else
    p.ph_lo = 0; p.ph_hi = N_PHASES; p.coop = 1;
    void* args[] = {&p};
    hipError_t e = hipLaunchCooperativeKernel((const void*)fwd_kernel, dim3(grid), dim3(NTHREADS), args, LDS_BYTES, stream);
    if (e != hipSuccess) fprintf(stderr, "cooperative launch failed: %s (grid %d)\n", hipGetErrorString(e), grid);
#endif
}
```
